# Optimizing an MI355X kernel written in HIP

```python
import math
import jax
import jax.numpy as jnp
from jax import lax
import numpy as np

D_MODEL = 2048
BATCH = 2
SEQ = 8192
DEPTH = 2

N_META = 16
CHUNK = 64
CONV_K = 4
MIX_WIDTH = D_MODEL

S5_WIDTH = D_MODEL // 2
S5_GROUP = 16
S5_GROUPS = S5_WIDTH // S5_GROUP
S5_STATE = 64

GLA_HEADS = 4
GLA_DV = (D_MODEL // 2) // GLA_HEADS
GLA_DK = GLA_DV // 2
GLA_RANK = 16
GLA_TAU = 16.0

GDN_HEADS = 8
GDN_DK = (D_MODEL // 2) // GDN_HEADS
GDN_DV = GDN_DK

LRU_WIDTH = D_MODEL // 2
LRU_BLOCKS = 8
LRU_BW = LRU_WIDTH // LRU_BLOCKS
LRU_C = 8.0

MOE_GROUPS = 4
MOE_EPG = 8
MOE_TOPK = 2
MOE_FF = D_MODEL // 8

AB_SPLITS = (S5_WIDTH, GLA_HEADS * GLA_DK, GLA_HEADS * GLA_DK, GLA_HEADS * GLA_DV, GLA_RANK, GLA_HEADS * GLA_DV)
AB_IN = sum(AB_SPLITS)
CD_SPLITS = (2 * GDN_HEADS * GDN_DK + GDN_HEADS * GDN_DV, GDN_HEADS * GDN_DV, GDN_HEADS, GDN_HEADS, LRU_WIDTH, LRU_WIDTH)
CD_IN = sum(CD_SPLITS)

N_AB = (DEPTH + 1) // 2
N_CD = DEPTH // 2
DN_ALPHA = (2.0 * DEPTH) ** 0.25
DN_BETA = (8.0 * DEPTH) ** -0.25
LN_EPS = 1e-5
NORM_EPS = 1e-6

kernel_name = 'hybrid_s5_gla_gdn_rglru_hmoe'


def split_cols(h, sizes):
    offs = [int(s) for s in np.cumsum(sizes)[:-1]]
    return jnp.split(h, offs, axis=-1)


def layer_norm(x, g, b):
    xf = x.astype(jnp.float32)
    mu = jnp.mean(xf, axis=-1, keepdims=True)
    xc = xf - mu
    var = jnp.mean(xc * xc, axis=-1, keepdims=True)
    y = xc * lax.rsqrt(var + LN_EPS) * g.astype(jnp.float32) + b.astype(jnp.float32)
    return y.astype(x.dtype)


def rms_norm_heads(o, g):
    return o * lax.rsqrt(jnp.mean(o * o, axis=-1, keepdims=True) + NORM_EPS) * g.astype(jnp.float32)


def l2_normalize(t):
    return t * lax.rsqrt(jnp.sum(t * t, axis=-1, keepdims=True) + NORM_EPS)


def causal_conv(x, w, b=None):
    L = x.shape[1]
    xp = jnp.pad(x, ((0, 0), (CONV_K - 1, 0), (0, 0)))
    y = xp[:, 0:L] * w[0]
    for j in range(1, CONV_K):
        y = y + xp[:, j:j + L] * w[j]
    if b is not None:
        y = y + b
    return y


def linear_combine(left, right):
    a_l, b_l = left
    a_r, b_r = right
    return a_r * a_l, a_r * b_l + b_r


def to_chunks(t):
    pad = CHUNK - N_META
    t = jnp.pad(t.astype(jnp.float32), [(0, 0), (pad, 0)] + [(0, 0)] * (t.ndim - 2))
    bsz, lp = t.shape[:2]
    t = t.reshape((bsz, lp // CHUNK, CHUNK) + t.shape[2:])
    return jnp.moveaxis(t, 3, 1)


def from_chunks(t):
    bsz, nh, nc, c = t.shape[:4]
    t = jnp.moveaxis(t, 1, 3).reshape((bsz, nc * c, nh) + t.shape[4:])
    return t[:, CHUNK - N_META:]


def s5_mixer(u, a_re, a_im, log_dt, b_re, b_im, c_re, c_im, d, w_glu, b_glu):
    f32 = jnp.float32
    bsz, L, _ = u.shape
    uf = u.astype(f32).reshape(bsz, L, S5_GROUPS, S5_GROUP)
    a = lax.complex(a_re.astype(f32), a_im.astype(f32))
    dt = jnp.exp(log_dt.astype(f32))[:, None]
    a_bar = jnp.exp(a * dt)
    zoh = (a_bar - 1.0) / a
    bu = lax.complex(jnp.einsum('blgc,gpc->blgp', uf, b_re.astype(f32)),
                     jnp.einsum('blgc,gpc->blgp', uf, b_im.astype(f32))) * zoh
    a_seq = jnp.broadcast_to(a_bar, bu.shape)
    _, state = lax.associative_scan(linear_combine, (a_seq, bu), axis=1)
    y = (jnp.einsum('blgp,gcp->blgc', state.real, c_re.astype(f32))
         - jnp.einsum('blgp,gcp->blgc', state.imag, c_im.astype(f32))
         + d.astype(f32).reshape(S5_GROUPS, S5_GROUP) * uf)
    z = jax.nn.gelu(y.reshape(bsz, L, S5_WIDTH))
    out = z * jax.nn.sigmoid(z @ w_glu.astype(f32) + b_glu.astype(f32))
    return out.astype(u.dtype)


def gla_chunked(q, k, v, g):
    q, k, v, g = to_chunks(q), to_chunks(k), to_chunks(v), to_chunks(g)
    bsz, nh, _, _, dk = q.shape
    dv = v.shape[-1]
    bcum = jnp.cumsum(g, axis=3)
    b_last = bcum[:, :, :, -1:, :]
    q_in = q * jnp.exp(bcum)
    k_in = k * jnp.exp(-bcum)
    k_st = k * jnp.exp(b_last - bcum)
    causal = jnp.tril(jnp.ones((CHUNK, CHUNK), dtype=bool))
    att = jnp.where(causal, jnp.einsum('bhncd,bhnsd->bhncs', q_in, k_in), 0.0)
    o_intra = jnp.einsum('bhncs,bhnsv->bhncv', att, v)

    def step(s, inp):
        q_n, k_n, v_n, dec_n = inp
        o_n = jnp.einsum('bhcd,bhdv->bhcv', q_n, s)
        s = s * dec_n[..., None] + jnp.einsum('bhcd,bhcv->bhdv', k_n, v_n)
        return s, o_n

    s0 = jnp.zeros((bsz, nh, dk, dv), jnp.float32)
    xs = (jnp.moveaxis(q_in, 2, 0), jnp.moveaxis(k_st, 2, 0), jnp.moveaxis(v, 2, 0),
          jnp.moveaxis(jnp.exp(b_last[:, :, :, 0]), 2, 0))
    _, o_inter = lax.scan(step, s0, xs)
    return from_chunks(o_intra + jnp.moveaxis(o_inter, 0, 2))


def gla_mixer(q, k, v, g_low, r, w_gate, b_gate, norm_g):
    bsz, L, _ = q.shape
    logf = jax.nn.log_sigmoid((g_low @ w_gate).astype(jnp.float32) + b_gate.astype(jnp.float32)) / GLA_TAU
    qh = q.astype(jnp.float32).reshape(bsz, L, GLA_HEADS, GLA_DK) * (GLA_DK ** -0.5)
    kh = k.reshape(bsz, L, GLA_HEADS, GLA_DK)
    vh = v.reshape(bsz, L, GLA_HEADS, GLA_DV)
    o = gla_chunked(qh, kh, vh, logf.reshape(bsz, L, GLA_HEADS, GLA_DK))
    o = rms_norm_heads(o, norm_g) * jax.nn.silu(r.astype(jnp.float32).reshape(bsz, L, GLA_HEADS, GLA_DV))
    return o.reshape(bsz, L, GLA_HEADS * GLA_DV).astype(q.dtype)


def gdn_chunked(q, k, v, beta, g):
    q, k, v, beta, g = to_chunks(q), to_chunks(k), to_chunks(v), to_chunks(beta), to_chunks(g)
    bsz, nh, _, _, dk = q.shape
    dv = v.shape[-1]
    gc = jnp.cumsum(g, axis=-1)
    tril = jnp.tril(jnp.ones((CHUNK, CHUNK), dtype=bool))
    strict = jnp.tril(jnp.ones((CHUNK, CHUNK), dtype=bool), -1)
    gam = jnp.exp(jnp.where(tril, gc[..., :, None] - gc[..., None, :], -jnp.inf))
    kb = k * beta[..., None]
    m = jnp.where(strict, jnp.einsum('bhncd,bhnsd->bhncs', kb, k) * gam, 0.0)
    eye = jnp.eye(CHUNK, dtype=jnp.float32)
    rhs = jnp.concatenate([v * beta[..., None], kb * jnp.exp(gc)[..., None]], axis=-1)
    sol = lax.linalg.triangular_solve(eye + m, rhs, left_side=True, lower=True, unit_diagonal=True)
    u_c, w_c = sol[..., :dv], sol[..., dv:]
    a_qk = jnp.einsum('bhncd,bhnsd->bhncs', q, k) * gam
    q_dec = q * jnp.exp(gc)[..., None]
    g_last = gc[..., -1]
    k_st = k * jnp.exp(g_last[..., None] - gc)[..., None]

    def step(s, inp):
        q_n, k_n, u_n, w_n, a_n, dec_n = inp
        v_new = u_n - jnp.einsum('bhcd,bhdv->bhcv', w_n, s)
        o_n = jnp.einsum('bhcd,bhdv->bhcv', q_n, s) + jnp.einsum('bhcs,bhsv->bhcv', a_n, v_new)
        s = s * dec_n[..., None, None] + jnp.einsum('bhcd,bhcv->bhdv', k_n, v_new)
        return s, o_n

    s0 = jnp.zeros((bsz, nh, dk, dv), jnp.float32)
    xs = tuple(jnp.moveaxis(t, 2, 0) for t in (q_dec, k_st, u_c, w_c, a_qk, jnp.exp(g_last)))
    _, o = lax.scan(step, s0, xs)
    return from_chunks(jnp.moveaxis(o, 0, 2))


def gated_deltanet(qkv, z, beta_logit, a_logit, conv_w, a_log, dt_bias, norm_g):
    f32 = jnp.float32
    bsz, L, _ = qkv.shape
    qkv = jax.nn.silu(causal_conv(qkv, conv_w).astype(f32))
    q, k, v = split_cols(qkv, (GDN_HEADS * GDN_DK, GDN_HEADS * GDN_DK, GDN_HEADS * GDN_DV))
    q = l2_normalize(q.reshape(bsz, L, GDN_HEADS, GDN_DK)) * (GDN_DK ** -0.5)
    k = l2_normalize(k.reshape(bsz, L, GDN_HEADS, GDN_DK))
    v = v.reshape(bsz, L, GDN_HEADS, GDN_DV)
    beta = jax.nn.sigmoid(beta_logit.astype(f32))
    g = -jnp.exp(a_log.astype(f32)) * jax.nn.softplus(a_logit.astype(f32) + dt_bias.astype(f32))
    o = gdn_chunked(q, k, v, beta, g)
    o = rms_norm_heads(o, norm_g) * jax.nn.silu(z.astype(f32).reshape(bsz, L, GDN_HEADS, GDN_DV))
    return o.reshape(bsz, L, GDN_HEADS * GDN_DV).astype(z.dtype)


def rglru_mixer(xb, gate, conv_w, conv_b, w_a, b_a, w_x, b_x, lam):
    f32 = jnp.float32
    bsz, L, _ = xb.shape
    xc = causal_conv(xb, conv_w, conv_b).astype(f32).reshape(bsz, L, LRU_BLOCKS, LRU_BW)
    r = jax.nn.sigmoid(jnp.einsum('blhi,hij->blhj', xc, w_a.astype(f32)) + b_a.astype(f32).reshape(LRU_BLOCKS, LRU_BW))
    i = jax.nn.sigmoid(jnp.einsum('blhi,hij->blhj', xc, w_x.astype(f32)) + b_x.astype(f32).reshape(LRU_BLOCKS, LRU_BW))
    log_a = -LRU_C * jax.nn.softplus(-lam.astype(f32)).reshape(LRU_BLOCKS, LRU_BW) * r
    a = jnp.exp(log_a)
    bx = jnp.sqrt(-jnp.expm1(2.0 * log_a)) * (i * xc)
    _, hs = lax.associative_scan(linear_combine, (a, bx), axis=1)
    y = hs.reshape(bsz, L, LRU_WIDTH) * jax.nn.gelu(gate.astype(f32))
    return y.astype(xb.dtype)


def mixer_ab(x, w_in, a_re, a_im, log_dt, b_re, b_im, c_re, c_im, d, w_glu, b_glu,
             gla_w_gate, gla_b_gate, gla_norm, w_out):
    h = x @ w_in
    u, q, k, v, g_low, r = split_cols(h, AB_SPLITS)
    y_s5 = s5_mixer(u, a_re, a_im, log_dt, b_re, b_im, c_re, c_im, d, w_glu, b_glu)
    y_gla = gla_mixer(q, k, v, g_low, r, gla_w_gate, gla_b_gate, gla_norm)
    return jnp.concatenate([y_s5, y_gla], axis=-1) @ w_out


def mixer_cd(x, w_in, conv_w, a_log, dt_bias, gdn_norm, lru_conv_w, lru_conv_b,
             lru_w_a, lru_b_a, lru_w_x, lru_b_x, lru_lambda, w_out):
    h = x @ w_in
    qkv, z, beta_logit, a_logit, lru_x, lru_gate = split_cols(h, CD_SPLITS)
    y_gdn = gated_deltanet(qkv, z, beta_logit, a_logit, conv_w, a_log, dt_bias, gdn_norm)
    y_lru = rglru_mixer(lru_x, lru_gate, lru_conv_w, lru_conv_b, lru_w_a, lru_b_a, lru_w_x, lru_b_x, lru_lambda)
    return jnp.concatenate([y_gdn, y_lru], axis=-1) @ w_out


def hier_moe(x, w_rg, b_rg, w_re, b_re, w_gate, w_up, w_down):
    f32 = jnp.float32
    bsz, L, dm = x.shape
    xt = x.reshape(bsz * L, dm)
    lg = (xt @ w_rg).astype(f32) + b_rg.astype(f32)
    pg = jax.nn.softmax(lg, axis=-1)
    p_top, g_top = lax.top_k(pg, 1)
    le = jnp.einsum('td,dge->tge', xt, w_re).astype(f32) + b_re.astype(f32)
    le_sel = jnp.take_along_axis(le, g_top[:, :, None], axis=1)[:, 0]
    v_top, e_top = lax.top_k(le_sel, MOE_TOPK)
    w_tok = p_top * jax.nn.softmax(v_top, axis=-1)
    comb_e = jnp.einsum('tk,tke->te', w_tok, jax.nn.one_hot(e_top, MOE_EPG, dtype=f32))
    comb = (jax.nn.one_hot(g_top[:, 0], MOE_GROUPS, dtype=f32)[:, :, None] * comb_e[:, None, :]).astype(x.dtype)
    out = jnp.zeros_like(xt)
    for gi in range(MOE_GROUPS):
        hg = jnp.einsum('td,edf->tef', xt, w_gate[gi])
        hu = jnp.einsum('td,edf->tef', xt, w_up[gi])
        hh = jax.nn.silu(hg) * hu * comb[:, gi, :, None]
        out = out + jnp.einsum('tef,efd->td', hh, w_down[gi])
    return out.reshape(bsz, L, dm)


def setup_inputs(seed: int = 0) -> dict:
    key = jax.random.key(seed)
    ks = iter(jax.random.split(key, 64))
    f32 = jnp.float32

    def nrm(shape, scale):
        return jax.random.normal(next(ks), shape, f32) * scale

    def unif(shape, lo, hi):
        return jax.random.uniform(next(ks), shape, f32, lo, hi)

    x = nrm((BATCH, SEQ, D_MODEL), 1.0)
    meta_tokens = nrm((N_META, D_MODEL), 1.0)
    ab_w_in = nrm((N_AB, D_MODEL, AB_IN), D_MODEL ** -0.5)
    ab_s5_a_re = -0.5 * jnp.exp(nrm((N_AB, S5_GROUPS, S5_STATE), 0.05))
    ab_s5_a_im = math.pi * jnp.arange(S5_STATE, dtype=f32) + nrm((N_AB, S5_GROUPS, S5_STATE), 0.01)
    ab_s5_log_dt = unif((N_AB, S5_GROUPS), math.log(1e-3), math.log(1e-1))
    ab_s5_b_re = nrm((N_AB, S5_GROUPS, S5_STATE, S5_GROUP), (2 * S5_GROUP) ** -0.5)
    ab_s5_b_im = nrm((N_AB, S5_GROUPS, S5_STATE, S5_GROUP), (2 * S5_GROUP) ** -0.5)
    ab_s5_c_re = nrm((N_AB, S5_GROUPS, S5_GROUP, S5_STATE), S5_STATE ** -0.5)
    ab_s5_c_im = nrm((N_AB, S5_GROUPS, S5_GROUP, S5_STATE), S5_STATE ** -0.5)
    ab_s5_d = nrm((N_AB, S5_WIDTH), 1.0)
    ab_s5_w_glu = nrm((N_AB, S5_WIDTH, S5_WIDTH), S5_WIDTH ** -0.5)
    ab_s5_b_glu = nrm((N_AB, S5_WIDTH), 0.01)
    ab_gla_w_gate = nrm((N_AB, GLA_RANK, GLA_HEADS * GLA_DK), GLA_RANK ** -0.5)
    ab_gla_b_gate = nrm((N_AB, GLA_HEADS * GLA_DK), 0.01)
    ab_gla_norm = 1.0 + nrm((N_AB, GLA_DV), 0.02)
    ab_w_out = nrm((N_AB, MIX_WIDTH, D_MODEL), (MIX_WIDTH ** -0.5) * DN_BETA)
    cd_w_in = nrm((N_CD, D_MODEL, CD_IN), D_MODEL ** -0.5)
    cd_conv_w = nrm((N_CD, CONV_K, CD_SPLITS[0]), CONV_K ** -0.5)
    cd_gdn_a_log = jnp.log(unif((N_CD, GDN_HEADS), 1.0, 16.0))
    dt0 = jnp.exp(unif((N_CD, GDN_HEADS), math.log(1e-3), math.log(1e-1)))
    cd_gdn_dt_bias = dt0 + jnp.log(-jnp.expm1(-dt0))
    cd_gdn_norm = 1.0 + nrm((N_CD, GDN_DV), 0.02)
    cd_lru_conv_w = nrm((N_CD, CONV_K, LRU_WIDTH), CONV_K ** -0.5)
    cd_lru_conv_b = nrm((N_CD, LRU_WIDTH), 0.01)
    cd_lru_w_a = nrm((N_CD, LRU_BLOCKS, LRU_BW, LRU_BW), LRU_BW ** -0.5)
    cd_lru_b_a = nrm((N_CD, LRU_WIDTH), 0.01)
    cd_lru_w_x = nrm((N_CD, LRU_BLOCKS, LRU_BW, LRU_BW), LRU_BW ** -0.5)
    cd_lru_b_x = nrm((N_CD, LRU_WIDTH), 0.01)
    a_c = unif((N_CD, LRU_WIDTH), 0.9, 0.999) ** (1.0 / LRU_C)
    cd_lru_lambda = jnp.log(a_c) - jnp.log1p(-a_c)
    cd_w_out = nrm((N_CD, MIX_WIDTH, D_MODEL), (MIX_WIDTH ** -0.5) * DN_BETA)
    moe_w_router_g = nrm((DEPTH, D_MODEL, MOE_GROUPS), D_MODEL ** -0.5)
    moe_b_router_g = nrm((DEPTH, MOE_GROUPS), 0.01)
    moe_w_router_e = nrm((DEPTH, D_MODEL, MOE_GROUPS, MOE_EPG), D_MODEL ** -0.5)
    moe_b_router_e = nrm((DEPTH, MOE_GROUPS, MOE_EPG), 0.01)
    moe_w_gate = nrm((DEPTH, MOE_GROUPS, MOE_EPG, D_MODEL, MOE_FF), D_MODEL ** -0.5)
    moe_w_up = nrm((DEPTH, MOE_GROUPS, MOE_EPG, D_MODEL, MOE_FF), D_MODEL ** -0.5)
    moe_w_down = nrm((DEPTH, MOE_GROUPS, MOE_EPG, MOE_FF, D_MODEL), (MOE_FF ** -0.5) * DN_BETA)
    ln_mix_g = 1.0 + nrm((DEPTH, D_MODEL), 0.02)
    ln_mix_b = nrm((DEPTH, D_MODEL), 0.01)
    ln_ffn_g = 1.0 + nrm((DEPTH, D_MODEL), 0.02)
    ln_ffn_b = nrm((DEPTH, D_MODEL), 0.01)
    return {'x': x, 'meta_tokens': meta_tokens, 'ab_w_in': ab_w_in,
            'ab_s5_a_re': ab_s5_a_re, 'ab_s5_a_im': ab_s5_a_im, 'ab_s5_log_dt': ab_s5_log_dt,
            'ab_s5_b_re': ab_s5_b_re, 'ab_s5_b_im': ab_s5_b_im, 'ab_s5_c_re': ab_s5_c_re,
            'ab_s5_c_im': ab_s5_c_im, 'ab_s5_d': ab_s5_d, 'ab_s5_w_glu': ab_s5_w_glu,
            'ab_s5_b_glu': ab_s5_b_glu, 'ab_gla_w_gate': ab_gla_w_gate, 'ab_gla_b_gate': ab_gla_b_gate,
            'ab_gla_norm': ab_gla_norm, 'ab_w_out': ab_w_out, 'cd_w_in': cd_w_in,
            'cd_conv_w': cd_conv_w, 'cd_gdn_a_log': cd_gdn_a_log, 'cd_gdn_dt_bias': cd_gdn_dt_bias,
            'cd_gdn_norm': cd_gdn_norm, 'cd_lru_conv_w': cd_lru_conv_w, 'cd_lru_conv_b': cd_lru_conv_b,
            'cd_lru_w_a': cd_lru_w_a, 'cd_lru_b_a': cd_lru_b_a, 'cd_lru_w_x': cd_lru_w_x,
            'cd_lru_b_x': cd_lru_b_x, 'cd_lru_lambda': cd_lru_lambda, 'cd_w_out': cd_w_out,
            'moe_w_router_g': moe_w_router_g, 'moe_b_router_g': moe_b_router_g,
            'moe_w_router_e': moe_w_router_e, 'moe_b_router_e': moe_b_router_e,
            'moe_w_gate': moe_w_gate, 'moe_w_up': moe_w_up, 'moe_w_down': moe_w_down,
            'ln_mix_g': ln_mix_g, 'ln_mix_b': ln_mix_b, 'ln_ffn_g': ln_ffn_g, 'ln_ffn_b': ln_ffn_b}


def reference(x, meta_tokens, ab_w_in, ab_s5_a_re, ab_s5_a_im, ab_s5_log_dt, ab_s5_b_re, ab_s5_b_im,
              ab_s5_c_re, ab_s5_c_im, ab_s5_d, ab_s5_w_glu, ab_s5_b_glu, ab_gla_w_gate, ab_gla_b_gate,
              ab_gla_norm, ab_w_out, cd_w_in, cd_conv_w, cd_gdn_a_log, cd_gdn_dt_bias, cd_gdn_norm,
              cd_lru_conv_w, cd_lru_conv_b, cd_lru_w_a, cd_lru_b_a, cd_lru_w_x, cd_lru_b_x, cd_lru_lambda,
              cd_w_out, moe_w_router_g, moe_b_router_g, moe_w_router_e, moe_b_router_e, moe_w_gate,
              moe_w_up, moe_w_down, ln_mix_g, ln_mix_b, ln_ffn_g, ln_ffn_b):
    bsz = x.shape[0]
    meta = jnp.broadcast_to(meta_tokens.astype(x.dtype)[None], (bsz, N_META, D_MODEL))
    h = jnp.concatenate([meta, x], axis=1)
    for layer in range(DEPTH):
        j = layer // 2
        if layer % 2 == 0:
            mix = mixer_ab(h, ab_w_in[j], ab_s5_a_re[j], ab_s5_a_im[j], ab_s5_log_dt[j], ab_s5_b_re[j],
                           ab_s5_b_im[j], ab_s5_c_re[j], ab_s5_c_im[j], ab_s5_d[j], ab_s5_w_glu[j],
                           ab_s5_b_glu[j], ab_gla_w_gate[j], ab_gla_b_gate[j], ab_gla_norm[j], ab_w_out[j])
        else:
            mix = mixer_cd(h, cd_w_in[j], cd_conv_w[j], cd_gdn_a_log[j], cd_gdn_dt_bias[j], cd_gdn_norm[j],
                           cd_lru_conv_w[j], cd_lru_conv_b[j], cd_lru_w_a[j], cd_lru_b_a[j], cd_lru_w_x[j],
                           cd_lru_b_x[j], cd_lru_lambda[j], cd_w_out[j])
        h = layer_norm(DN_ALPHA * h + mix, ln_mix_g[layer], ln_mix_b[layer])
        ffn = hier_moe(h, moe_w_router_g[layer], moe_b_router_g[layer], moe_w_router_e[layer],
                       moe_b_router_e[layer], moe_w_gate[layer], moe_w_up[layer], moe_w_down[layer])
        h = layer_norm(DN_ALPHA * h + ffn, ln_ffn_g[layer], ln_ffn_b[layer])
    return h[:, N_META:]
```

```cpp
#include <hip/hip_runtime.h>
#include <cstdio>
#include <cstdint>

typedef unsigned short bf16_t;
typedef unsigned v4u __attribute__((ext_vector_type(4)));
typedef unsigned v2u __attribute__((ext_vector_type(2)));

constexpr int D = 2048, BATCH = 2, SEQ = 8192, NMETA = 16, CHUNK = 64;
constexpr int PADF = CHUNK - NMETA;
constexpr int LP = SEQ + NMETA + PADF;
constexpr int NCH = LP / CHUNK;
constexpr int MROWS = BATCH * LP;
constexpr int MP = 16640;
constexpr int NP0 = 4096, NP1 = 6144;
constexpr int S5W = 1024, S5G = 64, S5P = 64, S5C = 16;
constexpr int GLH = 4, GLDK = 128, GLDV = 256, GLR = 16;
constexpr int GDH = 8, GDK = 128, GDV = 128;
constexpr int LRW = 1024, LRB = 8, LRBW = 128;
constexpr int MOE_G = 4, MOE_E = 8, MOE_NE = 32, MOE_FF = 256;
constexpr float DN_ALPHA = 1.41421356237309515f;
constexpr float LN_EPS = 1e-5f, NORM_EPS = 1e-6f;

constexpr int P0_U = 0, P0_Q = 1024, P0_K = 1536, P0_V = 2048, P0_R = 3072;
constexpr int P1_Q = 0, P1_K = 1024, P1_V = 2048, P1_Z = 3072, P1_LX = 4096, P1_LG = 5120;

constexpr size_t MiB = 1u << 20;
constexpr size_t WS_CTL = 0;
constexpr size_t WS_WIN0 = 1 * MiB;
constexpr size_t WS_WIN1 = WS_WIN0 + (size_t)NP0 * D * 2;
constexpr size_t WS_WOUT0 = WS_WIN1 + (size_t)NP1 * D * 2;
constexpr size_t WS_WOUT1 = WS_WOUT0 + (size_t)D * D * 2;
constexpr size_t WS_WGLU = WS_WOUT1 + (size_t)D * D * 2;
constexpr size_t WS_S5C = WS_WGLU + (size_t)S5W * S5W * 2;
constexpr size_t WS_WR = WS_S5C + 1 * MiB;
constexpr size_t WS_S5B = WS_S5C + 2 * MiB;
constexpr size_t WS_WSK3 = WS_S5C + 3 * MiB + 512 * 1024;
constexpr size_t WS_WLRU = WS_S5C + 3 * MiB;
constexpr size_t WS_MW1 = WS_S5C + 4 * MiB;
constexpr size_t WS_MW2 = WS_MW1 + (size_t)MOE_NE * 512 * D * 2;
constexpr size_t WS_H = WS_MW2 + (size_t)MOE_NE * D * MOE_FF * 2;
constexpr size_t WS_HB = WS_H + (size_t)MP * D * 4;
constexpr size_t WS_P = WS_HB + (size_t)MP * D * 2;
constexpr size_t WS_Z = WS_P + (size_t)MP * NP0 * 2;
constexpr size_t WS_Y = WS_P + (size_t)MP * NP1 * 2;
constexpr size_t WS_SK = WS_Y + (size_t)MP * D * 2;
constexpr size_t WS_TOKE = WS_SK + (size_t)MP * 16 * 4;
constexpr size_t WS_TOKW = WS_TOKE + (size_t)MROWS * 2 * 4;
constexpr size_t WS_TOKS = WS_TOKW + (size_t)MROWS * 2 * 4;
constexpr int XS_ROWS = 2 * (BATCH * (SEQ + NMETA)) + 256;
constexpr size_t WS_XW = WS_TOKS + (size_t)MROWS * 2 * 4;
constexpr size_t WS_LRUF = WS_XW + (size_t)XS_ROWS * 4;
constexpr size_t WS_END = WS_LRUF + 3 * MiB;
constexpr size_t WS_S5X = WS_Z + (size_t)MP * S5W * 2;
constexpr size_t WS_GDEC = WS_S5X + 9 * MiB;
static_assert(WS_GDEC + 1 * MiB <= WS_P + (size_t)MP * NP1 * 2, "layer-0 scratch inside the P region");
static_assert((size_t)BATCH * NCH * GLH * 256 * 128 * 2 <= (size_t)MP * D * 2, "GLA states fit in HB");
constexpr size_t WS_LISTE = WS_LRUF;
static_assert((size_t)MOE_NE * MROWS * 4 <= 3 * MiB, "expert lists fit in the LRUF region");
constexpr size_t WS_MIX = WS_P;
constexpr size_t WS_XS = WS_P;
constexpr size_t WS_HH = WS_XS + (size_t)XS_ROWS * D * 2;
static_assert(WS_HH + (size_t)XS_ROWS * MOE_FF * 2 <= WS_Y, "MoE temporaries fit in the P region");
constexpr int CW_CNT = 64;
constexpr int CW_BAR = 4096;
constexpr int S5C_ABAR = 0;
constexpr int S5C_BBAR = S5C_ABAR + 64 * 64 * 2;
constexpr int S5C_END = S5C_BBAR + 64 * 64 * 16 * 2;
constexpr int S5B_BR = 0, S5B_BI = 65536, S5B_CM = 131072;

__device__ __forceinline__ float bf2f(bf16_t b) { return __uint_as_float(((unsigned)b) << 16); }
typedef __bf16 bf16n2 __attribute__((ext_vector_type(2)));
__device__ __forceinline__ unsigned pk2(float lo, float hi) { const bf16n2 v = {(__bf16)lo, (__bf16)hi}; return __builtin_bit_cast(unsigned, v); }
__device__ __forceinline__ unsigned f2bf(float f) { return pk2(f, f) & 0xffffu; }
__device__ __forceinline__ float rcpf_(float x) { return __builtin_amdgcn_rcpf(x); }
__device__ __forceinline__ float sigmoidf_(float x) { return rcpf_(1.0f + __expf(-x)); }
__device__ __forceinline__ float siluf_(float x) { return x * sigmoidf_(x); }
__device__ __forceinline__ float softplusf_(float x) { return fmaxf(x, 0.f) + __logf(1.0f + __expf(-fabsf(x))); }
__device__ __forceinline__ float logsigmoidf_(float x) { return -softplusf_(-x); }
__device__ __forceinline__ float gelu_tanh(float x) { const float u = 0.7978845608028654f * (x + 0.044715f * x * x * x); return x * sigmoidf_(2.0f * u); }
__device__ __forceinline__ float neg_expm1f_(float x) { const float ax = -x; return ax < 0.03f ? ax * (1.0f - ax * (0.5f - ax * (1.0f / 6.0f))) : 1.0f - __expf(x); }
__device__ __forceinline__ float wave_sum(float v) {
#pragma unroll
    for (int o = 1; o < 64; o <<= 1) v += __shfl_xor(v, o);
    return v;
}
__device__ __forceinline__ bool row_valid(int m) { return m < MROWS && (m % LP) >= PADF; }

__device__ __forceinline__ void transpose_item(const float* src  , size_t ldw, bf16_t* dst  , size_t ldt, float* scr, int lane) {
#pragma unroll 8
    for (int i = 0; i < 32; ++i) { const int kk = 2 * i + (lane >> 5); scr[kk * 33 + (lane & 31)] = src[(size_t)kk * ldw + (lane & 31)]; }
    __builtin_amdgcn_s_waitcnt(0); asm volatile("" ::: "memory");
    const int c = lane & 7;
#pragma unroll
    for (int j = 0; j < 4; ++j) { const int n = (lane >> 3) + 8 * j; const float* s = scr + (8 * c) * 33 + n;
        v4u o; o.x = pk2(s[0 * 33], s[1 * 33]); o.y = pk2(s[2 * 33], s[3 * 33]); o.z = pk2(s[4 * 33], s[5 * 33]); o.w = pk2(s[6 * 33], s[7 * 33]);
        *(v4u*)(dst + (size_t)n * ldt + 8 * c) = o; }
    __builtin_amdgcn_s_waitcnt(0); asm volatile("" ::: "memory");
}
struct CvtJob { const float* src; size_t ldw; int K, ncols; bf16_t* dst; size_t ldt; };
__device__ __forceinline__ void cvt_job_items(const CvtJob& j, int item, float* scr, int lane) {
    const int nblk = j.ncols / 32, kb = item / nblk, nb = item % nblk;
    transpose_item(j.src + (size_t)(64 * kb) * j.ldw + 32 * nb, j.ldw, j.dst + (size_t)(32 * nb) * j.ldt + 64 * kb, j.ldt, scr, lane);
}
struct Ptrs {
    const float* in[41];
    float* out;
    unsigned char* ws;
};
template <class PP> __device__ __forceinline__ CvtJob static_job(PP p, int j) {
    CvtJob r;
    switch (j) {
    case 0: r = {p->in[2], 4112, D, 3072, (bf16_t*)(p->ws + WS_WIN0), D}; break;
    case 1: r = {p->in[2] + 3088, 4112, D, 1024, (bf16_t*)(p->ws + WS_WIN0) + (size_t)3072 * D, D}; break;
    case 2: r = {p->in[17], 6160, D, 4096, (bf16_t*)(p->ws + WS_WIN1), D}; break;
    case 3: r = {p->in[17] + 4112, 6160, D, 2048, (bf16_t*)(p->ws + WS_WIN1) + (size_t)4096 * D, D}; break;
    case 4: r = {p->in[16], D, D, D, (bf16_t*)(p->ws + WS_WOUT0), D}; break;
    case 5: r = {p->in[29], D, D, D, (bf16_t*)(p->ws + WS_WOUT1), D}; break;
    case 6: r = {p->in[11], S5W, S5W, S5W, (bf16_t*)(p->ws + WS_WGLU), S5W}; break;
    default: { const int q = j - 7, which = q >> 3, hb = q & 7;
        r = {p->in[which ? 26 : 24] + (size_t)hb * 128 * 128, 128, 128, 128, (bf16_t*)(p->ws + WS_WLRU) + (size_t)which * LRB * 128 * 128 + (size_t)hb * 128 * 128, 128}; } break;
    }
    return r;
}
template <class PP> __device__ __forceinline__ CvtJob moe_job(PP p, int L, int j) {
    const int e = j / 5, t = j % 5; CvtJob r;
    const size_t eoff = ((size_t)L * MOE_NE + e) * (size_t)D * MOE_FF;
    bf16_t* w1 = (bf16_t*)(p->ws + WS_MW1) + (size_t)e * 512 * D; bf16_t* w2 = (bf16_t*)(p->ws + WS_MW2) + (size_t)e * D * MOE_FF;
    if (t < 2) r = {p->in[34] + eoff + 128 * t, MOE_FF, D, 128, w1 + (size_t)(256 * t) * D, D};
    else if (t < 4) r = {p->in[35] + eoff + 128 * (t - 2), MOE_FF, D, 128, w1 + (size_t)(256 * (t - 2) + 128) * D, D};
    else r = {p->in[36] + eoff, D, MOE_FF, D, w2, MOE_FF};
    return r;
}
namespace pg8 {
#define PG8_LAS __attribute__((address_space(3)))
typedef unsigned short bf16_t;
typedef short bf16x8 __attribute__((ext_vector_type(8)));
typedef float f32x4 __attribute__((ext_vector_type(4)));
typedef unsigned u32x4 __attribute__((ext_vector_type(4)));
constexpr int BM = 256, BK = 64, HALF = 128, HTB = HALF * BK * 2  , STAGE_BYTES = 8 * HTB, NXCD = 8, WGM = 8;

__host__ __device__ __forceinline__ int lds_byte(int r, int c) { const int st = (r >> 4) * 2 + (c >> 5), rr = r & 15, cc = c & 31, ob = rr * 64 + cc * 2; return st * 1024 + (ob ^ (((ob >> 9) & 1) << 5)); }
__host__ __device__ __forceinline__ void stage_rc(int b, int& R, int& C) { const int st = b / 1024, sb = b % 1024, swz = sb ^ (((sb >> 9) & 1) << 5); R = (st >> 1) * 16 + swz / 64; C = (st & 1) * 32 + (swz % 64) / 2; }
__host__ __device__ __forceinline__ int perm32(int rho) { const int n = rho >> 4, i = rho & 15; return 8 * (i >> 2) + 4 * n + (i & 3); }

struct Unit { int pm, pn, r0, nr, lb; };
struct Gemm { const bf16_t* A; const bf16_t* Bt; int M, N, K; };

struct StaticOrder {
    int nM, nN, nwg, G, c;
    __host__ __device__ void init(int M, int N, int G_, int c_) { nM = M / BM; nN = N / BM; nwg = nM * nN; G = G_; c = c_; }
    __host__ __device__ bool next(int i, Unit& u) const {
        const long L = (long)i * G + c; if (L >= nwg) return false;
        int wgid = (int)L; { const int q = nwg / NXCD, r = nwg % NXCD, xcd = wgid % NXCD, off = wgid / NXCD; wgid = (xcd < r ? xcd * (q + 1) : r * (q + 1) + (xcd - r) * q) + off; }
        const int nig = WGM * nN, gid = wgid / nig, fm = gid * WGM, gsz = (nM - fm) < WGM ? (nM - fm) : WGM;
        u.pm = fm + ((wgid % nig) % gsz); u.pn = (wgid % nig) / gsz; u.r0 = u.pm * BM; u.nr = BM; u.lb = 0; return true;
    }
    __device__ __forceinline__ void a_ready(const Unit&) const {}
    __device__ __forceinline__ void done(const Unit&) const {}
    static constexpr bool GATHER = false;
    __device__ __forceinline__ unsigned gather_voff(const Unit&, int, int, int) const { return 0u; }
};
__device__ __forceinline__ unsigned cvt_pk_bf16(float lo, float hi) { unsigned r; asm volatile("v_cvt_pk_bf16_f32 %0, %1, %2" : "=v"(r) : "v"(lo), "v"(hi)); return r; }
template <class Epi, class Sched, bool ALIGN_EPI = false, bool SP2 = false>
__device__ __forceinline__ void gemm_phase(PG8_LAS unsigned char* lds, const Gemm g, const Sched& S, const Epi& E) {
    int tid_ = threadIdx.x; asm volatile("" : "+v"(tid_));
    const int tid = tid_, wid = __builtin_amdgcn_readfirstlane(tid >> 6), lane = tid & 63, wr = wid >> 2, wc = wid & 3, fr = lane & 15, fq = lane >> 4;
    const int K = g.K, nt = K / BK;
    unsigned voffA[2], voffB[2]; int Rl[2], Cl[2];
#pragma unroll
    for (int i = 0; i < 2; ++i) { int R, C; stage_rc(tid * 16 + i * 8192, R, C); const int Rb = Epi::PERM ? ((R & ~31) + perm32(R & 31)) : R;
        Rl[i] = R; Cl[i] = C * 2; voffA[i] = (unsigned)(R * K + C) * 2u; voffB[i] = (unsigned)(Rb * K + C) * 2u; }
    const size_t kstep = (size_t)(BK * 2);
    const size_t hstep = (size_t)HALF * K * 2;
    const size_t tstep = 2 * hstep;
    const unsigned ldsw = (unsigned)wid * 1024u;
    const int aoff = lds_byte(wr * 64 + fr, fq * 8), boff = lds_byte(wc * 32 + fr, fq * 8);
#define PG8_SA(b, h) (((b) * 2 + (h)) * HTB)
#define PG8_SB(b, h) ((4 + (b) * 2 + (h)) * HTB)
#define PG8_STAGE(bufoff, gbase, voff) do { _Pragma("unroll") for (int _i = 0; _i < 2; ++_i) \
        __builtin_amdgcn_global_load_lds((const unsigned*)((const char*)(gbase) + (voff)[_i]), (PG8_LAS unsigned*)(lds + (bufoff) + ldsw + _i * 8192), 16, 0, 0); } while (0)
#define PG8_LDA(dst, b, h) do { _Pragma("unroll") for (int m = 0; m < 4; ++m) _Pragma("unroll") for (int k = 0; k < 2; ++k) dst[m][k] = *(const PG8_LAS bf16x8*)(lds + PG8_SA(b, h) + aoff + m * 2048 + k * 1024); } while (0)
#define PG8_LDB(dst, b, h) do { _Pragma("unroll") for (int n = 0; n < 2; ++n) _Pragma("unroll") for (int k = 0; k < 2; ++k) dst[n][k] = *(const PG8_LAS bf16x8*)(lds + PG8_SB(b, h) + boff + n * 2048 + k * 1024); } while (0)
#define PG8_MMA(ai, bj, At, Bt) do { __builtin_amdgcn_s_setprio(1); _Pragma("unroll") for (int m = 0; m < 4; ++m) _Pragma("unroll") for (int n = 0; n < 2; ++n) _Pragma("unroll") for (int k = 0; k < 2; ++k) \
        acc[ai][bj][m][n] = __builtin_amdgcn_mfma_f32_16x16x32_bf16(Bt[n][k], At[m][k], acc[ai][bj][m][n], 0, 0, 0); __builtin_amdgcn_s_setprio(0); } while (0)
#define PG8_WAIT_V(n) asm volatile("s_waitcnt vmcnt(" #n ")" ::: "memory")
#define PG8_WAIT_L(n) asm volatile("s_waitcnt lgkmcnt(" #n ")" ::: "memory")
#define PG8_BAR __builtin_amdgcn_s_barrier()
#define PG8_SCHED __builtin_amdgcn_sched_barrier(0)
    Unit cur, nxt; int ui = 0;
    if (!S.next(0, cur)) return;
    f32x4 acc[2][2][4][2];
#pragma unroll
    for (int a = 0; a < 2; ++a)
#pragma unroll
        for (int b = 0; b < 2; ++b)
#pragma unroll
            for (int m = 0; m < 4; ++m)
#pragma unroll
                for (int n = 0; n < 2; ++n) acc[a][b][m][n] = (f32x4){0.f, 0.f, 0.f, 0.f};
    bf16x8 At[4][2], B0[2][2], B1[2][2];
    constexpr bool GA = Sched::GATHER;
    const char* cA = GA ? (const char*)g.A : (const char*)g.A + (size_t)cur.r0 * (size_t)(K * 2); const char* cB = (const char*)g.Bt + (size_t)cur.pn * tstep;
    unsigned vAc[2][2], vAn[2][2];
#pragma unroll
    for (int h = 0; h < 2; ++h)
#pragma unroll
        for (int i = 0; i < 2; ++i) { vAc[h][i] = GA ? S.gather_voff(cur, h * HALF + Rl[i], Cl[i], K) : voffA[i] + (unsigned)(h * HALF * K * 2); vAn[h][i] = vAc[h][i]; }
#define PG8_VA(h) ((GA && last) ? vAn[h] : vAc[h])
    S.a_ready(cur);
    if constexpr (SP2) {
        PG8_STAGE(PG8_SB(0, 0), cB, voffB); PG8_STAGE(PG8_SB(0, 1), cB + hstep, voffB); PG8_STAGE(PG8_SA(0, 0), cA, vAc[0]); PG8_STAGE(PG8_SA(0, 1), cA, vAc[1]);
        if (wr == 1) PG8_BAR;
        PG8_WAIT_V(2); PG8_BAR;
        PG8_STAGE(PG8_SB(1, 0), cB + kstep, voffB); PG8_STAGE(PG8_SA(1, 0), cA + kstep, vAc[0]); PG8_STAGE(PG8_SB(1, 1), cB + hstep + kstep, voffB);
        PG8_WAIT_V(6); PG8_BAR;
    } else {
        PG8_STAGE(PG8_SB(0, 0), cB, voffB); PG8_STAGE(PG8_SA(0, 0), cA, voffA); PG8_STAGE(PG8_SB(0, 1), cB + hstep, voffB); PG8_STAGE(PG8_SA(0, 1), cA + hstep, voffA);
        if (wr == 1) PG8_BAR;
        PG8_WAIT_V(4); PG8_BAR;
        PG8_STAGE(PG8_SB(1, 0), cB + kstep, voffB); PG8_STAGE(PG8_SA(1, 0), cA + kstep, voffA); PG8_STAGE(PG8_SB(1, 1), cB + hstep + kstep, voffB);
        PG8_WAIT_V(6); PG8_BAR;
    }
    for (;;) {
        const bool has_next = S.next(ui + 1, nxt);
        const char* nA = GA ? cA : (has_next ? (const char*)g.A + (size_t)nxt.r0 * (size_t)(K * 2) : cA); const char* nB = has_next ? (const char*)g.Bt + (size_t)nxt.pn * tstep : cB;
        for (int t = 0; t < nt; t += 2) {
            const bool last = (t == nt - 2);
            const char* a1 = cA + (size_t)(t + 1) * kstep;
            const char* a2 = last ? nA : cA + (size_t)(t + 2) * kstep; const char* b2 = last ? nB : cB + (size_t)(t + 2) * kstep;
            const char* a3 = a2 + kstep; const char* b3 = b2 + kstep;
            if (last && has_next) { S.a_ready(nxt);
                if constexpr (GA) {
#pragma unroll
                    for (int h = 0; h < 2; ++h)
#pragma unroll
                        for (int i = 0; i < 2; ++i) vAn[h][i] = S.gather_voff(nxt, h * HALF + Rl[i], Cl[i], K); } }
            else if (GA && last) {
#pragma unroll
                for (int h = 0; h < 2; ++h)
#pragma unroll
                    for (int i = 0; i < 2; ++i) vAn[h][i] = vAc[h][i]; }
            if constexpr (SP2) {
            PG8_LDB(B0, 0, 0); PG8_LDB(B1, 0, 1); PG8_SCHED; PG8_LDA(At, 0, 0); PG8_STAGE(PG8_SA(1, 1), a1, vAc[1]);
            PG8_WAIT_V(8); PG8_WAIT_L(0); PG8_BAR; PG8_MMA(0, 0, At, B0); PG8_MMA(0, 1, At, B1); PG8_BAR; PG8_SCHED;
            PG8_LDA(At, 0, 1); PG8_STAGE(PG8_SB(0, 0), b2, voffB); PG8_STAGE(PG8_SB(0, 1), b2 + hstep, voffB); PG8_STAGE(PG8_SA(0, 0), a2, PG8_VA(0));
            PG8_WAIT_V(8); PG8_WAIT_L(0); PG8_BAR; PG8_MMA(1, 0, At, B0); PG8_MMA(1, 1, At, B1); PG8_BAR; PG8_SCHED;
            PG8_LDB(B0, 1, 0); PG8_LDB(B1, 1, 1); PG8_SCHED; PG8_LDA(At, 1, 0); PG8_STAGE(PG8_SA(0, 1), a2, PG8_VA(1));
            PG8_WAIT_V(8); PG8_WAIT_L(0); PG8_BAR; PG8_MMA(0, 0, At, B0); PG8_MMA(0, 1, At, B1); PG8_BAR; PG8_SCHED;
            PG8_LDA(At, 1, 1); PG8_STAGE(PG8_SB(1, 0), b3, voffB); PG8_STAGE(PG8_SB(1, 1), b3 + hstep, voffB); PG8_STAGE(PG8_SA(1, 0), a3, PG8_VA(0));
            PG8_WAIT_V(8); PG8_WAIT_L(0); PG8_BAR; PG8_MMA(1, 0, At, B0); PG8_MMA(1, 1, At, B1); PG8_BAR; PG8_SCHED;
            } else {
            PG8_LDB(B0, 0, 0); PG8_SCHED; PG8_LDA(At, 0, 0); PG8_STAGE(PG8_SA(1, 1), a1 + hstep, voffA);
            PG8_WAIT_L(8); PG8_BAR; PG8_WAIT_L(0); PG8_MMA(0, 0, At, B0); PG8_BAR; PG8_SCHED;
            PG8_LDB(B1, 0, 1); PG8_STAGE(PG8_SB(0, 0), b2, voffB);
            PG8_BAR; PG8_WAIT_L(0); PG8_MMA(0, 1, At, B1); PG8_BAR;
            PG8_LDA(At, 0, 1); PG8_STAGE(PG8_SA(0, 0), a2, voffA);
            PG8_BAR; PG8_WAIT_L(0); PG8_MMA(1, 0, At, B0); PG8_BAR; PG8_SCHED;
            PG8_STAGE(PG8_SB(0, 1), b2 + hstep, voffB);
            PG8_WAIT_V(6); PG8_BAR; PG8_MMA(1, 1, At, B1); PG8_BAR;
            PG8_LDB(B0, 1, 0); PG8_SCHED; PG8_LDA(At, 1, 0); PG8_STAGE(PG8_SA(0, 1), a2 + hstep, voffA);
            PG8_WAIT_L(8); PG8_BAR; PG8_WAIT_L(0); PG8_MMA(0, 0, At, B0); PG8_BAR; PG8_SCHED;
            PG8_LDB(B1, 1, 1); PG8_STAGE(PG8_SB(1, 0), b3, voffB);
            PG8_BAR; PG8_WAIT_L(0); PG8_MMA(0, 1, At, B1); PG8_BAR;
            PG8_LDA(At, 1, 1); PG8_STAGE(PG8_SA(1, 0), a3, voffA);
            PG8_BAR; PG8_WAIT_L(0); PG8_MMA(1, 0, At, B0); PG8_BAR; PG8_SCHED;
            PG8_STAGE(PG8_SB(1, 1), b3 + hstep, voffB);
            PG8_WAIT_V(6); PG8_BAR; PG8_MMA(1, 1, At, B1); PG8_BAR;
            }
        }
        if constexpr (ALIGN_EPI) { if (wr == 0) PG8_BAR; }
        if constexpr (!Epi::AFTER_DRAIN) { E(acc, cur, wr, wc, fr, fq); S.done(cur); }
        if (!has_next) break;
#pragma unroll
        for (int a = 0; a < 2; ++a)
#pragma unroll
            for (int b = 0; b < 2; ++b)
#pragma unroll
                for (int m = 0; m < 4; ++m)
#pragma unroll
                    for (int n = 0; n < 2; ++n) acc[a][b][m][n] = (f32x4){0.f, 0.f, 0.f, 0.f};
        cur = nxt; cA = nA; cB = nB; ++ui;
#pragma unroll
        for (int h = 0; h < 2; ++h)
#pragma unroll
            for (int i = 0; i < 2; ++i) vAc[h][i] = vAn[h][i];
        if constexpr (ALIGN_EPI) { if (wr == 1) PG8_BAR; }
    }
    PG8_WAIT_V(0);
    if constexpr (!ALIGN_EPI) { if (wr == 0) PG8_BAR; }
    PG8_BAR;
    if constexpr (Epi::AFTER_DRAIN) { E.fused(acc, cur, wr, wc, fr, fq, lds, wid, lane); S.done(cur); }
#undef PG8_SA
#undef PG8_VA
#undef PG8_SB
#undef PG8_STAGE
#undef PG8_LDA
#undef PG8_LDB
#undef PG8_MMA
#undef PG8_WAIT_V
#undef PG8_WAIT_L
#undef PG8_BAR
#undef PG8_SCHED
}
}
#define GAS __attribute__((address_space(1)))
#define LAS __attribute__((address_space(3)))
typedef float f32x4 __attribute__((ext_vector_type(4)));
typedef short bf16x8 __attribute__((ext_vector_type(8)));
constexpr int NWAVES = 8, NTHREADS = 512;
constexpr int LDS_BYTES = 163840, LDSCTL_OFF = LDS_BYTES - 4096, RING_BYTES = LDSCTL_OFF;
constexpr int LDS_TILETAB = LDSCTL_OFF + 256;

#define XB_TMO      128
#define XB_XCNT(j)  (256  + 64 * (j))
#define XB_XSUB(j)  (1280 + 64 * (j))
#define XB_XGEN(j)  (2304 + 64 * (j))
#define XB_TOP      3328
#define XB_TOPGEN   3392
#define XCD_BAR_WORDS 3456
#define XB_SPIN_CAP (1u << 18)
__device__ __forceinline__ unsigned xb_ld(unsigned* p)              { return __hip_atomic_load(p, __ATOMIC_RELAXED, __HIP_MEMORY_SCOPE_AGENT); }
__device__ __forceinline__ unsigned xb_add(unsigned* p, unsigned v) { return __hip_atomic_fetch_add(p, v, __ATOMIC_RELAXED, __HIP_MEMORY_SCOPE_AGENT); }
__device__ __forceinline__ unsigned xb_xcc_id() { return (unsigned)__builtin_amdgcn_s_getreg((3 << 11) | 20) & 0xFu; }
#define XB_SPIN(cond, bar) do { unsigned _sp = 0; while (cond) { __builtin_amdgcn_s_sleep(1); \
    if ((++_sp & 255u) == 0u) { if (xb_ld(&(bar)[XB_TMO])) break; if (_sp > XB_SPIN_CAP) { atomicAdd(&(bar)[XB_TMO], 1u); break; } } } } while (0)
struct XcdBarrier { unsigned* bar; unsigned x; volatile LAS unsigned* st; };
__device__ __forceinline__ XcdBarrier xcd_barrier_post(unsigned* bar, volatile LAS unsigned* st) {
    XcdBarrier b; b.bar = bar; b.x = xb_xcc_id(); b.st = st;
    if (threadIdx.x == 0) (void)xb_add(&bar[XB_XCNT(b.x)], 1u);
    return b;
}
__device__ __forceinline__ void xcd_barrier_complete(unsigned* bar, unsigned x, unsigned& nloc, unsigned& nx) {
    const unsigned G = gridDim.x * gridDim.y * gridDim.z;
    unsigned sum, cnt, mine, sp = 0u;
    for (;;) {
        sum = 0u; cnt = 0u; mine = 0u;
#pragma unroll
        for (unsigned j = 0; j < 16; ++j) { const unsigned c = xb_ld(&bar[XB_XCNT(j)]); sum += c; cnt += (c > 0u) ? 1u : 0u; mine = (j == x) ? c : mine; }
        if (sum == G) break;
        __builtin_amdgcn_s_sleep(1);
        if ((++sp & 255u) == 0u) { if (xb_ld(&bar[XB_TMO])) break; if (sp > XB_SPIN_CAP) { atomicAdd(&bar[XB_TMO], 1u); break; } }
    }
    nloc = mine > 0u ? mine : 1u; nx = cnt > 0u ? cnt : 1u;
}
__device__ __forceinline__ void xcd_barrier(const XcdBarrier& b) {
    asm volatile("s_waitcnt vmcnt(0)" ::: "memory");
    __syncthreads();
    if (threadIdx.x == 0) {
        unsigned* bar = b.bar;
        __builtin_amdgcn_s_waitcnt(0);
        unsigned nloc = b.st[0], nx = b.st[1];
        if (nloc == 0u) { xcd_barrier_complete(bar, b.x, nloc, nx); b.st[0] = nloc; b.st[1] = nx; }
        const unsigned old = xb_add(&bar[XB_XSUB(b.x)], 1u);
        const unsigned gen = old / nloc;
        if (old + 1u == (gen + 1u) * nloc) {
            __builtin_amdgcn_fence(__ATOMIC_RELEASE, "agent");
            asm volatile("s_waitcnt vmcnt(0)" ::: "memory");
            const unsigned og = xb_add(&bar[XB_TOP], 1u);
            const unsigned tg = og / nx;
            if (og + 1u == (tg + 1u) * nx) xb_add(&bar[XB_TOPGEN], 1u);
            else XB_SPIN(xb_ld(&bar[XB_TOPGEN]) == tg, bar);
            __builtin_amdgcn_fence(__ATOMIC_ACQUIRE, "agent");
            xb_add(&bar[XB_XGEN(b.x)], 1u);
            asm volatile("s_waitcnt vmcnt(0)" ::: "memory");
        } else {
            XB_SPIN(xb_ld(&bar[XB_XGEN(b.x)]) == gen, bar);
            __builtin_amdgcn_fence(__ATOMIC_ACQUIRE, "agent");
            asm volatile("s_waitcnt vmcnt(0)" ::: "memory");
        }
    }
    __syncthreads();
}

struct Ctx { LAS unsigned char* lds; int tid, lane, wave, vcu, G, gw, ngw; };
__device__ __forceinline__ Ctx refresh(const Ctx& C0) { Ctx C = C0; int t = threadIdx.x; asm volatile("" : "+v"(t)); C.tid = t; C.lane = t & 63; C.wave = __builtin_amdgcn_readfirstlane(t >> 6); C.gw = C.vcu * 8 + C.wave; return C; }

using pg8::cvt_pk_bf16;
struct EpiStoreBf16 {
    static constexpr bool PERM = false, AFTER_DRAIN = false;
    bf16_t* O; int ldc;
    __device__ __forceinline__ void operator()(const f32x4 (&acc)[2][2][4][2], const pg8::Unit& u, int wr, int wc, int fr, int fq) const {
        const int row0 = u.r0 + wr * 64 + fr, col0 = u.pn * 256 + wc * 32 + 4 * fq;
#pragma unroll
        for (int ai = 0; ai < 2; ++ai)
#pragma unroll
            for (int m = 0; m < 4; ++m) { bf16_t* rowp = (bf16_t*)((char*)O + ((unsigned)(row0 + ai * 128 + m * 16) * (unsigned)(ldc * 2) + (unsigned)(col0 * 2)));
#pragma unroll
                for (int bj = 0; bj < 2; ++bj)
#pragma unroll
                    for (int n = 0; n < 2; ++n) { const f32x4 v = acc[ai][bj][m][n]; uint2 w; w.x = cvt_pk_bf16(v[0], v[1]); w.y = cvt_pk_bf16(v[2], v[3]); *(uint2*)(rowp + bj * 128 + n * 16) = w; } }
    }
};
struct EpiGlu {
    static constexpr bool PERM = false, AFTER_DRAIN = false;
    const bf16_t* Z; const float* bglu; bf16_t* Y;
    __device__ __forceinline__ void operator()(const f32x4 (&acc)[2][2][4][2], const pg8::Unit& u, int wr, int wc, int fr, int fq) const {
        const int row0 = u.r0 + wr * 64 + fr, col0 = u.pn * 256 + wc * 32 + 4 * fq;
#pragma unroll
        for (int bj = 0; bj < 2; ++bj)
#pragma unroll
            for (int n = 0; n < 2; ++n) { const int c = col0 + bj * 128 + n * 16; const f32x4 bv = *(const f32x4*)(bglu + c);
#pragma unroll
                for (int ai = 0; ai < 2; ++ai)
#pragma unroll
                    for (int m = 0; m < 4; ++m) { const size_t r = (size_t)(row0 + ai * 128 + m * 16); const uint2 zz = *(const uint2*)(Z + r * S5W + c);
                        const f32x4 v = acc[ai][bj][m][n] + bv;
                        const float z0 = __uint_as_float(zz.x << 16), z1 = __uint_as_float(zz.x & 0xffff0000u), z2 = __uint_as_float(zz.y << 16), z3 = __uint_as_float(zz.y & 0xffff0000u);
                        uint2 w; w.x = cvt_pk_bf16(z0 * sigmoidf_(v[0]), z1 * sigmoidf_(v[1])); w.y = cvt_pk_bf16(z2 * sigmoidf_(v[2]), z3 * sigmoidf_(v[3]));
                        *(uint2*)(Y + r * D + c) = w; } }
    }
};
struct EpiResid {
    static constexpr bool PERM = false, AFTER_DRAIN = false;
    float* H;
    __device__ __forceinline__ void operator()(const f32x4 (&acc)[2][2][4][2], const pg8::Unit& u, int wr, int wc, int fr, int fq) const {
        const int row0 = u.r0 + wr * 64 + fr, col0 = u.pn * 256 + wc * 32 + 4 * fq;
#pragma unroll
        for (int ai = 0; ai < 2; ++ai)
#pragma unroll
            for (int m = 0; m < 4; ++m) { float* rowp = (float*)((char*)H + ((unsigned)(row0 + ai * 128 + m * 16) * (unsigned)(D * 4) + (unsigned)(col0 * 4)));
#pragma unroll
                for (int bj = 0; bj < 2; ++bj)
#pragma unroll
                    for (int n = 0; n < 2; ++n) { f32x4* q = (f32x4*)(rowp + bj * 128 + n * 16); *q = *q * DN_ALPHA + acc[ai][bj][m][n]; } }
    }
};
struct EpiMoe1 {
    static constexpr bool PERM = false, AFTER_DRAIN = false;
    bf16_t* HH; const int* list; const float* tokw;
    __device__ __forceinline__ void operator()(const f32x4 (&acc)[2][2][4][2], const pg8::Unit& u, int wr, int wc, int fr, int fq) const {
        const int f0 = (u.pn & 1) * 128 + wc * 32 + 4 * fq;
#pragma unroll
        for (int ai = 0; ai < 2; ++ai)
#pragma unroll
            for (int m = 0; m < 4; ++m) { const int lr = ai * 128 + wr * 64 + m * 16 + fr;
                if (lr < u.nr) { const unsigned r = (unsigned)(u.r0 + lr); const float w = tokw[list[u.lb + lr]];
#pragma unroll
                    for (int n = 0; n < 2; ++n) { const f32x4 g = acc[ai][0][m][n], up = acc[ai][1][m][n];
                        uint2 o; o.x = cvt_pk_bf16(siluf_(g[0]) * up[0] * w, siluf_(g[1]) * up[1] * w); o.y = cvt_pk_bf16(siluf_(g[2]) * up[2] * w, siluf_(g[3]) * up[3] * w);
                        *(uint2*)((char*)HH + (r * (unsigned)(MOE_FF * 2) + (unsigned)((f0 + n * 16) * 2))) = o; } } }
    }
};
struct EpiMoe2 {
    static constexpr bool PERM = false, AFTER_DRAIN = false;
    bf16_t* YS;
    __device__ __forceinline__ void operator()(const f32x4 (&acc)[2][2][4][2], const pg8::Unit& u, int wr, int wc, int fr, int fq) const {
        const int col0 = (u.pn & 7) * 256 + wc * 32 + 4 * fq;
#pragma unroll
        for (int ai = 0; ai < 2; ++ai)
#pragma unroll
            for (int m = 0; m < 4; ++m) { const int lr = ai * 128 + wr * 64 + m * 16 + fr; const int row = (lr < u.nr) ? (u.r0 + lr) : (XS_ROWS - 1);
                bf16_t* rowp = (bf16_t*)((char*)YS + ((unsigned)row * (unsigned)(D * 2) + (unsigned)(col0 * 2)));
#pragma unroll
                for (int bj = 0; bj < 2; ++bj)
#pragma unroll
                    for (int n = 0; n < 2; ++n) { const f32x4 v = acc[ai][bj][m][n]; uint2 w; w.x = cvt_pk_bf16(v[0], v[1]); w.y = cvt_pk_bf16(v[2], v[3]); *(uint2*)(rowp + bj * 128 + n * 16) = w; } }
    }
};
struct MoeOrder {
    static constexpr bool GATHER = false;
    __device__ __forceinline__ unsigned gather_voff(const pg8::Unit&, int, int, int) const { return 0u; }
    const volatile LAS int* tab; int ntiles, npn, G, c;
    __device__ __forceinline__ bool next(int i, pg8::Unit& u) const {
        const int L = i * G + c; if (L >= ntiles * npn) return false;
        const int t = L / npn, pn = L % npn;
        u.pm = t; u.pn = __builtin_amdgcn_readfirstlane(tab[t]) * npn + pn; u.r0 = __builtin_amdgcn_readfirstlane(tab[176 + t]); u.nr = __builtin_amdgcn_readfirstlane(tab[352 + t]); u.lb = 0; return true;
    }
    __device__ __forceinline__ void a_ready(const pg8::Unit&) const {}
    __device__ __forceinline__ void done(const pg8::Unit&) const {}
};
struct MoeGatherOrder {
    static constexpr bool GATHER = true;
    const volatile LAS int* tab; int ntiles, npn, G, c; const int* list;
    __device__ __forceinline__ bool next(int i, pg8::Unit& u) const {
        const int L = i * G + c; if (L >= ntiles * npn) return false;
        const int t = L / npn, pn = L % npn;
        u.pm = t; u.pn = __builtin_amdgcn_readfirstlane(tab[t]) * npn + pn; u.r0 = __builtin_amdgcn_readfirstlane(tab[176 + t]); u.nr = __builtin_amdgcn_readfirstlane(tab[352 + t]); u.lb = __builtin_amdgcn_readfirstlane(tab[704 + t]); return true;
    }
    __device__ __forceinline__ unsigned gather_voff(const pg8::Unit& u, int lr, int c2, int K) const {
        const int entry = (lr < u.nr) ? list[u.lb + lr] : 0;
        return (unsigned)((entry >> 1) * (K * 2) + c2);
    }
    __device__ __forceinline__ void a_ready(const pg8::Unit&) const {}
    __device__ __forceinline__ void done(const pg8::Unit&) const {}
};
__device__ __forceinline__ int moe_build_tiles(const Ctx& C0, unsigned* cnt) {
    const Ctx C = refresh(C0);
    volatile LAS int* tab = (volatile LAS int*)(C.lds + LDS_TILETAB);
    __syncthreads();
    if (C.tid == 0) { int nt = 0, off = 0;
        for (int e = 0; e < MOE_NE; ++e) { const int c = (int)xb_ld(cnt + e);
            for (int r = 0; r < c; r += 256) { tab[nt] = e; tab[176 + nt] = off + r; tab[352 + nt] = (c - r) < 256 ? (c - r) : 256; tab[704 + nt] = e * MROWS + r; ++nt; }
            off += c; }
        tab[528] = nt; }
    __syncthreads();
    return __builtin_amdgcn_readfirstlane(tab[528]);
}

__device__ __forceinline__ void split8(const f32x4 a0, const f32x4 a1, bf16x8& hi, bf16x8& lo) {
    float x[8] = {a0[0], a0[1], a0[2], a0[3], a1[0], a1[1], a1[2], a1[3]};
#pragma unroll
    for (int j = 0; j < 8; ++j) { const unsigned h = f2bf(x[j]); hi[j] = (short)h; lo[j] = (short)f2bf(x[j] - __uint_as_float(h << 16)); }
}
template <int NT> __device__ __forceinline__ void skinny3_tile(const float* Hr0, const bf16_t* Bhi, const bf16_t* Blo, f32x4 (&acc)[NT], int lane, int kb = 0, int ke = D) {
    const int fr = lane & 15, fq = lane >> 4;
#pragma unroll
    for (int nt = 0; nt < NT; ++nt) acc[nt] = (f32x4){0.f, 0.f, 0.f, 0.f};
    const float* ap = Hr0 + (size_t)fr * D + 8 * fq;
    const bf16_t* bh = Bhi + (size_t)fr * D + 8 * fq; const bf16_t* bl = Blo + (size_t)fr * D + 8 * fq;
#pragma unroll 4
    for (int k0 = kb; k0 < ke; k0 += 32) {
        bf16x8 ahi, alo; split8(*(const f32x4*)(ap + k0), *(const f32x4*)(ap + k0 + 4), ahi, alo);
#pragma unroll
        for (int nt = 0; nt < NT; ++nt) { const bf16x8 wh = *(const bf16x8*)(bh + (size_t)nt * 16 * D + k0), wl = *(const bf16x8*)(bl + (size_t)nt * 16 * D + k0);
            acc[nt] = __builtin_amdgcn_mfma_f32_16x16x32_bf16(ahi, wh, acc[nt], 0, 0, 0);
            acc[nt] = __builtin_amdgcn_mfma_f32_16x16x32_bf16(ahi, wl, acc[nt], 0, 0, 0);
            acc[nt] = __builtin_amdgcn_mfma_f32_16x16x32_bf16(alo, wh, acc[nt], 0, 0, 0); }
    }
}
constexpr int SKW_LD = 264;
template <int NT> __device__ __forceinline__ void wg_skinny(const Ctx& C, const float* H, const int (&rb)[4], const bf16_t* Bhi, const bf16_t* Blo, f32x4 (&acc)[NT]) {
    const int lane = C.lane, fr = lane & 15, fq = lane >> 4, tid = C.tid;
    LAS bf16_t* AH = (LAS bf16_t*)(C.lds + 36864); LAS bf16_t* AL = AH + 64 * SKW_LD; LAS bf16_t* BH = AL + 64 * SKW_LD; LAS bf16_t* BL = BH + NT * 16 * SKW_LD;
#pragma unroll
    for (int nt = 0; nt < NT; ++nt) acc[nt] = (f32x4){0.f, 0.f, 0.f, 0.f};
    const int ti = C.wave >> 1, kp = C.wave & 1;
    for (int kc = 0; kc < D; kc += 256) {
        __syncthreads();
        f32x4 av[8];
#pragma unroll
        for (int i = 0; i < 8; ++i) { const int idx = tid + NTHREADS * i, row = idx >> 6, c4 = (idx & 63) * 4; av[i] = *(const f32x4*)(H + (size_t)(rb[row >> 4] + (row & 15)) * D + kc + c4); }
        constexpr int NBV = NT * 16 * 32;
        v4u bhv[(NBV + NTHREADS - 1) / NTHREADS], blv[(NBV + NTHREADS - 1) / NTHREADS];
#pragma unroll
        for (int i = 0; i < (NBV + NTHREADS - 1) / NTHREADS; ++i) { const int idx = tid + NTHREADS * i;
            if (idx < NBV) { const int row = idx >> 5, c8 = (idx & 31) * 8; bhv[i] = *(const v4u*)(Bhi + (size_t)row * D + kc + c8); blv[i] = *(const v4u*)(Blo + (size_t)row * D + kc + c8); } }
#pragma unroll
        for (int i = 0; i < 8; ++i) { const int idx = tid + NTHREADS * i, row = idx >> 6, c4 = (idx & 63) * 4;
            const unsigned h01 = pk2(av[i][0], av[i][1]), h23 = pk2(av[i][2], av[i][3]);
            const unsigned l01 = pk2(av[i][0] - __uint_as_float(h01 << 16), av[i][1] - __uint_as_float(h01 & 0xffff0000u)), l23 = pk2(av[i][2] - __uint_as_float(h23 << 16), av[i][3] - __uint_as_float(h23 & 0xffff0000u));
            *(LAS v2u*)(AH + row * SKW_LD + c4) = (v2u){h01, h23}; *(LAS v2u*)(AL + row * SKW_LD + c4) = (v2u){l01, l23}; }
#pragma unroll
        for (int i = 0; i < (NBV + NTHREADS - 1) / NTHREADS; ++i) { const int idx = tid + NTHREADS * i;
            if (idx < NBV) { const int row = idx >> 5, c8 = (idx & 31) * 8; *(LAS v4u*)(BH + row * SKW_LD + c8) = bhv[i]; *(LAS v4u*)(BL + row * SKW_LD + c8) = blv[i]; } }
        __syncthreads();
#pragma unroll
        for (int k4 = 0; k4 < 4; ++k4) { const int ko = (kp * 4 + k4) * 32 + 8 * fq;
            const bf16x8 ahi = *(const LAS bf16x8*)(AH + (ti * 16 + fr) * SKW_LD + ko), alo = *(const LAS bf16x8*)(AL + (ti * 16 + fr) * SKW_LD + ko);
#pragma unroll
            for (int nt = 0; nt < NT; ++nt) { const bf16x8 wh = *(const LAS bf16x8*)(BH + (nt * 16 + fr) * SKW_LD + ko), wl = *(const LAS bf16x8*)(BL + (nt * 16 + fr) * SKW_LD + ko);
                acc[nt] = __builtin_amdgcn_mfma_f32_16x16x32_bf16(ahi, wh, acc[nt], 0, 0, 0);
                acc[nt] = __builtin_amdgcn_mfma_f32_16x16x32_bf16(ahi, wl, acc[nt], 0, 0, 0);
                acc[nt] = __builtin_amdgcn_mfma_f32_16x16x32_bf16(alo, wh, acc[nt], 0, 0, 0); } }
    }
    __syncthreads();
}
struct Args { Ptrs p; int ph_lo, ph_hi, li, pad; };
typedef const __attribute__((address_space(4))) Args* KA;
typedef const __attribute__((address_space(4))) Ptrs* KP;
__device__ __forceinline__ KA kargs() { KA q = (KA)__builtin_amdgcn_kernarg_segment_ptr(); asm volatile("" : "+s"(q)); return q; }
__device__ __forceinline__ KP kp() { return &kargs()->p; }
__device__ __forceinline__ bool in_ph(int k) { KA a = kargs(); return a->ph_lo <= k && k < a->ph_hi; }
__device__ __forceinline__ void cvt_tile64(const float* src  , size_t ldw, bf16_t* dst  , size_t ldt, LAS bf16_t* T  , int lane) {
    const int r = lane >> 4, c4 = (lane & 15) * 4;
    f32x4 v[16];
#pragma unroll
    for (int i = 0; i < 16; ++i) v[i] = *(const f32x4*)(src + (size_t)(4 * i + r) * ldw + c4);
#pragma unroll
    for (int i = 0; i < 16; ++i) { const int k = 4 * i + r;
        T[(c4 + 0) * 72 + k] = (bf16_t)f2bf(v[i][0]); T[(c4 + 1) * 72 + k] = (bf16_t)f2bf(v[i][1]); T[(c4 + 2) * 72 + k] = (bf16_t)f2bf(v[i][2]); T[(c4 + 3) * 72 + k] = (bf16_t)f2bf(v[i][3]); }
    asm volatile("s_waitcnt lgkmcnt(0)" ::: "memory");
#pragma unroll
    for (int j = 0; j < 8; ++j) { const int idx = lane + 64 * j, n = idx >> 3, kc = idx & 7;
        *(v4u*)(dst + (size_t)n * ldt + kc * 8) = *(const LAS v4u*)(T + n * 72 + kc * 8); }
    asm volatile("s_waitcnt lgkmcnt(0)" ::: "memory");
}
__device__ __forceinline__ void cvt_job_tile64(const CvtJob& j, int item, LAS bf16_t* T, int lane) {
    const int nblk = j.ncols / 64, kb = item / nblk, nb = item % nblk;
    cvt_tile64(j.src + (size_t)(64 * kb) * j.ldw + 64 * nb, j.ldw, j.dst + (size_t)(64 * nb) * j.ldt + 64 * kb, j.ldt, T, lane);
}
constexpr int CVT_MOE_TILES = MOE_NE * 384;
constexpr int CVT_STATIC_TILES = 2048 + 1024 + 1024 + 1024 + 256 + 16 * 4;
__device__ __forceinline__ void cvt_list_item(KP p, int list, int it, LAS bf16_t* T, int lane) {
    if (list == 0 && it < CVT_STATIC_TILES) {
        int j, r = it;
        if (r < 2048) j = 2; else if ((r -= 2048) < 1024) j = 3; else if ((r -= 1024) < 1024) j = 4; else if ((r -= 1024) < 1024) j = 5; else if ((r -= 1024) < 256) j = 6; else { r -= 256; j = 7 + (r >> 2); r &= 3; }
        cvt_job_tile64(static_job(p, j), r, T, lane);
    } else {
        if (list == 0) it -= CVT_STATIC_TILES;
        const int e = it / 384, r = it % 384, jj = r < 256 ? (r >> 6) : 4;
        cvt_job_tile64(moe_job(p, list, e * 5 + jj), r < 256 ? (r & 63) : (r - 256), T, lane);
    }
}
constexpr int CW_CVTQ = 32;
__device__ __forceinline__ void cvt_pull(const Ctx& C0, KP p, int list) {
    const Ctx C = refresh(C0);
    LAS bf16_t* T = (LAS bf16_t*)(C.lds + C.wave * 9216);
    unsigned* q = (unsigned*)(p->ws + WS_CTL) + CW_CVTQ + 16 * list;
    const int total = (list == 0) ? CVT_STATIC_TILES + CVT_MOE_TILES : CVT_MOE_TILES;
    constexpr int CVT_BATCH = 16;
    for (;;) {
        int it = 0; if (C.lane == 0) it = (int)atomicAdd(q, (unsigned)CVT_BATCH);
        it = __builtin_amdgcn_readfirstlane(it);
        if (it >= total) break;
        const int ie = (it + CVT_BATCH < total) ? it + CVT_BATCH : total;
        for (int k = it; k < ie; ++k) cvt_list_item(p, list, k, T, C.lane);
    }
}

__device__ __forceinline__ void ph_prologue(const Ctx& C0, KP p) {
    const Ctx C = refresh(C0);
    { LAS bf16_t* T = (LAS bf16_t*)(C.lds + C.wave * 9216);
      for (int j = 0; j < 2; ++j) { const CvtJob job = static_job(p, j); const int nit = (job.K / 64) * (job.ncols / 64);
          for (int it = C.gw; it < nit; it += C.ngw) cvt_job_tile64(job, it, T, C.lane); } }
    const size_t gt = (size_t)C.vcu * NTHREADS + C.tid, ngt = (size_t)C.G * NTHREADS;
    {
        float* H = (float*)(p->ws + WS_H); bf16_t* HB = (bf16_t*)(p->ws + WS_HB);
        const size_t n4 = (size_t)MP * D / 4;
        for (size_t i = gt; i < n4; i += ngt) {
            const int m = (int)(i / (D / 4)), c = (int)(i % (D / 4)) * 4;
            float4 v = make_float4(0.f, 0.f, 0.f, 0.f);
            if (m < MROWS) { const int b = m / LP, q = m % LP;
                if (q >= CHUNK) v = *(const float4*)(p->in[0] + ((size_t)b * SEQ + (q - CHUNK)) * D + c);
                else if (q >= PADF) v = *(const float4*)(p->in[1] + (size_t)(q - PADF) * D + c); }
            *(float4*)(H + (size_t)m * D + c) = v;
            uint2 o; o.x = pk2(v.x, v.y); o.y = pk2(v.z, v.w); *(uint2*)(HB + (size_t)m * D + c) = o;
        }
    }
    {
        bf16_t* WR = (bf16_t*)(p->ws + WS_WR); bf16_t* WK = (bf16_t*)(p->ws + WS_WSK3);
        for (size_t i = gt; i < (size_t)2 * 64 * D; i += ngt) { const int k = (int)(i % D), n = (int)((i / D) % 64), L = (int)(i / ((size_t)64 * D));
            if (n < 48) { const float x = n < 4 ? p->in[30][((size_t)L * D + k) * 4 + n] : (n < 36 ? p->in[32][((size_t)L * D + k) * 32 + (n - 4)] : 0.f);
                const unsigned h = f2bf(x); WR[((size_t)(L * 2 + 0) * 48 + n) * D + k] = (bf16_t)h; WR[((size_t)(L * 2 + 1) * 48 + n) * D + k] = (bf16_t)f2bf(x - __uint_as_float(h << 16)); }
            else { const int c = n - 48; const float x = L == 0 ? p->in[2][(size_t)k * 4112 + 3072 + c] : p->in[17][(size_t)k * 6160 + 4096 + c];
                const unsigned h = f2bf(x); WK[((size_t)(L * 2 + 0) * 16 + c) * D + k] = (bf16_t)h; WK[((size_t)(L * 2 + 1) * 16 + c) * D + k] = (bf16_t)f2bf(x - __uint_as_float(h << 16)); } }
    }
    if (gt < S5G * S5P) {
        const int i = (int)gt, g = i / S5P, pp = i % S5P;
        float* Cc = (float*)(p->ws + WS_S5C); bf16_t* Bb = (bf16_t*)(p->ws + WS_S5B);
        const float are = p->in[3][i], aim = p->in[4][i], dt = expf(p->in[5][g]);
        const float mag = expf(are * dt); float sn, cs; sincosf(aim * dt, &sn, &cs);
        const float br = mag * cs, bi = mag * sn;
        Cc[S5C_ABAR + 2 * i] = br; Cc[S5C_ABAR + 2 * i + 1] = bi;
        const float nr = br - 1.0f, ni = bi, den = are * are + aim * aim;
        const float zr = (nr * are + ni * aim) / den, zi = (ni * are - nr * aim) / den;
        for (int c = 0; c < S5C; ++c) { const float b_r = p->in[6][(size_t)i * S5C + c], b_i = p->in[7][(size_t)i * S5C + c];
            const float xr = b_r * zr - b_i * zi, xi = b_r * zi + b_i * zr;
            Cc[S5C_BBAR + ((size_t)i * S5C + c) * 2] = xr; Cc[S5C_BBAR + ((size_t)i * S5C + c) * 2 + 1] = xi;
            Bb[S5B_BR + (size_t)i * 16 + c] = (bf16_t)f2bf(xr); Bb[S5B_BI + (size_t)i * 16 + c] = (bf16_t)f2bf(xi);
            Bb[S5B_CM + ((size_t)g * 16 + c) * 128 + pp] = (bf16_t)f2bf(p->in[8][((size_t)g * 16 + c) * 64 + pp]);
            Bb[S5B_CM + ((size_t)g * 16 + c) * 128 + 64 + pp] = (bf16_t)f2bf(-p->in[9][((size_t)g * 16 + c) * 64 + pp]); }
    }
}
__device__ __forceinline__ void ph_cvt_moe(const Ctx& C0, KP p, int L) {
    const Ctx C = refresh(C0);
    float* scr = (float*)(C.lds + C.wave * 8448);
    for (int j = 0; j < MOE_NE * 5; ++j) { const CvtJob job = moe_job(p, L, j); const int nit = (job.K / 64) * (job.ncols / 32);
        for (int it = C.gw; it < nit; it += C.ngw) cvt_job_items(job, it, scr, C.lane); }
}
__device__ __forceinline__ void ph_skinny(const Ctx& C0, KP p, int L) {
    const Ctx C = refresh(C0);
    const float* H = (const float*)(p->ws + WS_H); float* SK = (float*)(p->ws + WS_SK);
    const bf16_t* Bhi = (const bf16_t*)(p->ws + WS_WSK3) + (size_t)(L * 2) * 16 * D; const bf16_t* Blo = Bhi + (size_t)16 * D;
    volatile LAS float* S = (volatile LAS float*)(C.lds);
    const int NTILE = MROWS / 16;
    for (int tb = C.vcu; tb < NTILE; tb += 4 * C.G) {
        int rb[4];
#pragma unroll
        for (int i = 0; i < 4; ++i) rb[i] = ((tb + i * C.G < NTILE) ? (tb + i * C.G) : tb) * 16;
        f32x4 acc[1]; wg_skinny<1>(C, H, rb, Bhi, Blo, acc);
        const int ti = C.wave >> 1, kh = C.wave & 1;
#pragma unroll
        for (int i = 0; i < 4; ++i) S[((ti * 2 + kh) * 16 + 4 * (C.lane >> 4) + i) * 16 + (C.lane & 15)] = acc[0][i];
        __syncthreads();
        if (kh == 0 && tb + ti * C.G < NTILE) {
#pragma unroll
            for (int i = 0; i < 4; ++i) { const int r = 4 * (C.lane >> 4) + i;
                SK[(size_t)(rb[ti] + r) * 16 + (C.lane & 15)] = S[((ti * 2) * 16 + r) * 16 + (C.lane & 15)] + S[((ti * 2 + 1) * 16 + r) * 16 + (C.lane & 15)]; } }
        __syncthreads();
    }
}
template <int MODE> __device__ __forceinline__ void ln_row(KP p, int m, const float* g, const float* b, float* out, int lane, int pos0 = 0, int pos1 = 0) {
    float* H = (float*)(p->ws + WS_H); bf16_t* HB = (bf16_t*)(p->ws + WS_HB);
    float4* hr = (float4*)(H + (size_t)m * D); uint2* hb = (uint2*)(HB + (size_t)m * D);
    if (!row_valid(m)) {
#pragma unroll
        for (int j = 0; j < 8; ++j) { hr[lane + 64 * j] = make_float4(0.f, 0.f, 0.f, 0.f); hb[lane + 64 * j] = make_uint2(0u, 0u); }
        return; }
    float4 v[8]; float s = 0.f;
#pragma unroll
    for (int j = 0; j < 8; ++j) v[j] = hr[lane + 64 * j];
    if (MODE == 2) { const uint2* mx = (const uint2*)((const bf16_t*)(p->ws + WS_MIX) + (size_t)m * D);
#pragma unroll
        for (int j = 0; j < 8; ++j) { const uint2 a = mx[lane + 64 * j];
            v[j].x = DN_ALPHA * v[j].x + __uint_as_float(a.x << 16); v[j].y = DN_ALPHA * v[j].y + __uint_as_float(a.x & 0xffff0000u);
            v[j].z = DN_ALPHA * v[j].z + __uint_as_float(a.y << 16); v[j].w = DN_ALPHA * v[j].w + __uint_as_float(a.y & 0xffff0000u); } }
    if (MODE == 1) { const bf16_t* YS = (const bf16_t*)(p->ws + WS_XS);
        const uint2* y0 = (const uint2*)(YS + (size_t)pos0 * D); const uint2* y1 = (const uint2*)(YS + (size_t)pos1 * D);
#pragma unroll
        for (int j = 0; j < 8; ++j) { const uint2 a = y0[lane + 64 * j], c = y1[lane + 64 * j];
            v[j].x = DN_ALPHA * v[j].x + (__uint_as_float(a.x << 16) + __uint_as_float(c.x << 16));
            v[j].y = DN_ALPHA * v[j].y + (__uint_as_float(a.x & 0xffff0000u) + __uint_as_float(c.x & 0xffff0000u));
            v[j].z = DN_ALPHA * v[j].z + (__uint_as_float(a.y << 16) + __uint_as_float(c.y << 16));
            v[j].w = DN_ALPHA * v[j].w + (__uint_as_float(a.y & 0xffff0000u) + __uint_as_float(c.y & 0xffff0000u)); } }
#pragma unroll
    for (int j = 0; j < 8; ++j) s += (v[j].x + v[j].y) + (v[j].z + v[j].w);
    const float mean = wave_sum(s) * (1.0f / D); float q = 0.f;
#pragma unroll
    for (int j = 0; j < 8; ++j) { v[j].x -= mean; v[j].y -= mean; v[j].z -= mean; v[j].w -= mean; q += (v[j].x * v[j].x + v[j].y * v[j].y) + (v[j].z * v[j].z + v[j].w * v[j].w); }
    const float rstd = rsqrtf(wave_sum(q) * (1.0f / D) + LN_EPS);
    const int q_ = m % LP, bb = m / LP;
#pragma unroll
    for (int j = 0; j < 8; ++j) { const int c = (lane + 64 * j) * 4; const float4 gg = *(const float4*)(g + c), bv = *(const float4*)(b + c);
        float4 o; o.x = v[j].x * rstd * gg.x + bv.x; o.y = v[j].y * rstd * gg.y + bv.y; o.z = v[j].z * rstd * gg.z + bv.z; o.w = v[j].w * rstd * gg.w + bv.w;
        hr[lane + 64 * j] = o; hb[lane + 64 * j] = make_uint2(pk2(o.x, o.y), pk2(o.z, o.w));
        if (out && q_ >= CHUNK) *(float4*)(out + ((size_t)bb * SEQ + (q_ - CHUNK)) * D + c) = o; }
}
__device__ __forceinline__ void ph_ln1_router(const Ctx& C0, KP p, int L) {
    const Ctx C = refresh(C0);
    const float* g = p->in[37] + L * D; const float* b = p->in[38] + L * D;
    const float* H = (const float*)(p->ws + WS_H); const bf16_t* WRhi = (const bf16_t*)(p->ws + WS_WR) + (size_t)(L * 2) * 48 * D; const bf16_t* WRlo = WRhi + (size_t)48 * D;
    const float* brg = p->in[31] + L * 4; const float* bre = p->in[33] + L * 32;
    int* toke = (int*)(p->ws + WS_TOKE); float* tokw = (float*)(p->ws + WS_TOKW); int* toks = (int*)(p->ws + WS_TOKS);
    unsigned* cnt = (unsigned*)(p->ws + WS_CTL) + CW_CNT + L * 32;
    volatile LAS float* S = (volatile LAS float*)(C.lds);
    const int NTILE = MP / 16;
    for (int tb = C.vcu; tb < NTILE; tb += 4 * C.G) {
        int nt = 0;
#pragma unroll
        for (int i = 0; i < 4; ++i) nt += (tb + i * C.G < NTILE) ? 1 : 0;
        for (int j = C.wave; j < nt * 16; j += NWAVES) ln_row<2>(p, (tb + (j >> 4) * C.G) * 16 + (j & 15), g, b, nullptr, C.lane);
        __syncthreads();
        const int ti = C.wave >> 1, kh = C.wave & 1, t = tb + ti * C.G;
        const bool act = ti < nt && t * 16 < MROWS;
        int rb[4];
#pragma unroll
        for (int i = 0; i < 4; ++i) rb[i] = ((i < nt) ? (tb + i * C.G) : tb) * 16;
        f32x4 acc[3]; wg_skinny<3>(C, H, rb, WRhi, WRlo, acc);
        if (act) {
#pragma unroll
            for (int n3 = 0; n3 < 3; ++n3)
#pragma unroll
                for (int i = 0; i < 4; ++i) S[((ti * 2 + kh) * 16 + 4 * (C.lane >> 4) + i) * 48 + 16 * n3 + (C.lane & 15)] = acc[n3][i];
        }
        __syncthreads();
        volatile LAS int* LC = (volatile LAS int*)(C.lds + 32768);
        if (C.tid < 32) LC[C.tid] = 0;
        __syncthreads();
        int ea = -1, eb = -1, la = 0, lb = 0; const int m = t * 16 + C.lane;
        if (act && kh == 0 && C.lane < 16) {
            if (!row_valid(m)) { toke[m * 2] = 0; toke[m * 2 + 1] = 0; tokw[m * 2] = 0.f; tokw[m * 2 + 1] = 0.f; toks[m * 2] = 0; toks[m * 2 + 1] = 0; }
            else {
                volatile LAS float* r0 = S + ((ti * 2) * 16 + C.lane) * 48; volatile LAS float* r1 = r0 + 16 * 48;
                float best = r0[0] + r1[0] + brg[0]; int gtp = 0; float lg[4]; lg[0] = best;
#pragma unroll
                for (int j = 1; j < 4; ++j) { lg[j] = r0[j] + r1[j] + brg[j]; if (lg[j] > best) { best = lg[j]; gtp = j; } }
                float den = 0.f;
#pragma unroll
                for (int j = 0; j < 4; ++j) den += __expf(lg[j] - best);
                const float ptop = 1.0f / den;
                float v0 = -3.0e38f, v1 = -3.0e38f; int e0 = 0, e1 = 0;
                for (int j = 0; j < 8; ++j) { const float le = r0[4 + gtp * 8 + j] + r1[4 + gtp * 8 + j] + bre[gtp * 8 + j]; if (le > v0) { v0 = le; e0 = j; } }
                for (int j = 0; j < 8; ++j) { const float le = r0[4 + gtp * 8 + j] + r1[4 + gtp * 8 + j] + bre[gtp * 8 + j]; if (j != e0 && le > v1) { v1 = le; e1 = j; } }
                const float x = __expf(v1 - v0), w0 = 1.0f / (1.0f + x), w1 = x / (1.0f + x);
                ea = gtp * 8 + e0; eb = gtp * 8 + e1;
                toke[m * 2] = ea; toke[m * 2 + 1] = eb; tokw[m * 2] = ptop * w0; tokw[m * 2 + 1] = ptop * w1;
                la = atomicAdd((int*)(C.lds + 32768) + ea, 1); lb = atomicAdd((int*)(C.lds + 32768) + eb, 1);
            }
        }
        __syncthreads();
        if (C.tid < 32) { const int n = LC[C.tid]; LC[32 + C.tid] = n ? (int)atomicAdd(cnt + C.tid, (unsigned)n) : 0; }
        __syncthreads();
        if (ea >= 0) { const int sa = LC[32 + ea] + la, sb_ = LC[32 + eb] + lb; toks[m * 2] = sa; toks[m * 2 + 1] = sb_;
            int* liste = (int*)(p->ws + WS_LISTE); liste[ea * MROWS + sa] = m * 2; liste[eb * MROWS + sb_] = m * 2 + 1; }
        __syncthreads();
    }
}
__device__ __forceinline__ void ph_permute(const Ctx& C0, KP p, int L) {
    const Ctx C = refresh(C0);
    unsigned* cnt = (unsigned*)(p->ws + WS_CTL) + CW_CNT + L * 32;
    const int* toke = (const int*)(p->ws + WS_TOKE); const float* tokw = (const float*)(p->ws + WS_TOKW); int* toks = (int*)(p->ws + WS_TOKS);
    const bf16_t* HB = (const bf16_t*)(p->ws + WS_HB); bf16_t* XS = (bf16_t*)(p->ws + WS_XS); float* XW = (float*)(p->ws + WS_XW);
    int c = (C.lane < 32) ? (int)xb_ld(cnt + C.lane) : 0;
    int incl = c;
#pragma unroll
    for (int o = 1; o < 32; o <<= 1) { const int t = __shfl_up(incl, o); if (C.lane >= o) incl += t; }
    const int excl = incl - c;
    for (int m = C.gw; m < MROWS; m += C.ngw) {
        if (!row_valid(m)) continue;
        const int e0 = toke[m * 2], e1 = toke[m * 2 + 1];
        const int p0 = __shfl(excl, e0) + toks[m * 2], p1 = __shfl(excl, e1) + toks[m * 2 + 1];
        const v4u* src = (const v4u*)(HB + (size_t)m * D); v4u* d0 = (v4u*)(XS + (size_t)p0 * D); v4u* d1 = (v4u*)(XS + (size_t)p1 * D);
#pragma unroll
        for (int j = 0; j < 4; ++j) { const v4u x = src[C.lane + 64 * j]; d0[C.lane + 64 * j] = x; d1[C.lane + 64 * j] = x; }
        if (C.lane == 0) { XW[p0] = tokw[m * 2]; XW[p1] = tokw[m * 2 + 1]; }
        asm volatile("s_waitcnt vmcnt(0)" ::: "memory");
        if (C.lane == 0) { toks[m * 2] = p0; toks[m * 2 + 1] = p1; }
    }
}
__device__ __forceinline__ void ph_ln2(const Ctx& C0, KP p, int L) {
    const Ctx C = refresh(C0);
    const float* g = p->in[39] + L * D; const float* b = p->in[40] + L * D;
    float* out = (L == 1) ? p->out : nullptr;
    unsigned* cnt = (unsigned*)(p->ws + WS_CTL) + CW_CNT + L * 32;
    const int* toke = (const int*)(p->ws + WS_TOKE); const int* toks = (const int*)(p->ws + WS_TOKS);
    int c = (C.lane < 32) ? (int)xb_ld(cnt + C.lane) : 0;
    int incl = c;
#pragma unroll
    for (int o = 1; o < 32; o <<= 1) { const int t = __shfl_up(incl, o); if (C.lane >= o) incl += t; }
    const int excl = incl - c;
    for (int m = C.gw; m < MP; m += C.ngw) {
        int p0 = 0, p1 = 0;
        if (row_valid(m)) { const int e0 = toke[m * 2], e1 = toke[m * 2 + 1]; p0 = __shfl(excl, e0) + toks[m * 2]; p1 = __shfl(excl, e1) + toks[m * 2 + 1]; }
        ln_row<1>(p, m, g, b, out, C.lane, p0, p1);
    }
}
constexpr int NPHASES = 23;
typedef short bf16x4 __attribute__((ext_vector_type(4)));
#define LDSW() asm volatile("s_waitcnt lgkmcnt(0)" ::: "memory")
#define LBAR() do { asm volatile("s_waitcnt lgkmcnt(0)" ::: "memory"); __builtin_amdgcn_s_barrier(); asm volatile("" ::: "memory"); } while (0)
__device__ __forceinline__ f32x4 mmaT(bf16x8 a_rows_m, bf16x8 b_rows_n, f32x4 acc) {
    return __builtin_amdgcn_mfma_f32_16x16x32_bf16(b_rows_n, a_rows_m, acc, 0, 0, 0);
}
__device__ __forceinline__ float bflo(unsigned w) { return __uint_as_float(w << 16); }
__device__ __forceinline__ float bfhi(unsigned w) { return __uint_as_float(w & 0xffff0000u); }
__device__ __forceinline__ int chunk_row0(int c) { return (c / NCH) * LP + (c % NCH) * CHUNK; }

template <bool FINAL> __device__ __forceinline__ void ph_s5(const Ctx& C0, KP p) {
    const Ctx C = refresh(C0);
    const int lane = C.lane, fr = lane & 15, fq = lane >> 4;
    LAS float* bre_l = (LAS float*)(C.lds + C.wave * 16384); LAS float* bim_l = bre_l + 16 * 68; LAS bf16_t* Sb = (LAS bf16_t*)(bim_l + 16 * 68);
    const float* Cc = (const float*)(p->ws + WS_S5C); const bf16_t* Bb = (const bf16_t*)(p->ws + WS_S5B);
    const bf16_t* P = (const bf16_t*)(p->ws + WS_P); bf16_t* Z = (bf16_t*)(p->ws + WS_Z); float* X = (float*)(p->ws + WS_S5X);
    const bf16x8 zero8 = {0, 0, 0, 0, 0, 0, 0, 0};
    const int NIT = BATCH * NCH * S5G;
    int gcur = -1; float ar = 0.f, ai = 0.f; bf16x8 bfr[4], bfi[4], cm[4]; f32x4 dd = {0.f, 0.f, 0.f, 0.f};
#pragma unroll
    for (int q = 0; q < 4; ++q) { bfr[q] = zero8; bfi[q] = zero8; cm[q] = zero8; }
    bf16x8 a[4], an[4]; uint2 uu[4], un[4]; float2 x0 = make_float2(0.f, 0.f), xn = make_float2(0.f, 0.f);
#define S5_LOAD(it_, a_, u_, x_) do { const int c_ = (it_) / S5G, g_ = (it_) % S5G, m0_ = chunk_row0(c_); \
        _Pragma("unroll") for (int sub = 0; sub < 4; ++sub) { const bf16_t* urow = P + (size_t)(m0_ + sub * 16 + fr) * NP0 + P0_U + g_ * 16; \
            a_[sub] = (lane < 32) ? *(const bf16x8*)(urow + 8 * fq) : zero8; if (FINAL) u_[sub] = *(const uint2*)(urow + 4 * fq); } \
        if (FINAL) x_ = *(const float2*)(X + ((size_t)(c_ * S5G + g_) * 64 + lane) * 2); } while (0)
    if (C.gw < NIT) S5_LOAD(C.gw, an, un, xn);
    for (int it = C.gw; it < NIT; it += C.ngw) {
        const int c = it / S5G, g = it % S5G, m0 = chunk_row0(c);
#pragma unroll
        for (int sub = 0; sub < 4; ++sub) { a[sub] = an[sub]; uu[sub] = un[sub]; }
        x0 = xn;
        if (it + C.ngw < NIT) S5_LOAD(it + C.ngw, an, un, xn);
        if (g != gcur) { gcur = g;
            ar = Cc[S5C_ABAR + 2 * (g * 64 + lane)]; ai = Cc[S5C_ABAR + 2 * (g * 64 + lane) + 1];
#pragma unroll
            for (int nt = 0; nt < 4; ++nt) { bfr[nt] = (lane < 32) ? *(const bf16x8*)(Bb + S5B_BR + (size_t)(g * 64 + nt * 16 + fr) * 16 + 8 * fq) : zero8;
                                             bfi[nt] = (lane < 32) ? *(const bf16x8*)(Bb + S5B_BI + (size_t)(g * 64 + nt * 16 + fr) * 16 + 8 * fq) : zero8; }
            if (FINAL) {
#pragma unroll
                for (int ks = 0; ks < 4; ++ks) cm[ks] = *(const bf16x8*)(Bb + S5B_CM + (size_t)(g * 16 + fr) * 128 + 32 * ks + 8 * fq);
                dd = *(const f32x4*)(p->in[10] + g * 16 + 4 * fq); } }
        float sr = FINAL ? x0.x : 0.f, si = FINAL ? x0.y : 0.f;
#pragma unroll
        for (int sub = 0; sub < 4; ++sub) {
#pragma unroll
            for (int nt = 0; nt < 4; ++nt) { const f32x4 z4 = {0.f, 0.f, 0.f, 0.f};
                const f32x4 r = mmaT(a[sub], bfr[nt], z4), im = mmaT(a[sub], bfi[nt], z4);
                *(LAS f32x4*)(bre_l + fr * 68 + nt * 16 + 4 * fq) = r; *(LAS f32x4*)(bim_l + fr * 68 + nt * 16 + 4 * fq) = im; }
            LDSW();
            float brv[16], biv[16];
#pragma unroll
            for (int t = 0; t < 16; ++t) { brv[t] = bre_l[t * 68 + lane]; biv[t] = bim_l[t * 68 + lane]; }
#pragma unroll
            for (int t = 0; t < 16; ++t) { const float nr = ar * sr - ai * si + brv[t], ni = ar * si + ai * sr + biv[t]; sr = nr; si = ni;
                if (FINAL) { Sb[t * 136 + lane] = (bf16_t)f2bf(sr); Sb[t * 136 + 64 + lane] = (bf16_t)f2bf(si); } }
            if (FINAL) {
                LDSW();
                f32x4 y = {0.f, 0.f, 0.f, 0.f};
#pragma unroll
                for (int ks = 0; ks < 4; ++ks) { const bf16x8 sa = *(const LAS bf16x8*)(Sb + fr * 136 + 32 * ks + 8 * fq); y = mmaT(sa, cm[ks], y); }
                const float z0 = gelu_tanh(y[0] + dd[0] * bflo(uu[sub].x)), z1 = gelu_tanh(y[1] + dd[1] * bfhi(uu[sub].x)), z2 = gelu_tanh(y[2] + dd[2] * bflo(uu[sub].y)), z3 = gelu_tanh(y[3] + dd[3] * bfhi(uu[sub].y));
                *(uint2*)(Z + (size_t)(m0 + sub * 16 + fr) * S5W + g * 16 + 4 * fq) = make_uint2(pk2(z0, z1), pk2(z2, z3));
            }
            LDSW();
        }
        if (!FINAL) *(float2*)(X + ((size_t)(c * S5G + g) * 64 + lane) * 2) = make_float2(sr, si);
    }
#undef S5_LOAD
}
__device__ __forceinline__ void ph_s5_carry(const Ctx& C0, KP p) {
    const Ctx C = refresh(C0);
    const int gt = C.vcu * NTHREADS + C.tid;
    if (gt >= BATCH * S5G * S5P) return;
    const float* Cc = (const float*)(p->ws + WS_S5C); float* X = (float*)(p->ws + WS_S5X);
    const int b = gt / (S5G * S5P), gp = gt % (S5G * S5P);
    float ar = Cc[S5C_ABAR + 2 * gp], ai = Cc[S5C_ABAR + 2 * gp + 1];
#pragma unroll
    for (int i = 0; i < 6; ++i) { const float nr = ar * ar - ai * ai, ni = 2.f * ar * ai; ar = nr; ai = ni; }
    float xr = 0.f, xi = 0.f;
    float2* base = (float2*)X + (size_t)b * NCH * (S5G * S5P) + gp;
    for (int n0 = 0; n0 < NCH; n0 += 8) {
        float2 f[8];
#pragma unroll
        for (int j = 0; j < 8; ++j) f[j] = (n0 + j < NCH) ? base[(size_t)(n0 + j) * (S5G * S5P)] : make_float2(0.f, 0.f);
#pragma unroll
        for (int j = 0; j < 8; ++j) if (n0 + j < NCH) { base[(size_t)(n0 + j) * (S5G * S5P)] = make_float2(xr, xi);
            const float nr = ar * xr - ai * xi + f[j].x, ni = ar * xi + ai * xr + f[j].y; xr = nr; xi = ni; }
    }
}

constexpr int LFS = 129;
constexpr int GLA_LF = 0, GLA_TOT = 64 * LFS * 4, GLA_A_KST = GLA_TOT + 2048 + 4096, GLA_A_VT = GLA_A_KST + 128 * 72 * 2, GLA_A_END = GLA_A_VT + 256 * 72 * 2;
constexpr int GLA_C_QI = GLA_TOT + 2048 + 4096, GLA_C_KI = GLA_C_QI + 64 * 136 * 2, GLA_C_ATT = GLA_C_KI + 64 * 136 * 2, GLA_C_VT = GLA_C_ATT + 64 * 72 * 2, GLA_C_RED = GLA_C_VT + 256 * 72 * 2, GLA_C_END = GLA_C_RED + 64 * 8 * 4;
static_assert(GLA_C_END <= RING_BYTES && GLA_A_END <= RING_BYTES, "GLA LDS");
__device__ __forceinline__ void gla_bcum(const Ctx& C, KP p, int m0, int h, LAS float* LF, LAS float* TOT) {
    const int t = C.tid, d = t & 127, qd = t >> 7;
    const float* SK = (const float*)(p->ws + WS_SK); const float* wg = p->in[13];
    LAS float* SKL = TOT + 512;
    if (t < 256) *(LAS f32x4*)(SKL + t * 4) = *(const f32x4*)(SK + (size_t)m0 * 16 + t * 4);
    float wgc[16];
#pragma unroll
    for (int j = 0; j < 16; ++j) wgc[j] = wg[j * 512 + h * 128 + d];
    const float bgc = p->in[14][h * 128 + d];
    __syncthreads();
    float run = 0.f;
#pragma unroll 4
    for (int i = 0; i < 16; ++i) { const int tok = 16 * qd + i, m = m0 + tok;
        float lg = bgc;
#pragma unroll
        for (int q = 0; q < 4; ++q) { const f32x4 s4 = *(const LAS f32x4*)(SKL + tok * 16 + 4 * q); lg += s4[0] * wgc[4 * q] + s4[1] * wgc[4 * q + 1] + s4[2] * wgc[4 * q + 2] + s4[3] * wgc[4 * q + 3]; }
        const float lsg = fminf(lg, 0.f) - __logf(1.0f + __expf(-fabsf(lg)));
        const float lf = ((m % LP) >= PADF) ? lsg * (1.0f / 16.0f) : 0.f;
        run += lf; LF[tok * LFS + d] = run; }
    TOT[qd * 128 + d] = run;
    __syncthreads();
    float off = 0.f;
#pragma unroll
    for (int q = 0; q < 3; ++q) off += (q < qd) ? TOT[q * 128 + d] : 0.f;
    if (qd > 0) {
#pragma unroll 4
        for (int i = 0; i < 16; ++i) LF[(16 * qd + i) * LFS + d] += off; }
    __syncthreads();
}
__device__ __forceinline__ void stage_transposed(const Ctx& C, const bf16_t* src  , int ld, int ncols, LAS bf16_t* T) {
    for (int cg = C.wave; cg < ncols / 8; cg += NWAVES) {
        const v4u x = *(const v4u*)(src + (size_t)C.lane * ld + cg * 8);
        const unsigned w[4] = {x.x, x.y, x.z, x.w};
#pragma unroll
        for (int q = 0; q < 4; ++q) { T[(cg * 8 + 2 * q) * 72 + C.lane] = (bf16_t)(w[q] & 0xffffu); T[(cg * 8 + 2 * q + 1) * 72 + C.lane] = (bf16_t)(w[q] >> 16); }
    }
}
__device__ __forceinline__ void ph_gla_a(const Ctx& C0, KP p) {
    const Ctx C = refresh(C0);
    const int lane = C.lane, fr = lane & 15, fq = lane >> 4, t = C.tid;
    LAS float* LF = (LAS float*)(C.lds + GLA_LF); LAS float* TOT = (LAS float*)(C.lds + GLA_TOT);
    LAS bf16_t* KSt = (LAS bf16_t*)(C.lds + GLA_A_KST); LAS bf16_t* Vt = (LAS bf16_t*)(C.lds + GLA_A_VT);
    const bf16_t* P = (const bf16_t*)(p->ws + WS_P); bf16_t* KV = (bf16_t*)(p->ws + WS_HB); float* DEC = (float*)(p->ws + WS_GDEC);
    for (int it = C.vcu; it < BATCH * NCH * GLH; it += C.G) {
        const int c = it / GLH, h = it % GLH, m0 = chunk_row0(c);
        v4u xk[2], xv[4];
#pragma unroll
        for (int i = 0; i < 2; ++i) xk[i] = *(const v4u*)(P + (size_t)(m0 + lane) * NP0 + P0_K + h * 128 + (C.wave + 8 * i) * 8);
#pragma unroll
        for (int i = 0; i < 4; ++i) xv[i] = *(const v4u*)(P + (size_t)(m0 + lane) * NP0 + P0_V + h * 256 + (C.wave + 8 * i) * 8);
        __syncthreads();
        gla_bcum(C, p, m0, h, LF, TOT);
#pragma unroll
        for (int i = 0; i < 2; ++i) { const int cg = C.wave + 8 * i;
            const unsigned w[4] = {xk[i].x, xk[i].y, xk[i].z, xk[i].w};
#pragma unroll
            for (int q = 0; q < 4; ++q) { const int d0 = cg * 8 + 2 * q;
                const float bl0 = LF[63 * LFS + d0], bl1 = LF[63 * LFS + d0 + 1];
                KSt[d0 * 72 + lane] = (bf16_t)f2bf(bflo(w[q]) * __expf(bl0 - LF[lane * LFS + d0]));
                KSt[(d0 + 1) * 72 + lane] = (bf16_t)f2bf(bfhi(w[q]) * __expf(bl1 - LF[lane * LFS + d0 + 1])); }
        }
#pragma unroll
        for (int i = 0; i < 4; ++i) { const int cg = C.wave + 8 * i; const unsigned w[4] = {xv[i].x, xv[i].y, xv[i].z, xv[i].w};
#pragma unroll
            for (int q = 0; q < 4; ++q) { Vt[(cg * 8 + 2 * q) * 72 + lane] = (bf16_t)(w[q] & 0xffffu); Vt[(cg * 8 + 2 * q + 1) * 72 + lane] = (bf16_t)(w[q] >> 16); } }
        if (t < 128) DEC[(size_t)it * 128 + t] = __expf(LF[63 * LFS + t]);
        __syncthreads();
        bf16x8 af[2][2];
#pragma unroll
        for (int mt = 0; mt < 2; ++mt)
#pragma unroll
            for (int ks = 0; ks < 2; ++ks) af[mt][ks] = *(const LAS bf16x8*)(Vt + ((2 * C.wave + mt) * 16 + fr) * 72 + 32 * ks + 8 * fq);
        bf16_t* kvo = KV + (size_t)it * 256 * 128;
#pragma unroll
        for (int nt = 0; nt < 8; ++nt) {
            const bf16x8 b0 = *(const LAS bf16x8*)(KSt + (nt * 16 + fr) * 72 + 8 * fq), b1 = *(const LAS bf16x8*)(KSt + (nt * 16 + fr) * 72 + 32 + 8 * fq);
#pragma unroll
            for (int mt = 0; mt < 2; ++mt) { f32x4 acc = {0.f, 0.f, 0.f, 0.f}; acc = mmaT(af[mt][0], b0, acc); acc = mmaT(af[mt][1], b1, acc);
                *(uint2*)(kvo + (size_t)((2 * C.wave + mt) * 16 + fr) * 128 + nt * 16 + 4 * fq) = make_uint2(pk2(acc[0], acc[1]), pk2(acc[2], acc[3])); }
        }
    }
}
__device__ __forceinline__ void ph_gla_b(const Ctx& C0, KP p) {
    const Ctx C = refresh(C0);
    bf16_t* KV = (bf16_t*)(p->ws + WS_HB); const float* DEC = (const float*)(p->ws + WS_GDEC);
    for (int gt = C.vcu * NTHREADS + C.tid; gt < BATCH * GLH * 256 * 64; gt += C.G * NTHREADS) {
        const int bh = gt / (256 * 64), rem = gt % (256 * 64), e = rem / 64, d = (rem % 64) * 2, b = bh / GLH, h = bh % GLH;
        float s0 = 0.f, s1 = 0.f;
        for (int n0 = 0; n0 < NCH; n0 += 8) {
            unsigned kv[8]; float2 dc[8];
#pragma unroll
            for (int j = 0; j < 8; ++j) { const int n = (n0 + j < NCH) ? n0 + j : NCH - 1; const size_t ch = (size_t)(b * NCH + n) * GLH + h;
                kv[j] = *(const unsigned*)(KV + (ch * 256 + e) * 128 + d); dc[j] = *(const float2*)(DEC + ch * 128 + d); }
#pragma unroll
            for (int j = 0; j < 8; ++j) if (n0 + j < NCH) { const size_t ch = (size_t)(b * NCH + n0 + j) * GLH + h;
                *(unsigned*)(KV + (ch * 256 + e) * 128 + d) = pk2(s0, s1);
                s0 = s0 * dc[j].x + bflo(kv[j]); s1 = s1 * dc[j].y + bfhi(kv[j]); }
        }
    }
}
__device__ __forceinline__ void ph_gla_c(const Ctx& C0, KP p) {
    const Ctx C = refresh(C0);
    const int lane = C.lane, fr = lane & 15, fq = lane >> 4;
    LAS float* LF = (LAS float*)(C.lds + GLA_LF); LAS float* TOT = (LAS float*)(C.lds + GLA_TOT);
    LAS bf16_t* Qi = (LAS bf16_t*)(C.lds + GLA_C_QI); LAS bf16_t* Ki = (LAS bf16_t*)(C.lds + GLA_C_KI); LAS bf16_t* ATT = (LAS bf16_t*)(C.lds + GLA_C_ATT);
    LAS bf16_t* Vt = (LAS bf16_t*)(C.lds + GLA_C_VT); LAS float* RED = (LAS float*)(C.lds + GLA_C_RED);
    const bf16_t* P = (const bf16_t*)(p->ws + WS_P); const bf16_t* KV = (const bf16_t*)(p->ws + WS_HB); bf16_t* Y = (bf16_t*)(p->ws + WS_Y);
    for (int it = C.vcu; it < BATCH * NCH * GLH; it += C.G) {
        const int c = it / GLH, h = it % GLH, m0 = chunk_row0(c);
        v4u xq[2], xk[2], xv[4]; bf16x8 sbf[4][2]; uint2 rr[4][2];
        const bf16_t* Sn = KV + (size_t)it * 256 * 128;
#pragma unroll
        for (int i = 0; i < 2; ++i) { const int idx = C.tid + NTHREADS * i, tok = idx >> 4, cg = idx & 15;
            xq[i] = *(const v4u*)(P + (size_t)(m0 + tok) * NP0 + P0_Q + h * 128 + cg * 8); xk[i] = *(const v4u*)(P + (size_t)(m0 + tok) * NP0 + P0_K + h * 128 + cg * 8); }
#pragma unroll
        for (int i = 0; i < 4; ++i) xv[i] = *(const v4u*)(P + (size_t)(m0 + lane) * NP0 + P0_V + h * 256 + (C.wave + 8 * i) * 8);
#pragma unroll
        for (int ks = 0; ks < 4; ++ks)
#pragma unroll
            for (int et = 0; et < 2; ++et) sbf[ks][et] = *(const bf16x8*)(Sn + (size_t)((2 * C.wave + et) * 16 + fr) * 128 + 32 * ks + 8 * fq);
#pragma unroll
        for (int mt = 0; mt < 4; ++mt)
#pragma unroll
            for (int et = 0; et < 2; ++et) rr[mt][et] = *(const uint2*)(P + (size_t)(m0 + mt * 16 + fr) * NP0 + P0_R + h * 256 + (2 * C.wave + et) * 16 + 4 * fq);
        __syncthreads();
        gla_bcum(C, p, m0, h, LF, TOT);
#pragma unroll
        for (int i = 0; i < 2; ++i) { const int idx = C.tid + NTHREADS * i, tok = idx >> 4, cg = idx & 15;
            const unsigned wq[4] = {xq[i].x, xq[i].y, xq[i].z, xq[i].w}, wk[4] = {xk[i].x, xk[i].y, xk[i].z, xk[i].w}; unsigned oq[4], ok[4];
#pragma unroll
            for (int q = 0; q < 4; ++q) { const float b0 = LF[tok * LFS + cg * 8 + 2 * q], b1 = LF[tok * LFS + cg * 8 + 2 * q + 1];
                const float e0 = __expf(b0), e1 = __expf(b1);
                oq[q] = pk2(bflo(wq[q]) * 0.08838834764831845f * e0, bfhi(wq[q]) * 0.08838834764831845f * e1);
                ok[q] = pk2(bflo(wk[q]) * rcpf_(e0), bfhi(wk[q]) * rcpf_(e1)); }
            *(LAS v4u*)(Qi + tok * 136 + cg * 8) = (v4u){oq[0], oq[1], oq[2], oq[3]}; *(LAS v4u*)(Ki + tok * 136 + cg * 8) = (v4u){ok[0], ok[1], ok[2], ok[3]}; }
#pragma unroll
        for (int i = 0; i < 4; ++i) { const int cg = C.wave + 8 * i; const unsigned w[4] = {xv[i].x, xv[i].y, xv[i].z, xv[i].w};
#pragma unroll
            for (int q = 0; q < 4; ++q) { Vt[(cg * 8 + 2 * q) * 72 + lane] = (bf16_t)(w[q] & 0xffffu); Vt[(cg * 8 + 2 * q + 1) * 72 + lane] = (bf16_t)(w[q] >> 16); } }
        __syncthreads();
        {
            const int mt = C.wave >> 1;
            bf16x8 qa[4];
#pragma unroll
            for (int ks = 0; ks < 4; ++ks) qa[ks] = *(const LAS bf16x8*)(Qi + (mt * 16 + fr) * 136 + 32 * ks + 8 * fq);
#pragma unroll
            for (int j = 0; j < 2; ++j) { const int nt = 2 * (C.wave & 1) + j; f32x4 acc = {0.f, 0.f, 0.f, 0.f};
#pragma unroll
                for (int ks = 0; ks < 4; ++ks) acc = mmaT(qa[ks], *(const LAS bf16x8*)(Ki + (nt * 16 + fr) * 136 + 32 * ks + 8 * fq), acc);
                const int cc = mt * 16 + fr, s0 = nt * 16 + 4 * fq;
                const float a0 = (s0 <= cc) ? acc[0] : 0.f, a1 = (s0 + 1 <= cc) ? acc[1] : 0.f, a2 = (s0 + 2 <= cc) ? acc[2] : 0.f, a3 = (s0 + 3 <= cc) ? acc[3] : 0.f;
                *(LAS v2u*)(ATT + cc * 72 + s0) = (v2u){pk2(a0, a1), pk2(a2, a3)}; }
        }
        __syncthreads();
        f32x4 o[4][2];
#pragma unroll
        for (int mt = 0; mt < 4; ++mt)
#pragma unroll
            for (int et = 0; et < 2; ++et) o[mt][et] = (f32x4){0.f, 0.f, 0.f, 0.f};
#pragma unroll
        for (int ks = 0; ks < 2; ++ks) { bf16x8 vb[2];
#pragma unroll
            for (int et = 0; et < 2; ++et) vb[et] = *(const LAS bf16x8*)(Vt + ((2 * C.wave + et) * 16 + fr) * 72 + 32 * ks + 8 * fq);
#pragma unroll
            for (int mt = 0; mt < 4; ++mt) { const bf16x8 aa = *(const LAS bf16x8*)(ATT + (mt * 16 + fr) * 72 + 32 * ks + 8 * fq);
#pragma unroll
                for (int et = 0; et < 2; ++et) o[mt][et] = mmaT(aa, vb[et], o[mt][et]); } }
#pragma unroll
        for (int ks = 0; ks < 4; ++ks) {
#pragma unroll
            for (int mt = 0; mt < 4; ++mt) { const bf16x8 qa = *(const LAS bf16x8*)(Qi + (mt * 16 + fr) * 136 + 32 * ks + 8 * fq);
#pragma unroll
                for (int et = 0; et < 2; ++et) o[mt][et] = mmaT(qa, sbf[ks][et], o[mt][et]); } }
#pragma unroll
        for (int mt = 0; mt < 4; ++mt) { float s = 0.f;
#pragma unroll
            for (int et = 0; et < 2; ++et) s += (o[mt][et][0] * o[mt][et][0] + o[mt][et][1] * o[mt][et][1]) + (o[mt][et][2] * o[mt][et][2] + o[mt][et][3] * o[mt][et][3]);
            s += __shfl_xor(s, 16); s += __shfl_xor(s, 32);
            if (fq == 0) RED[(mt * 16 + fr) * 8 + C.wave] = s; }
        __syncthreads();
#pragma unroll
        for (int mt = 0; mt < 4; ++mt) { const int cc = mt * 16 + fr; float s = 0.f;
#pragma unroll
            for (int w = 0; w < 8; ++w) s += RED[cc * 8 + w];
            const float rs = rsqrtf(s * (1.0f / 256.0f) + NORM_EPS);
#pragma unroll
            for (int et = 0; et < 2; ++et) { const int e = (2 * C.wave + et) * 16 + 4 * fq; const f32x4 ng = *(const f32x4*)(p->in[15] + e);
                const uint2 rg = rr[mt][et];
                const float y0 = o[mt][et][0] * rs * ng[0] * siluf_(bflo(rg.x)), y1 = o[mt][et][1] * rs * ng[1] * siluf_(bfhi(rg.x)), y2 = o[mt][et][2] * rs * ng[2] * siluf_(bflo(rg.y)), y3 = o[mt][et][3] * rs * ng[3] * siluf_(bfhi(rg.y));
                *(uint2*)(Y + (size_t)(m0 + cc) * D + 1024 + h * 256 + e) = make_uint2(pk2(y0, y1), pk2(y2, y3)); } }
    }
}
constexpr int XST = 129;
constexpr int LRU_XCF = 0, LRU_XCB = LRU_XCF + 64 * XST * 4, LRU_AL = LRU_XCB + 64 * 136 * 2, LRU_BL = LRU_AL + 64 * XST * 4, LRU_QT = LRU_BL + 64 * XST * 4, LRU_VAL = LRU_QT + 4096, LRU_END = LRU_VAL + 256;
static_assert(LRU_END <= RING_BYTES, "LRU LDS");
struct LruW { bf16x8 ba[4], bx[4]; int hb; };
template <bool FINAL> __device__ __forceinline__ void lru_item(const Ctx& C, KP p, int it, LruW& W) {
    const int lane = C.lane, fr = lane & 15, fq = lane >> 4, t = C.tid;
    LAS float* XCF = (LAS float*)(C.lds + LRU_XCF); LAS bf16_t* XCB = (LAS bf16_t*)(C.lds + LRU_XCB); LAS float* AL = (LAS float*)(C.lds + LRU_AL); LAS float* BL = (LAS float*)(C.lds + LRU_BL);
    LAS float* QT = (LAS float*)(C.lds + LRU_QT); LAS float* VAL = (LAS float*)(C.lds + LRU_VAL);
    const bf16_t* P = (const bf16_t*)(p->ws + WS_P); bf16_t* Y = (bf16_t*)(p->ws + WS_Y); float* F = (float*)(p->ws + WS_LRUF);
    const bf16_t* WA = (const bf16_t*)(p->ws + WS_WLRU); const bf16_t* WX = WA + (size_t)LRB * 128 * 128;
    const int c = it / LRB, hb = it % LRB, m0 = chunk_row0(c);
    const int j = t & 127, qd = t >> 7, ch = hb * 128 + j;
    float hq = 0.f; if (FINAL) hq = F[((size_t)c * LRW + ch) * 2];
    bf16_t gate[16];
    if (FINAL) {
#pragma unroll
        for (int i = 0; i < 16; ++i) gate[i] = P[(size_t)(m0 + 16 * qd + i) * NP1 + P1_LG + ch]; }
    if (hb != W.hb) { W.hb = hb;
#pragma unroll
        for (int ks = 0; ks < 4; ++ks) { W.ba[ks] = *(const bf16x8*)(WA + ((size_t)hb * 128 + C.wave * 16 + fr) * 128 + 32 * ks + 8 * fq); W.bx[ks] = *(const bf16x8*)(WX + ((size_t)hb * 128 + C.wave * 16 + fr) * 128 + 32 * ks + 8 * fq); } }
    __syncthreads();
    for (int i = t; i < 64 * 16; i += NTHREADS) { const int tok = i >> 4, cg = i & 15, m = m0 + tok, chc = hb * 128 + cg * 8;
        float xc[8];
#pragma unroll
        for (int q = 0; q < 8; ++q) xc[q] = p->in[23][chc + q];
#pragma unroll
        for (int tt = 0; tt < 4; ++tt) { const int mm = m - 3 + tt; v4u x = {0u, 0u, 0u, 0u}; if (mm >= 0) x = *(const v4u*)(P + (size_t)mm * NP1 + P1_LX + chc);
            const f32x4 w0 = *(const f32x4*)(p->in[22] + tt * LRW + chc), w1 = *(const f32x4*)(p->in[22] + tt * LRW + chc + 4);
            xc[0] += w0[0] * bflo(x.x); xc[1] += w0[1] * bfhi(x.x); xc[2] += w0[2] * bflo(x.y); xc[3] += w0[3] * bfhi(x.y);
            xc[4] += w1[0] * bflo(x.z); xc[5] += w1[1] * bfhi(x.z); xc[6] += w1[2] * bflo(x.w); xc[7] += w1[3] * bfhi(x.w); }
#pragma unroll
        for (int q = 0; q < 8; ++q) XCF[tok * XST + cg * 8 + q] = xc[q];
        *(LAS v4u*)(XCB + tok * 136 + cg * 8) = (v4u){pk2(xc[0], xc[1]), pk2(xc[2], xc[3]), pk2(xc[4], xc[5]), pk2(xc[6], xc[7])}; }
    if (t < 64) VAL[t] = (((m0 + t) % LP) >= PADF) ? 1.0f : 0.0f;
    __syncthreads();
    {
        f32x4 ra[4], ri[4];
#pragma unroll
        for (int mt = 0; mt < 4; ++mt) { ra[mt] = (f32x4){0.f, 0.f, 0.f, 0.f}; ri[mt] = (f32x4){0.f, 0.f, 0.f, 0.f}; }
#pragma unroll
        for (int ks = 0; ks < 4; ++ks) {
#pragma unroll
            for (int mt = 0; mt < 4; ++mt) { const bf16x8 a = *(const LAS bf16x8*)(XCB + (mt * 16 + fr) * 136 + 32 * ks + 8 * fq); ra[mt] = mmaT(a, W.ba[ks], ra[mt]); ri[mt] = mmaT(a, W.bx[ks], ri[mt]); } }
        const int j0 = C.wave * 16 + 4 * fq, ch0 = hb * 128 + j0;
        const f32x4 b_a = *(const f32x4*)(p->in[25] + ch0), b_x = *(const f32x4*)(p->in[27] + ch0), lam = *(const f32x4*)(p->in[28] + ch0);
#pragma unroll
        for (int mt = 0; mt < 4; ++mt) { const int tok = mt * 16 + fr; const float vv = VAL[tok];
#pragma unroll
            for (int i = 0; i < 4; ++i) { const float r = sigmoidf_(ra[mt][i] + b_a[i]), ig = sigmoidf_(ri[mt][i] + b_x[i]);
                const float la = -8.0f * softplusf_(-lam[i]) * r;
                AL[tok * XST + j0 + i] = __expf(la); BL[tok * XST + j0 + i] = vv * sqrtf(neg_expm1f_(2.0f * la)) * (ig * XCF[tok * XST + j0 + i]); } }
    }
    __syncthreads();
    { float av[16], bv[16];
#pragma unroll
        for (int i = 0; i < 16; ++i) { av[i] = AL[(16 * qd + i) * XST + j]; bv[i] = BL[(16 * qd + i) * XST + j]; }
        float A = 1.f, h = 0.f;
#pragma unroll
        for (int i = 0; i < 16; ++i) { h = av[i] * h + bv[i]; A *= av[i]; av[i] = A; bv[i] = h; }
        QT[(qd * 128 + j) * 2] = A; QT[(qd * 128 + j) * 2 + 1] = h;
        __syncthreads();
        float Atot = 1.f;
#pragma unroll
        for (int q = 0; q < 4; ++q) { const float Aq = QT[(q * 128 + j) * 2], hh = QT[(q * 128 + j) * 2 + 1]; if (q < qd) hq = Aq * hq + hh; Atot *= Aq; }
        if (!FINAL) { if (qd == 3) { const float A3 = QT[(3 * 128 + j) * 2], h3 = QT[(3 * 128 + j) * 2 + 1]; *(float2*)(F + ((size_t)c * LRW + ch) * 2) = make_float2(Atot, A3 * hq + h3); } }
        else {
#pragma unroll
            for (int i = 0; i < 16; ++i) { const size_t m = (size_t)(m0 + 16 * qd + i);
                Y[m * D + 1024 + ch] = (bf16_t)f2bf((bv[i] + av[i] * hq) * gelu_tanh(bf2f(gate[i]))); }
        }
    }
}
__device__ __forceinline__ void ph_lru_carry(const Ctx& C0, KP p) {
    const Ctx C = refresh(C0);
    const int gt = C.vcu * NTHREADS + C.tid;
    if (gt >= BATCH * LRW) return;
    const int b = gt / LRW, ch = gt % LRW;
    float2* base = (float2*)(p->ws + WS_LRUF) + (size_t)b * NCH * LRW + ch;
    float carry = 0.f;
    for (int n0 = 0; n0 < NCH; n0 += 8) {
        float2 f[8];
#pragma unroll
        for (int jj = 0; jj < 8; ++jj) f[jj] = (n0 + jj < NCH) ? base[(size_t)(n0 + jj) * LRW] : make_float2(1.f, 0.f);
#pragma unroll
        for (int jj = 0; jj < 8; ++jj) if (n0 + jj < NCH) { base[(size_t)(n0 + jj) * LRW] = make_float2(carry, 0.f); carry = f[jj].x * carry + f[jj].y; }
    }
}

__device__ __forceinline__ void ph_gdn_conv(const Ctx& C0, KP p) {
    const Ctx C = refresh(C0);
    const int lane = C.lane;
    const bf16_t* P = (const bf16_t*)(p->ws + WS_P); bf16_t* HBq = (bf16_t*)(p->ws + WS_HB); bf16_t* Yv = (bf16_t*)(p->ws + WS_Y);
    for (int it = C.gw; it < BATCH * NCH * 2 * 6; it += C.ngw) {
        const int cgp = it % 6, hc = it / 6, r0 = chunk_row0(hc >> 1) + 32 * (hc & 1), col = cgp * 512 + lane * 8;
        float w[4][8];
#pragma unroll
        for (int tt = 0; tt < 4; ++tt) { const f32x4 w0 = *(const f32x4*)(p->in[18] + tt * 3072 + col), w1 = *(const f32x4*)(p->in[18] + tt * 3072 + col + 4);
#pragma unroll
            for (int q = 0; q < 4; ++q) { w[tt][q] = w0[q]; w[tt][4 + q] = w1[q]; } }
        v4u win[4];
#pragma unroll
        for (int tt = 0; tt < 3; ++tt) { const int mm = r0 - 3 + tt; win[tt + 1] = (mm >= 0) ? *(const v4u*)(P + (size_t)mm * NP1 + col) : (v4u){0u, 0u, 0u, 0u}; }
        for (int rb = 0; rb < 32; rb += 8) {
            v4u rows[8];
#pragma unroll
            for (int q = 0; q < 8; ++q) rows[q] = *(const v4u*)(P + (size_t)(r0 + rb + q) * NP1 + col);
#pragma unroll
            for (int q8 = 0; q8 < 8; ++q8) { const int m = r0 + rb + q8;
                win[0] = win[1]; win[1] = win[2]; win[2] = win[3]; win[3] = rows[q8];
                float y[8];
#pragma unroll
                for (int q = 0; q < 8; ++q) y[q] = 0.f;
#pragma unroll
                for (int tt = 0; tt < 4; ++tt) { const v4u x = win[tt];
                    y[0] += w[tt][0] * bflo(x.x); y[1] += w[tt][1] * bfhi(x.x); y[2] += w[tt][2] * bflo(x.y); y[3] += w[tt][3] * bfhi(x.y);
                    y[4] += w[tt][4] * bflo(x.z); y[5] += w[tt][5] * bfhi(x.z); y[6] += w[tt][6] * bflo(x.w); y[7] += w[tt][7] * bfhi(x.w); }
                float ss = 0.f;
#pragma unroll
                for (int q = 0; q < 8; ++q) { y[q] = siluf_(y[q]); ss += y[q] * y[q]; }
                float sc = 1.0f;
                if (cgp < 4) { ss += __shfl_xor(ss, 1); ss += __shfl_xor(ss, 2); ss += __shfl_xor(ss, 4); ss += __shfl_xor(ss, 8);
                    sc = rsqrtf(ss + NORM_EPS) * (cgp < 2 ? 0.08838834764831845f : 1.0f); }
                if ((m % LP) < PADF) sc = 0.f;
                const v4u o = {pk2(y[0] * sc, y[1] * sc), pk2(y[2] * sc, y[3] * sc), pk2(y[4] * sc, y[5] * sc), pk2(y[6] * sc, y[7] * sc)};
                if (cgp < 4) *(v4u*)(HBq + (size_t)m * D + col) = o;
                else *(v4u*)(Yv + (size_t)m * D + (col - 2048)) = o;
            }
        }
    }
}
template <int S4, int N4> __device__ __forceinline__ void tri_inner(float& acc, const float (&x)[64], const LAS float* mrow) {
    if constexpr (S4 < N4) { const f32x4 mm = *(const LAS f32x4*)(mrow + 4 * S4);
        acc -= mm[0] * x[4 * S4]; acc -= mm[1] * x[4 * S4 + 1]; acc -= mm[2] * x[4 * S4 + 2]; acc -= mm[3] * x[4 * S4 + 3];
        tri_inner<S4 + 1, N4>(acc, x, mrow); }
}
template <int CC> __device__ __forceinline__ void tri_rows(float (&x)[64], const LAS float* MM, const LAS float* RHS, int t) {
    if constexpr (CC < 64) { float acc = RHS[CC * 256 + t]; tri_inner<0, (CC + 3) / 4>(acc, x, MM + CC * 68); asm volatile("" : "+v"(acc) :: "memory"); x[CC] = acc;
        tri_rows<CC + 1>(x, MM, RHS, t); }
}
constexpr int GP_KN = 0, GP_QN = GP_KN + 64 * 136 * 2, GP_MM = GP_QN + 64 * 136 * 2, GP_RHS = GP_MM + 64 * 68 * 4, GP_GC = GP_RHS + 64 * 256 * 4, GP_END = GP_GC + 1024;
static_assert(GP_END <= RING_BYTES, "GDN prep LDS");
__device__ __forceinline__ void ph_gdn_prep(const Ctx& C0, KP p) {
    const Ctx C = refresh(C0);
    const int lane = C.lane, fr = lane & 15, fq = lane >> 4, t = C.tid;
    LAS bf16_t* KN = (LAS bf16_t*)(C.lds + GP_KN); LAS bf16_t* QN = (LAS bf16_t*)(C.lds + GP_QN); LAS float* MM = (LAS float*)(C.lds + GP_MM);
    LAS float* RHS = (LAS float*)(C.lds + GP_RHS); LAS float* GC = (LAS float*)(C.lds + GP_GC); LAS float* BETA = GC + 64; LAS float* EG = GC + 128;
    bf16_t* HBq = (bf16_t*)(p->ws + WS_HB); const bf16_t* Yv = (const bf16_t*)(p->ws + WS_Y); bf16_t* P = (bf16_t*)(p->ws + WS_P);
    const float* SK = (const float*)(p->ws + WS_SK); float* GD = (float*)(p->ws + WS_LRUF) + 2 * BATCH * NCH * LRW;
    for (int it = C.vcu; it < BATCH * NCH * GDH; it += C.G) {
        const int c = it / GDH, h = it % GDH, m0 = chunk_row0(c);
        __syncthreads();
        for (int i = t; i < 64 * 16; i += NTHREADS) { const int tok = i >> 4, cg = i & 15;
            *(LAS v4u*)(QN + tok * 136 + cg * 8) = *(const v4u*)(HBq + (size_t)(m0 + tok) * D + h * 128 + cg * 8);
            *(LAS v4u*)(KN + tok * 136 + cg * 8) = *(const v4u*)(HBq + (size_t)(m0 + tok) * D + 1024 + h * 128 + cg * 8); }
        if (t < 64) { const int m = m0 + t; const bool val = (m % LP) >= PADF;
            float g = val ? -__expf(p->in[19][h]) * softplusf_(SK[(size_t)m * 16 + 8 + h] + p->in[20][h]) : 0.f;
            BETA[t] = val ? sigmoidf_(SK[(size_t)m * 16 + h]) : 0.f;
#pragma unroll
            for (int o = 1; o < 64; o <<= 1) { const float x = __shfl_up(g, o); if (lane >= o) g += x; }
            GC[t] = g; EG[t] = __expf(g); }
        __syncthreads();
        {
            const int mt = C.wave >> 1;
            bf16x8 ka[4], qa[4];
#pragma unroll
            for (int ks = 0; ks < 4; ++ks) { ka[ks] = *(const LAS bf16x8*)(KN + (mt * 16 + fr) * 136 + 32 * ks + 8 * fq); qa[ks] = *(const LAS bf16x8*)(QN + (mt * 16 + fr) * 136 + 32 * ks + 8 * fq); }
#pragma unroll
            for (int jn = 0; jn < 2; ++jn) { const int nt = 2 * (C.wave & 1) + jn; f32x4 kk = {0.f, 0.f, 0.f, 0.f}, qk = {0.f, 0.f, 0.f, 0.f};
#pragma unroll
                for (int ks = 0; ks < 4; ++ks) { const bf16x8 kb = *(const LAS bf16x8*)(KN + (nt * 16 + fr) * 136 + 32 * ks + 8 * fq); kk = mmaT(ka[ks], kb, kk); qk = mmaT(qa[ks], kb, qk); }
                const int cc = mt * 16 + fr, s0 = nt * 16 + 4 * fq; const float gcc = GC[cc], bc = BETA[cc];
                float mv[4], av[4];
#pragma unroll
                for (int i = 0; i < 4; ++i) { const int s = s0 + i; const float dcy = (s <= cc) ? __expf(gcc - GC[s]) : 0.f; mv[i] = (s < cc) ? bc * kk[i] * dcy : 0.f; av[i] = qk[i] * dcy; }
                *(LAS f32x4*)(MM + cc * 68 + s0) = (f32x4){mv[0], mv[1], mv[2], mv[3]};
                *(uint2*)(P + (size_t)(m0 + cc) * NP1 + 1024 + h * 64 + s0) = make_uint2(pk2(av[0], av[1]), pk2(av[2], av[3])); }
        }
        for (int i = t; i < 64 * 16; i += NTHREADS) { const int tok = i >> 4, cg = i & 15; const float bt = BETA[tok], be = bt * EG[tok];
            const v4u xv = *(const v4u*)(Yv + (size_t)(m0 + tok) * D + h * 128 + cg * 8); const v4u xk = *(const LAS v4u*)(KN + tok * 136 + cg * 8);
            LAS float* r = RHS + tok * 256 + cg * 8;
            r[0] = bflo(xv.x) * bt; r[1] = bfhi(xv.x) * bt; r[2] = bflo(xv.y) * bt; r[3] = bfhi(xv.y) * bt; r[4] = bflo(xv.z) * bt; r[5] = bfhi(xv.z) * bt; r[6] = bflo(xv.w) * bt; r[7] = bfhi(xv.w) * bt;
            r[128] = bflo(xk.x) * be; r[129] = bfhi(xk.x) * be; r[130] = bflo(xk.y) * be; r[131] = bfhi(xk.y) * be; r[132] = bflo(xk.z) * be; r[133] = bfhi(xk.z) * be; r[134] = bflo(xk.w) * be; r[135] = bfhi(xk.w) * be; }
        __syncthreads();
        if (C.wave < 4) {
            float x[64];
#pragma unroll
            for (int cc = 0; cc < 64; ++cc) x[cc] = 0.f;
            tri_rows<0>(x, MM, RHS, t);
            bf16_t* dst = (t < 128) ? (P + (size_t)m0 * NP1 + 2048 + h * 128 + t) : (P + (size_t)m0 * NP1 + h * 128 + (t - 128));
#pragma unroll
            for (int cc = 0; cc < 64; ++cc) dst[(size_t)cc * NP1] = (bf16_t)f2bf(x[cc]);
        } else {
            const float glast = GC[63];
            for (int i = t - 256; i < 64 * 16; i += 256) { const int tok = i >> 4, cg = i & 15; const float eq = EG[tok], ek = __expf(glast - GC[tok]);
                const v4u xq = *(const LAS v4u*)(QN + tok * 136 + cg * 8), xk = *(const LAS v4u*)(KN + tok * 136 + cg * 8);
                const v4u oq = {pk2(bflo(xq.x) * eq, bfhi(xq.x) * eq), pk2(bflo(xq.y) * eq, bfhi(xq.y) * eq), pk2(bflo(xq.z) * eq, bfhi(xq.z) * eq), pk2(bflo(xq.w) * eq, bfhi(xq.w) * eq)};
                const v4u ok = {pk2(bflo(xk.x) * ek, bfhi(xk.x) * ek), pk2(bflo(xk.y) * ek, bfhi(xk.y) * ek), pk2(bflo(xk.z) * ek, bfhi(xk.z) * ek), pk2(bflo(xk.w) * ek, bfhi(xk.w) * ek)};
                *(v4u*)(HBq + (size_t)(m0 + tok) * D + h * 128 + cg * 8) = oq; *(v4u*)(HBq + (size_t)(m0 + tok) * D + 1024 + h * 128 + cg * 8) = ok; }
            if (t == 256) GD[it] = __expf(glast);
        }
    }
}
constexpr int GS_W = 0, GS_QD = GS_W + 64 * 136 * 2, GS_KT = GS_QD + 64 * 136 * 2, GS_AQ = GS_KT + 128 * 72 * 2, GS_U = GS_AQ + 64 * 72 * 2, GS_BUF = GS_U + 64 * 40 * 2;
constexpr int GS_ST = 2 * GS_BUF, GS_VN = GS_ST + 2 * 16 * 136 * 2, GS_DEC = GS_VN + 2 * 16 * 72 * 2, GS_END = GS_DEC + 1024;
static_assert(GS_END <= RING_BYTES, "GDN seq LDS");
constexpr int GDN_STREAMS = BATCH * GDH * 4;
#define GS_STAGE_LOAD(n_) do { const size_t m0_ = (size_t)b * LP + (size_t)(n_) * 64; \
            const char* bW = (const char*)(P + m0_ * NP1 + h * 128); const char* bQ = (const char*)(HBq + m0_ * D + h * 128); const char* bK = (const char*)(HBq + m0_ * D + 1024 + h * 128); \
            const char* bA = (const char*)(P + m0_ * NP1 + 1024 + h * 64); const char* bU = (const char*)(P + m0_ * NP1 + 2048 + h * 128 + e0); \
            _Pragma("unroll") for (int i = 0; i < 8; ++i) { rw[i] = *(const v4u*)(bW + (size_t)i * (8 * NP1 * 2) + offW); rq[i] = *(const v4u*)(bQ + (size_t)i * (8 * D * 2) + offQ); rk[i] = *(const v4u*)(bK + (size_t)i * 32 + offK); } \
            _Pragma("unroll") for (int i = 0; i < 4; ++i) ra[i] = *(const v4u*)(bA + (size_t)i * (16 * NP1 * 2) + offA); \
            _Pragma("unroll") for (int i = 0; i < 2; ++i) ru[i] = *(const v4u*)(bU + (size_t)i * (32 * NP1 * 2) + offU); } while (0)
#define GS_STAGE_STORE(buf_) do { LAS bf16_t* B_ = (LAS bf16_t*)(C.lds + (buf_) * GS_BUF); \
            _Pragma("unroll") for (int i = 0; i < 8; ++i) { \
                *(LAS v4u*)(B_ + GS_W / 2 + (tid2 >> 4) * 136 + (tid2 & 15) * 8 + i * (8 * 136)) = rw[i]; *(LAS v4u*)(B_ + GS_QD / 2 + (tid2 >> 4) * 136 + (tid2 & 15) * 8 + i * (8 * 136)) = rq[i]; \
                const unsigned ww[4] = {rk[i].x, rk[i].y, rk[i].z, rk[i].w}; \
                _Pragma("unroll") for (int q = 0; q < 4; ++q) { B_[GS_KT / 2 + (tid2 >> 6) * (8 * 72) + (tid2 & 63) + (i * 16 + 2 * q) * 72] = (bf16_t)(ww[q] & 0xffffu); B_[GS_KT / 2 + (tid2 >> 6) * (8 * 72) + (tid2 & 63) + (i * 16 + 2 * q + 1) * 72] = (bf16_t)(ww[q] >> 16); } } \
            _Pragma("unroll") for (int i = 0; i < 4; ++i) *(LAS v4u*)(B_ + GS_AQ / 2 + (tid2 >> 3) * 72 + (tid2 & 7) * 8 + i * (16 * 72)) = ra[i]; \
            _Pragma("unroll") for (int i = 0; i < 2; ++i) *(LAS v4u*)(B_ + GS_U / 2 + (tid2 >> 2) * 40 + (tid2 & 3) * 8 + i * (32 * 40)) = ru[i]; } while (0)
__device__ __forceinline__ void ph_gdn_seq(const Ctx& C0, KP p, int st0, int stn) {
    const Ctx C = refresh(C0);
    const int lane = C.lane, fr = lane & 15, fq = lane >> 4, t = C.tid, w = C.wave;
    LAS bf16_t* ST = (LAS bf16_t*)(C.lds + GS_ST) + (w & 1) * 16 * 136; LAS bf16_t* VN = (LAS bf16_t*)(C.lds + GS_VN) + (w & 1) * 16 * 72; LAS float* DECL = (LAS float*)(C.lds + GS_DEC);
    const bf16_t* HBq = (const bf16_t*)(p->ws + WS_HB); const bf16_t* P = (const bf16_t*)(p->ws + WS_P); bf16_t* Y = (bf16_t*)(p->ws + WS_Y);
    const float* GD = (const float*)(p->ws + WS_LRUF) + 2 * BATCH * NCH * LRW;
    for (int st = st0; st < GDN_STREAMS; st += stn) {
        const int b = st / (GDH * 4), h = (st >> 2) % GDH, e0 = (st & 3) * 32;
        __syncthreads();
        if (w < 2) {
#pragma unroll
            for (int nt = 0; nt < 8; ++nt) *(LAS v2u*)(ST + fr * 136 + nt * 16 + 4 * fq) = (v2u){0u, 0u}; }
        if (t < NCH) DECL[t] = GD[(size_t)(b * NCH + t) * GDH + h];
        __syncthreads();
        if (w >= 4) {
            v4u rw[8], rq[8], rk[8], ra[4], ru[2];
            const int grp = (w >> 1) - 2, tid2 = t & 127;
            const unsigned offW = (unsigned)(((tid2 >> 4) * NP1 + (tid2 & 15) * 8) * 2), offQ = (unsigned)(((tid2 >> 4) * D + (tid2 & 15) * 8) * 2);
            const unsigned offK = (unsigned)(((tid2 & 63) * D + (tid2 >> 6) * 8) * 2), offA = (unsigned)(((tid2 >> 3) * NP1 + (tid2 & 7) * 8) * 2), offU = (unsigned)(((tid2 >> 2) * NP1 + (tid2 & 3) * 8) * 2);
            if (grp == 0) { GS_STAGE_LOAD(0); GS_STAGE_STORE(0); GS_STAGE_LOAD(2); } else GS_STAGE_LOAD(1);
            LBAR();
            for (int n = 0; n < NCH; ++n) {
                if (n + 1 < NCH && grp == ((n + 1) & 1)) { GS_STAGE_STORE((n + 1) & 1); if (n + 3 < NCH) GS_STAGE_LOAD(n + 3); }
                LBAR();
            }
        } else if (w < 2) {
            f32x4 S[8];
#pragma unroll
            for (int nt = 0; nt < 8; ++nt) S[nt] = (f32x4){0.f, 0.f, 0.f, 0.f};
            LBAR();
            for (int n = 0; n < NCH; ++n) {
                const LAS bf16_t* B_ = (const LAS bf16_t*)(C.lds + (n & 1) * GS_BUF);
                const LAS bf16_t* Wl = B_ + GS_W / 2; const LAS bf16_t* QD = B_ + GS_QD / 2; const LAS bf16_t* KT = B_ + GS_KT / 2; const LAS bf16_t* AQ = B_ + GS_AQ / 2; const LAS bf16_t* Ul = B_ + GS_U / 2;
                const float dec = DECL[n];
                const size_t m0 = (size_t)b * LP + (size_t)n * 64;
                f32x4 vn[4], o[4];
#pragma unroll
                for (int mt = 0; mt < 4; ++mt) { vn[mt] = (f32x4){0.f, 0.f, 0.f, 0.f}; o[mt] = (f32x4){0.f, 0.f, 0.f, 0.f}; }
                bf16x8 sb[4], wf[4][4], qf[4][4];
#pragma unroll
                for (int ks = 0; ks < 4; ++ks) sb[ks] = *(const LAS bf16x8*)(ST + fr * 136 + 32 * ks + 8 * fq);
#pragma unroll
                for (int ks = 0; ks < 4; ++ks)
#pragma unroll
                    for (int mt = 0; mt < 4; ++mt) wf[ks][mt] = *(const LAS bf16x8*)(Wl + (mt * 16 + fr) * 136 + 32 * ks + 8 * fq);
#pragma unroll
                for (int ks = 0; ks < 4; ++ks)
#pragma unroll
                    for (int mt = 0; mt < 4; ++mt) qf[ks][mt] = *(const LAS bf16x8*)(QD + (mt * 16 + fr) * 136 + 32 * ks + 8 * fq);
                v2u uu[4];
#pragma unroll
                for (int mt = 0; mt < 4; ++mt) uu[mt] = *(const LAS v2u*)(Ul + (mt * 16 + fr) * 40 + w * 16 + 4 * fq);
#pragma unroll
                for (int ks = 0; ks < 4; ++ks)
#pragma unroll
                    for (int mt = 0; mt < 4; ++mt) vn[mt] = mmaT(wf[ks][mt], sb[ks], vn[mt]);
                bf16x8 kf[8][2];
#pragma unroll
                for (int nt = 0; nt < 8; ++nt)
#pragma unroll
                    for (int ks = 0; ks < 2; ++ks) kf[nt][ks] = *(const LAS bf16x8*)(KT + (nt * 16 + fr) * 72 + 32 * ks + 8 * fq);
#pragma unroll
                for (int mt = 0; mt < 4; ++mt) {
                    const float v0 = bflo(uu[mt].x) - vn[mt][0], v1 = bfhi(uu[mt].x) - vn[mt][1], v2 = bflo(uu[mt].y) - vn[mt][2], v3 = bfhi(uu[mt].y) - vn[mt][3];
                    VN[(4 * fq + 0) * 72 + mt * 16 + fr] = (bf16_t)f2bf(v0); VN[(4 * fq + 1) * 72 + mt * 16 + fr] = (bf16_t)f2bf(v1);
                    VN[(4 * fq + 2) * 72 + mt * 16 + fr] = (bf16_t)f2bf(v2); VN[(4 * fq + 3) * 72 + mt * 16 + fr] = (bf16_t)f2bf(v3); }
#pragma unroll
                for (int ks = 0; ks < 4; ++ks)
#pragma unroll
                    for (int mt = 0; mt < 4; ++mt) o[mt] = mmaT(qf[ks][mt], sb[ks], o[mt]);
                LDSW();
                bf16x8 vb[2], af[4][2];
#pragma unroll
                for (int ks = 0; ks < 2; ++ks) vb[ks] = *(const LAS bf16x8*)(VN + fr * 72 + 32 * ks + 8 * fq);
#pragma unroll
                for (int mt = 0; mt < 4; ++mt)
#pragma unroll
                    for (int ks = 0; ks < 2; ++ks) af[mt][ks] = *(const LAS bf16x8*)(AQ + (mt * 16 + fr) * 72 + 32 * ks + 8 * fq);
#pragma unroll
                for (int nt = 0; nt < 8; ++nt) { S[nt] *= dec;
#pragma unroll
                    for (int ks = 0; ks < 2; ++ks) S[nt] = mmaT(vb[ks], kf[nt][ks], S[nt]); }
#pragma unroll
                for (int nt = 0; nt < 8; ++nt) *(LAS v2u*)(ST + fr * 136 + nt * 16 + 4 * fq) = (v2u){pk2(S[nt][0], S[nt][1]), pk2(S[nt][2], S[nt][3])};
#pragma unroll
                for (int mt = 0; mt < 4; ++mt) {
#pragma unroll
                    for (int ks = 0; ks < 2; ++ks) o[mt] = mmaT(af[mt][ks], vb[ks], o[mt]);
                    *(uint2*)(Y + (m0 + mt * 16 + fr) * D + h * 128 + e0 + w * 16 + 4 * fq) = make_uint2(pk2(o[mt][0], o[mt][1]), pk2(o[mt][2], o[mt][3])); }
                LBAR();
            }
        } else {
            LBAR();
            for (int n = 0; n < NCH; ++n) LBAR();
        }
    }
}
#undef GS_STAGE_LOAD
#undef GS_STAGE_STORE
__device__ __forceinline__ void ph_gdn_norm(const Ctx& C0, KP p) {
    const Ctx C = refresh(C0);
    const int lane = C.lane;
    bf16_t* Y = (bf16_t*)(p->ws + WS_Y); const bf16_t* P = (const bf16_t*)(p->ws + WS_P);
    for (int m = C.gw; m < MROWS; m += C.ngw) {
        bf16_t* yr = Y + (size_t)m * D + lane * 16; const bf16_t* zr = P + (size_t)m * NP1 + P1_Z + lane * 16;
        const v4u a0 = *(const v4u*)yr, a1 = *(const v4u*)(yr + 8), z0 = *(const v4u*)zr, z1 = *(const v4u*)(zr + 8);
        const unsigned aw[8] = {a0.x, a0.y, a0.z, a0.w, a1.x, a1.y, a1.z, a1.w}, zw[8] = {z0.x, z0.y, z0.z, z0.w, z1.x, z1.y, z1.z, z1.w};
        float ss = 0.f;
#pragma unroll
        for (int q = 0; q < 8; ++q) ss += bflo(aw[q]) * bflo(aw[q]) + bfhi(aw[q]) * bfhi(aw[q]);
        ss += __shfl_xor(ss, 1); ss += __shfl_xor(ss, 2); ss += __shfl_xor(ss, 4);
        const float rs = rsqrtf(ss * (1.0f / 128.0f) + NORM_EPS);
        const float* ng = p->in[21] + (lane & 7) * 16;
        unsigned ow[8];
#pragma unroll
        for (int q = 0; q < 8; ++q) ow[q] = pk2(bflo(aw[q]) * rs * ng[2 * q] * siluf_(bflo(zw[q])), bfhi(aw[q]) * rs * ng[2 * q + 1] * siluf_(bfhi(zw[q])));
        *(v4u*)yr = (v4u){ow[0], ow[1], ow[2], ow[3]}; *(v4u*)(yr + 8) = (v4u){ow[4], ow[5], ow[6], ow[7]};
    }
}

template <bool FINAL> __device__ __forceinline__ void ph_lru(const Ctx& C0, KP p, int worker, int nworkers) {
    const Ctx C = refresh(C0);
    LruW W; W.hb = -1;
#pragma unroll
    for (int q = 0; q < 4; ++q) { W.ba[q] = (bf16x8){0, 0, 0, 0, 0, 0, 0, 0}; W.bx[q] = W.ba[q]; }
    for (int it = worker; it < BATCH * NCH * LRB; it += nworkers) lru_item<FINAL>(C, p, it, W);
}
#ifndef DUP_SUB
#define DUP_SUB 0
#endif
#ifndef DUP_PHASE
#define DUP_PHASE -1
#endif
#define REP(k) for (int rep_ = 0; rep_ < ((DUP_PHASE) == (k) ? 2 : 1); ++rep_)
#define IN(k) in_ph(k)
#define SEAM(k) do { if (in_ph(k) && in_ph((k) + 1)) xcd_barrier(bar); } while (0)
template <int L> __device__ __forceinline__ void layer_phases(const Ctx& C, const XcdBarrier& bar, PG8_LAS unsigned char* ring) {
        const int base = 1 + 11 * L;
        REP(1 + 11 * L + 0) if (IN(base + 0)) {
            KP p = kp(); const int N = L ? NP1 : NP0;
            pg8::Gemm g{(const bf16_t*)(p->ws + WS_HB), (const bf16_t*)(p->ws + (L ? WS_WIN1 : WS_WIN0)), MP, N, D}; pg8::StaticOrder S; S.init(MP, N, C.G, (int)blockIdx.x);
            EpiStoreBf16 E{(bf16_t*)(p->ws + WS_P), N};
            pg8::gemm_phase<EpiStoreBf16, pg8::StaticOrder, true, true>(ring, g, S, E);
            ph_skinny(C, kp(), L);
            cvt_pull(C, kp(), L);
        }
        SEAM(base + 0);
        if constexpr (L == 0) {
            REP(1 + 11 * L + 1) if (IN(base + 1)) { for (int r2 = 0; r2 < (DUP_SUB == 3 ? 2 : 1); ++r2) ph_s5<false>(C, kp()); for (int r2 = 0; r2 < (DUP_SUB == 4 ? 2 : 1); ++r2) ph_gla_a(C, kp()); }
            SEAM(base + 1);
            REP(1 + 11 * L + 2) if (IN(base + 2)) { ph_s5_carry(C, kp()); ph_gla_b(C, kp()); }
            SEAM(base + 2);
            REP(1 + 11 * L + 3) if (IN(base + 3)) { for (int r2 = 0; r2 < (DUP_SUB == 5 ? 2 : 1); ++r2) ph_s5<true>(C, kp()); for (int r2 = 0; r2 < (DUP_SUB == 6 ? 2 : 1); ++r2) ph_gla_c(C, kp()); }
            SEAM(base + 3);
            REP(1 + 11 * L + 4) if (IN(base + 4)) {
                KP p = kp();
                pg8::Gemm g{(const bf16_t*)(p->ws + WS_Z), (const bf16_t*)(p->ws + WS_WGLU), MP, S5W, S5W}; pg8::StaticOrder S; S.init(MP, S5W, C.G, (int)blockIdx.x);
                EpiGlu E{(const bf16_t*)(p->ws + WS_Z), p->in[12], (bf16_t*)(p->ws + WS_Y)};
                pg8::gemm_phase<EpiGlu, pg8::StaticOrder, true, true>(ring, g, S, E);
            }
            SEAM(base + 4);
        } else {
            REP(1 + 11 * L + 1) if (IN(base + 1)) { for (int r2 = 0; r2 < (DUP_SUB == 7 ? 2 : 1); ++r2) ph_gdn_conv(C, kp()); for (int r2 = 0; r2 < (DUP_SUB == 8 ? 2 : 1); ++r2) ph_lru<false>(C, kp(), C.vcu, C.G); }
            SEAM(base + 1);
            REP(1 + 11 * L + 2) if (IN(base + 2)) { ph_gdn_prep(C, kp()); ph_lru_carry(C, kp()); }
            SEAM(base + 2);
            REP(1 + 11 * L + 3) if (IN(base + 3)) {
                if (C.G != 256) { ph_gdn_seq(C, kp(), C.vcu, C.G); ph_lru<true>(C, kp(), C.vcu, C.G); }
                else { const int xcd = C.vcu >> 5, j = C.vcu & 31;
                    if (j < 8) { for (int r2 = 0; r2 < (DUP_SUB == 1 ? 2 : 1); ++r2) ph_gdn_seq(C, kp(), (((j >> 2) * 8 + xcd) << 2) + (j & 3), GDN_STREAMS); }
                    else { for (int r2 = 0; r2 < (DUP_SUB == 2 ? 2 : 1); ++r2) ph_lru<true>(C, kp(), xcd * 24 + (j - 8), 192); } }
            }
            SEAM(base + 3);
            REP(1 + 11 * L + 4) if (IN(base + 4)) ph_gdn_norm(C, kp());
            SEAM(base + 4);
        }
        REP(1 + 11 * L + 5) if (IN(base + 5)) {
            KP p = kp();
            pg8::Gemm g{(const bf16_t*)(p->ws + WS_Y), (const bf16_t*)(p->ws + (L ? WS_WOUT1 : WS_WOUT0)), MP, D, D}; pg8::StaticOrder S; S.init(MP, D, C.G, (int)blockIdx.x);
            EpiStoreBf16 E{(bf16_t*)(p->ws + WS_MIX), D};
            pg8::gemm_phase<EpiStoreBf16, pg8::StaticOrder, true, true>(ring, g, S, E);
        }
        SEAM(base + 5);
        REP(1 + 11 * L + 6) if (IN(base + 6)) ph_ln1_router(C, kp(), L);
        SEAM(base + 6);
        REP(1 + 11 * L + 8) if (IN(base + 8)) {
            KP p = kp();
            const int nt = moe_build_tiles(C, (unsigned*)(p->ws + WS_CTL) + CW_CNT + L * 32);
            MoeGatherOrder S{(const volatile LAS int*)(C.lds + LDS_TILETAB), nt, 2, C.G, C.vcu, (const int*)(p->ws + WS_LISTE)};
            pg8::Gemm g{(const bf16_t*)(p->ws + WS_HB), (const bf16_t*)(p->ws + WS_MW1), 0, 0, D}; EpiMoe1 E{(bf16_t*)(p->ws + WS_HH), (const int*)(p->ws + WS_LISTE), (const float*)(p->ws + WS_TOKW)};
            pg8::gemm_phase<EpiMoe1, MoeGatherOrder, true, true>(ring, g, S, E);
        }
        SEAM(base + 8);
        REP(1 + 11 * L + 9) if (IN(base + 9)) {
            KP p = kp();
            const int nt = moe_build_tiles(C, (unsigned*)(p->ws + WS_CTL) + CW_CNT + L * 32);
            MoeOrder S{(const volatile LAS int*)(C.lds + LDS_TILETAB), nt, 8, C.G, C.vcu};
            int kk = MOE_FF; asm volatile("" : "+s"(kk));
            pg8::Gemm g{(const bf16_t*)(p->ws + WS_HH), (const bf16_t*)(p->ws + WS_MW2), 0, 0, kk}; EpiMoe2 E{(bf16_t*)(p->ws + WS_XS)};
            pg8::gemm_phase<EpiMoe2, MoeOrder, true, true>(ring, g, S, E);
        }
        SEAM(base + 9);
        REP(1 + 11 * L + 10) if (IN(base + 10)) ph_ln2(C, kp(), L);
        SEAM(base + 10);
    }
__global__ void __launch_bounds__(NTHREADS, 2) mk(Args a_unused) {
    extern __shared__ __attribute__((aligned(16))) unsigned char shm[];
    Ctx C; C.lds = (LAS unsigned char*)shm; C.tid = threadIdx.x; C.lane = C.tid & 63; C.wave = __builtin_amdgcn_readfirstlane(C.tid >> 6);
    C.G = gridDim.x; { const int bx = blockIdx.x; C.vcu = (C.G % 8 == 0) ? (bx % 8) * (C.G / 8) + bx / 8 : bx; }
    C.gw = C.vcu * NWAVES + C.wave; C.ngw = C.G * NWAVES;
    for (int u = C.tid; u < (LDS_BYTES - LDSCTL_OFF) / 4; u += NTHREADS) ((LAS unsigned*)(C.lds + LDSCTL_OFF))[u] = 0u;
    __syncthreads();
    XcdBarrier bar;
    { KA a = kargs(); bar = xcd_barrier_post((unsigned*)(a->p.ws + WS_CTL) + CW_BAR + a->li * XCD_BAR_WORDS, (volatile LAS unsigned*)(C.lds + LDSCTL_OFF)); }
    PG8_LAS unsigned char* ring = (PG8_LAS unsigned char*)shm;

    REP(0) if (IN(0)) ph_prologue(C, kp());
    SEAM(0);
    layer_phases<0>(C, bar, ring);
    layer_phases<1>(C, bar, ring);
}
#undef IN
#undef SEAM
#ifndef FUSE
#define FUSE 1
#endif
static void launch_mk(const Ptrs& p, int lo, int hi, int& li, int grid, hipStream_t s) {
    Args a{}; a.p = p; a.ph_lo = lo; a.ph_hi = hi; a.li = li++; a.pad = 0;
    if (FUSE) { hipLaunchKernelGGL(mk, dim3(grid), dim3(NTHREADS), LDS_BYTES, s, a); }
    else for (int k = lo; k < hi; ++k) { a.ph_lo = k; a.ph_hi = k + 1; a.li = li++; hipLaunchKernelGGL(mk, dim3(grid), dim3(NTHREADS), LDS_BYTES, s, a); }
}
extern "C" void kernel_launch(void* const* d_in, const int* in_sizes, int n_in, void* d_out, int out_size, void* d_ws, size_t ws_size, hipStream_t stream) {
    static int grid = 0;
    if (grid == 0) {
        if (n_in != 41 || ws_size < WS_END || out_size != BATCH * SEQ * D) { fprintf(stderr, "kernel_launch: unexpected shapes n_in %d ws %zu (need %zu) out %d\n", n_in, ws_size, (size_t)WS_END, out_size); grid = -1; }
        else {
            int dev = 0, cus = 0;
            if (hipGetDevice(&dev) != hipSuccess || hipDeviceGetAttribute(&cus, hipDeviceAttributeMultiprocessorCount, dev) != hipSuccess) { grid = -1; }
            else if (hipFuncSetAttribute((const void*)mk, hipFuncAttributeMaxDynamicSharedMemorySize, LDS_BYTES) != hipSuccess) { fprintf(stderr, "kernel_launch: hipFuncSetAttribute failed\n"); grid = -1; }
            else grid = cus;
        }
    }
    if (grid < 0) return;
    Ptrs p{};
    for (int i = 0; i < 41; ++i) p.in[i] = (const float*)d_in[i];
    p.out = (float*)d_out; p.ws = (unsigned char*)d_ws;
    hipMemsetAsync((char*)d_ws + WS_CTL, 0, 1 * MiB, stream);
    int li = 0;
    launch_mk(p, 0, NPHASES, li, grid, stream);
}
```

```cpp
#include <hip/hip_runtime.h>
#include <cstdio>
#include <cstdint>

typedef unsigned short bf16_t;
typedef unsigned v4u __attribute__((ext_vector_type(4)));
typedef unsigned v2u __attribute__((ext_vector_type(2)));

constexpr int D = 2048, BATCH = 2, SEQ = 8192, NMETA = 16, CHUNK = 64;
constexpr int PADF = CHUNK - NMETA;
constexpr int LP = SEQ + NMETA + PADF;
constexpr int NCH = LP / CHUNK;
constexpr int MROWS = BATCH * LP;
constexpr int MP = 16640;
constexpr int NP0 = 4096, NP1 = 6144;
constexpr int S5W = 1024, S5G = 64, S5P = 64, S5C = 16;
constexpr int GLH = 4, GLDK = 128, GLDV = 256, GLR = 16;
constexpr int GDH = 8, GDK = 128, GDV = 128;
constexpr int LRW = 1024, LRB = 8, LRBW = 128;
constexpr int MOE_G = 4, MOE_E = 8, MOE_NE = 32, MOE_FF = 256;
constexpr float DN_ALPHA = 1.41421356237309515f;
constexpr float LN_EPS = 1e-5f, NORM_EPS = 1e-6f;

constexpr int P0_U = 0, P0_Q = 1024, P0_K = 1536, P0_V = 2048, P0_R = 3072;
constexpr int P1_Q = 0, P1_K = 1024, P1_V = 2048, P1_Z = 3072, P1_LX = 4096, P1_LG = 5120;

constexpr size_t MiB = 1u << 20;
constexpr size_t WS_CTL = 0;
constexpr size_t WS_WIN0 = 1 * MiB;
constexpr size_t WS_WIN1 = WS_WIN0 + (size_t)NP0 * D * 2;
constexpr size_t WS_WOUT0 = WS_WIN1 + (size_t)NP1 * D * 2;
constexpr size_t WS_WOUT1 = WS_WOUT0 + (size_t)D * D * 2;
constexpr size_t WS_WGLU = WS_WOUT1 + (size_t)D * D * 2;
constexpr size_t WS_S5C = WS_WGLU + (size_t)S5W * S5W * 2;
constexpr size_t WS_WR = WS_S5C + 1 * MiB;
constexpr size_t WS_S5B = WS_S5C + 2 * MiB;
constexpr size_t WS_WSK3 = WS_S5C + 3 * MiB + 512 * 1024;
constexpr size_t WS_WLRU = WS_S5C + 3 * MiB;
constexpr size_t WS_MW1 = WS_S5C + 4 * MiB;
constexpr size_t WS_MW2 = WS_MW1 + (size_t)MOE_NE * 512 * D * 2;
constexpr size_t WS_H = WS_MW2 + (size_t)MOE_NE * D * MOE_FF * 2;
constexpr size_t WS_HB = WS_H + (size_t)MP * D * 4;
constexpr size_t WS_P = WS_HB + (size_t)MP * D * 2;
constexpr size_t WS_Z = WS_P + (size_t)MP * NP0 * 2;
constexpr size_t WS_Y = WS_P + (size_t)MP * NP1 * 2;
constexpr size_t WS_SK = WS_Y + (size_t)MP * D * 2;
constexpr size_t WS_TOKE = WS_SK + (size_t)MP * 16 * 4;
constexpr size_t WS_TOKW = WS_TOKE + (size_t)MROWS * 2 * 4;
constexpr size_t WS_TOKS = WS_TOKW + (size_t)MROWS * 2 * 4;
constexpr int XS_ROWS = 2 * (BATCH * (SEQ + NMETA)) + 256;
constexpr size_t WS_XW = WS_TOKS + (size_t)MROWS * 2 * 4;
constexpr size_t WS_LRUF = WS_XW + (size_t)XS_ROWS * 4;
constexpr size_t WS_END = WS_LRUF + 3 * MiB;
constexpr size_t WS_S5X = WS_Z + (size_t)MP * S5W * 2;
constexpr size_t WS_GDEC = WS_S5X + 9 * MiB;
static_assert(WS_GDEC + 1 * MiB <= WS_P + (size_t)MP * NP1 * 2, "layer-0 scratch inside the P region");
static_assert((size_t)BATCH * NCH * GLH * 256 * 128 * 2 <= (size_t)MP * D * 2, "GLA states fit in HB");
constexpr size_t WS_LISTE = WS_LRUF;
static_assert((size_t)MOE_NE * MROWS * 4 <= 3 * MiB, "expert lists fit in the LRUF region");
constexpr size_t WS_MIX = WS_P;
constexpr size_t WS_XS = WS_P;
constexpr size_t WS_HH = WS_XS + (size_t)XS_ROWS * D * 2;
static_assert(WS_HH + (size_t)XS_ROWS * MOE_FF * 2 <= WS_Y, "MoE temporaries fit in the P region");
constexpr int CW_CNT = 64;
constexpr int CW_BAR = 4096;
constexpr int S5C_ABAR = 0;
constexpr int S5C_BBAR = S5C_ABAR + 64 * 64 * 2;
constexpr int S5C_END = S5C_BBAR + 64 * 64 * 16 * 2;
constexpr int S5B_BR = 0, S5B_BI = 65536, S5B_CM = 131072;

__device__ __forceinline__ float bf2f(bf16_t b) { return __uint_as_float(((unsigned)b) << 16); }
typedef __bf16 bf16n2 __attribute__((ext_vector_type(2)));
__device__ __forceinline__ unsigned pk2(float lo, float hi) { const bf16n2 v = {(__bf16)lo, (__bf16)hi}; return __builtin_bit_cast(unsigned, v); }
__device__ __forceinline__ unsigned f2bf(float f) { return pk2(f, f) & 0xffffu; }
__device__ __forceinline__ float rcpf_(float x) { return __builtin_amdgcn_rcpf(x); }
__device__ __forceinline__ float sigmoidf_(float x) { return rcpf_(1.0f + __expf(-x)); }
__device__ __forceinline__ float siluf_(float x) { return x * sigmoidf_(x); }
__device__ __forceinline__ float softplusf_(float x) { return fmaxf(x, 0.f) + __logf(1.0f + __expf(-fabsf(x))); }
__device__ __forceinline__ float logsigmoidf_(float x) { return -softplusf_(-x); }
__device__ __forceinline__ float gelu_tanh(float x) { const float u = 0.7978845608028654f * (x + 0.044715f * x * x * x); return x * sigmoidf_(2.0f * u); }
__device__ __forceinline__ float neg_expm1f_(float x) { const float ax = -x; return ax < 0.03f ? ax * (1.0f - ax * (0.5f - ax * (1.0f / 6.0f))) : 1.0f - __expf(x); }
__device__ __forceinline__ float wave_sum(float v) {
#pragma unroll
    for (int o = 1; o < 64; o <<= 1) v += __shfl_xor(v, o);
    return v;
}
__device__ __forceinline__ bool row_valid(int m) { return m < MROWS && (m % LP) >= PADF; }

__device__ __forceinline__ void transpose_item(const float* src  , size_t ldw, bf16_t* dst  , size_t ldt, float* scr, int lane) {
#pragma unroll 8
    for (int i = 0; i < 32; ++i) { const int kk = 2 * i + (lane >> 5); scr[kk * 33 + (lane & 31)] = src[(size_t)kk * ldw + (lane & 31)]; }
    __builtin_amdgcn_s_waitcnt(0); asm volatile("" ::: "memory");
    const int c = lane & 7;
#pragma unroll
    for (int j = 0; j < 4; ++j) { const int n = (lane >> 3) + 8 * j; const float* s = scr + (8 * c) * 33 + n;
        v4u o; o.x = pk2(s[0 * 33], s[1 * 33]); o.y = pk2(s[2 * 33], s[3 * 33]); o.z = pk2(s[4 * 33], s[5 * 33]); o.w = pk2(s[6 * 33], s[7 * 33]);
        *(v4u*)(dst + (size_t)n * ldt + 8 * c) = o; }
    __builtin_amdgcn_s_waitcnt(0); asm volatile("" ::: "memory");
}
struct CvtJob { const float* src; size_t ldw; int K, ncols; bf16_t* dst; size_t ldt; };
__device__ __forceinline__ void cvt_job_items(const CvtJob& j, int item, float* scr, int lane) {
    const int nblk = j.ncols / 32, kb = item / nblk, nb = item % nblk;
    transpose_item(j.src + (size_t)(64 * kb) * j.ldw + 32 * nb, j.ldw, j.dst + (size_t)(32 * nb) * j.ldt + 64 * kb, j.ldt, scr, lane);
}
struct Ptrs {
    const float* in[41];
    float* out;
    unsigned char* ws;
};
template <class PP> __device__ __forceinline__ CvtJob static_job(PP p, int j) {
    CvtJob r;
    switch (j) {
    case 0: r = {p->in[2], 4112, D, 3072, (bf16_t*)(p->ws + WS_WIN0), D}; break;
    case 1: r = {p->in[2] + 3088, 4112, D, 1024, (bf16_t*)(p->ws + WS_WIN0) + (size_t)3072 * D, D}; break;
    case 2: r = {p->in[17], 6160, D, 4096, (bf16_t*)(p->ws + WS_WIN1), D}; break;
    case 3: r = {p->in[17] + 4112, 6160, D, 2048, (bf16_t*)(p->ws + WS_WIN1) + (size_t)4096 * D, D}; break;
    case 4: r = {p->in[16], D, D, D, (bf16_t*)(p->ws + WS_WOUT0), D}; break;
    case 5: r = {p->in[29], D, D, D, (bf16_t*)(p->ws + WS_WOUT1), D}; break;
    case 6: r = {p->in[11], S5W, S5W, S5W, (bf16_t*)(p->ws + WS_WGLU), S5W}; break;
    default: { const int q = j - 7, which = q >> 3, hb = q & 7;
        r = {p->in[which ? 26 : 24] + (size_t)hb * 128 * 128, 128, 128, 128, (bf16_t*)(p->ws + WS_WLRU) + (size_t)which * LRB * 128 * 128 + (size_t)hb * 128 * 128, 128}; } break;
    }
    return r;
}
template <class PP> __device__ __forceinline__ CvtJob moe_job(PP p, int L, int j) {
    const int e = j / 5, t = j % 5; CvtJob r;
    const size_t eoff = ((size_t)L * MOE_NE + e) * (size_t)D * MOE_FF;
    bf16_t* w1 = (bf16_t*)(p->ws + WS_MW1) + (size_t)e * 512 * D; bf16_t* w2 = (bf16_t*)(p->ws + WS_MW2) + (size_t)e * D * MOE_FF;
    if (t < 2) r = {p->in[34] + eoff + 128 * t, MOE_FF, D, 128, w1 + (size_t)(256 * t) * D, D};
    else if (t < 4) r = {p->in[35] + eoff + 128 * (t - 2), MOE_FF, D, 128, w1 + (size_t)(256 * (t - 2) + 128) * D, D};
    else r = {p->in[36] + eoff, D, MOE_FF, D, w2, MOE_FF};
    return r;
}
__global__ __launch_bounds__(256) void k_cvt_static(Ptrs p) {
    __shared__ float scr[4][64 * 33];
    const int lane = threadIdx.x & 63, w = threadIdx.x >> 6, gw = blockIdx.x * 4 + w, ngw = gridDim.x * 4;
    for (int j = 0; j < 7; ++j) { const CvtJob job = static_job(&p, j); const int nit = (job.K / 64) * (job.ncols / 32);
        for (int it = gw; it < nit; it += ngw) cvt_job_items(job, it, scr[w], lane); }
}
__global__ __launch_bounds__(256) void k_cvt_moe(Ptrs p, int L) {
    __shared__ float scr[4][64 * 33];
    const int lane = threadIdx.x & 63, w = threadIdx.x >> 6, gw = blockIdx.x * 4 + w, ngw = gridDim.x * 4;
    for (int j = 0; j < MOE_NE * 5; ++j) { const CvtJob job = moe_job(&p, L, j); const int nit = (job.K / 64) * (job.ncols / 32);
        for (int it = gw; it < nit; it += ngw) cvt_job_items(job, it, scr[w], lane); }
}
__global__ __launch_bounds__(256) void k_build_h0(Ptrs p) {
    float* H = (float*)(p.ws + WS_H); bf16_t* HB = (bf16_t*)(p.ws + WS_HB);
    const size_t n4 = (size_t)MP * D / 4;
    for (size_t i = (size_t)blockIdx.x * 256 + threadIdx.x; i < n4; i += (size_t)gridDim.x * 256) {
        const int m = (int)(i / (D / 4)), c = (int)(i % (D / 4)) * 4;
        float4 v = make_float4(0.f, 0.f, 0.f, 0.f);
        if (m < MROWS) { const int b = m / LP, q = m % LP;
            if (q >= CHUNK) v = *(const float4*)(p.in[0] + ((size_t)b * SEQ + (q - CHUNK)) * D + c);
            else if (q >= PADF) v = *(const float4*)(p.in[1] + (size_t)(q - PADF) * D + c); }
        *(float4*)(H + (size_t)m * D + c) = v;
        uint2 o; o.x = pk2(v.x, v.y); o.y = pk2(v.z, v.w); *(uint2*)(HB + (size_t)m * D + c) = o;
    }
}
__global__ void k_s5_consts(Ptrs p) {
    const int i = blockIdx.x * blockDim.x + threadIdx.x; if (i >= S5G * S5P) return;
    const int g = i / S5P;
    float* C = (float*)(p.ws + WS_S5C);
    const float are = p.in[3][i], aim = p.in[4][i], dt = expf(p.in[5][g]);
    const float mag = expf(are * dt); float sn, cs; sincosf(aim * dt, &sn, &cs);
    const float br = mag * cs, bi = mag * sn;
    C[S5C_ABAR + 2 * i] = br; C[S5C_ABAR + 2 * i + 1] = bi;
    const float nr = br - 1.0f, ni = bi, den = are * are + aim * aim;
    const float zr = (nr * are + ni * aim) / den, zi = (ni * are - nr * aim) / den;
    for (int c = 0; c < S5C; ++c) { const float b_r = p.in[6][(size_t)i * S5C + c], b_i = p.in[7][(size_t)i * S5C + c];
        C[S5C_BBAR + ((size_t)i * S5C + c) * 2] = b_r * zr - b_i * zi; C[S5C_BBAR + ((size_t)i * S5C + c) * 2 + 1] = b_r * zi + b_i * zr; }
}

template <class Epi> __global__ __launch_bounds__(256) void k_gemm_naive(const bf16_t* A, int lda, const bf16_t* Bt, int ldb, int K, Epi epi) {
    __shared__ float As[16][65], Bs[16][65];
    const int tx = threadIdx.x & 15, ty = threadIdx.x >> 4, m0 = blockIdx.y * 64, n0 = blockIdx.x * 64;
    float acc[4][4];
#pragma unroll
    for (int i = 0; i < 4; ++i)
#pragma unroll
        for (int j = 0; j < 4; ++j) acc[i][j] = 0.f;
    for (int k0 = 0; k0 < K; k0 += 16) {
        for (int i = threadIdx.x; i < 1024; i += 256) { const int r = i >> 4, c = i & 15;
            As[c][r] = bf2f(A[(size_t)(m0 + r) * lda + k0 + c]); Bs[c][r] = bf2f(Bt[(size_t)(n0 + r) * ldb + k0 + c]); }
        __syncthreads();
#pragma unroll
        for (int kk = 0; kk < 16; ++kk) { float a[4], b[4];
#pragma unroll
            for (int i = 0; i < 4; ++i) { a[i] = As[kk][ty * 4 + i]; b[i] = Bs[kk][tx * 4 + i]; }
#pragma unroll
            for (int i = 0; i < 4; ++i)
#pragma unroll
                for (int j = 0; j < 4; ++j) acc[i][j] += a[i] * b[j]; }
        __syncthreads();
    }
#pragma unroll
    for (int i = 0; i < 4; ++i)
#pragma unroll
        for (int j = 0; j < 4; ++j) epi(m0 + ty * 4 + i, n0 + tx * 4 + j, acc[i][j]);
}
struct NEpiBf16 { bf16_t* O; int ldo; __device__ void operator()(int r, int c, float v) const { O[(size_t)r * ldo + c] = (bf16_t)f2bf(v); } };
struct NEpiGlu { const bf16_t* Z; const float* bglu; bf16_t* Y; __device__ void operator()(int r, int c, float v) const {
    const float z = bf2f(Z[(size_t)r * S5W + c]); Y[(size_t)r * D + c] = (bf16_t)f2bf(z * sigmoidf_(v + bglu[c])); } };
struct NEpiResid { float* H; __device__ void operator()(int r, int c, float v) const { float* h = H + (size_t)r * D + c; *h = DN_ALPHA * *h + v; } };

__global__ __launch_bounds__(256) void k_skinny(const float* H, const float* W, int ldw, int col0, float* SK) {
    const int lane = threadIdx.x & 63, gw = blockIdx.x * 4 + (threadIdx.x >> 6), ngw = gridDim.x * 4;
    for (int m = gw; m < MP; m += ngw) {
        float acc[16];
#pragma unroll
        for (int j = 0; j < 16; ++j) acc[j] = 0.f;
        if (row_valid(m)) {
            for (int k = lane; k < D; k += 64) { const float h = H[(size_t)m * D + k]; const float4* w = (const float4*)(W + (size_t)k * ldw + col0);
#pragma unroll
                for (int q = 0; q < 4; ++q) { const float4 x = w[q]; acc[4 * q] += h * x.x; acc[4 * q + 1] += h * x.y; acc[4 * q + 2] += h * x.z; acc[4 * q + 3] += h * x.w; } }
#pragma unroll
            for (int j = 0; j < 16; ++j) acc[j] = wave_sum(acc[j]);
        }
        if (lane < 16) { float v = 0.f;
#pragma unroll
            for (int j = 0; j < 16; ++j) v = (lane == j) ? acc[j] : v;
            SK[(size_t)m * 16 + lane] = v; }
    }
}

__global__ __launch_bounds__(256) void k_layernorm(float* H, bf16_t* HB, const float* g, const float* b, float* out) {
    const int lane = threadIdx.x & 63, gw = blockIdx.x * 4 + (threadIdx.x >> 6), ngw = gridDim.x * 4;
    for (int m = gw; m < MP; m += ngw) {
        float4* hr = (float4*)(H + (size_t)m * D); uint2* hb = (uint2*)(HB + (size_t)m * D);
        if (!row_valid(m)) { for (int j = 0; j < 8; ++j) { hr[lane + 64 * j] = make_float4(0.f, 0.f, 0.f, 0.f); hb[lane + 64 * j] = make_uint2(0u, 0u); } continue; }
        float4 v[8]; float s = 0.f;
#pragma unroll
        for (int j = 0; j < 8; ++j) { v[j] = hr[lane + 64 * j]; s += (v[j].x + v[j].y) + (v[j].z + v[j].w); }
        const float mean = wave_sum(s) * (1.0f / D); float q = 0.f;
#pragma unroll
        for (int j = 0; j < 8; ++j) { v[j].x -= mean; v[j].y -= mean; v[j].z -= mean; v[j].w -= mean; q += (v[j].x * v[j].x + v[j].y * v[j].y) + (v[j].z * v[j].z + v[j].w * v[j].w); }
        const float rstd = rsqrtf(wave_sum(q) * (1.0f / D) + LN_EPS);
        const int q_ = m % LP, bb = m / LP;
#pragma unroll
        for (int j = 0; j < 8; ++j) { const int c = (lane + 64 * j) * 4; const float4 gg = *(const float4*)(g + c), bv = *(const float4*)(b + c);
            float4 o; o.x = v[j].x * rstd * gg.x + bv.x; o.y = v[j].y * rstd * gg.y + bv.y; o.z = v[j].z * rstd * gg.z + bv.z; o.w = v[j].w * rstd * gg.w + bv.w;
            hr[lane + 64 * j] = o; hb[lane + 64 * j] = make_uint2(pk2(o.x, o.y), pk2(o.z, o.w));
            if (out && q_ >= CHUNK) *(float4*)(out + ((size_t)bb * SEQ + (q_ - CHUNK)) * D + c) = o; }
    }
}

__global__ __launch_bounds__(64) void k_s5_naive(Ptrs p) {
    __shared__ float red[64][17];
    const int lane = threadIdx.x, b = blockIdx.x / S5G, g = blockIdx.x % S5G;
    const float* C = (const float*)(p.ws + WS_S5C);
    const bf16_t* P = (const bf16_t*)(p.ws + WS_P); bf16_t* Z = (bf16_t*)(p.ws + WS_Z);
    const float ar = C[S5C_ABAR + 2 * (g * 64 + lane)], ai = C[S5C_ABAR + 2 * (g * 64 + lane) + 1];
    float bbr[16], bbi[16], cr[16], ci[16];
#pragma unroll
    for (int c = 0; c < 16; ++c) { bbr[c] = C[S5C_BBAR + ((size_t)(g * 64 + lane) * 16 + c) * 2]; bbi[c] = C[S5C_BBAR + ((size_t)(g * 64 + lane) * 16 + c) * 2 + 1];
        cr[c] = p.in[8][((size_t)g * 16 + c) * 64 + lane]; ci[c] = p.in[9][((size_t)g * 16 + c) * 64 + lane]; }
    const float dd = (lane < 16) ? p.in[10][g * 16 + lane] : 0.f;
    float sr = 0.f, si = 0.f;
    for (int q = 0; q < LP; ++q) {
        const size_t m = (size_t)b * LP + q;
        if (q < PADF) { if (lane < 16) Z[m * S5W + g * 16 + lane] = 0; continue; }
        const bf16_t* ur = P + m * NP0 + P0_U + g * 16;
        float u[16], br = 0.f, bi = 0.f;
#pragma unroll
        for (int c = 0; c < 16; ++c) { u[c] = bf2f(ur[c]); br += u[c] * bbr[c]; bi += u[c] * bbi[c]; }
        const float nr = ar * sr - ai * si + br, ni = ar * si + ai * sr + bi; sr = nr; si = ni;
#pragma unroll
        for (int c = 0; c < 16; ++c) red[lane][c] = cr[c] * sr - ci[c] * si;
        __syncthreads();
        if (lane < 16) { float y = 0.f; for (int j = 0; j < 64; ++j) y += red[j][lane];
            float uu = 0.f;
#pragma unroll
            for (int c = 0; c < 16; ++c) uu = (lane == c) ? u[c] : uu;
            y += dd * uu; Z[m * S5W + g * 16 + lane] = (bf16_t)f2bf(gelu_tanh(y)); }
        __syncthreads();
    }
}

__global__ __launch_bounds__(256) void k_gla_naive(Ptrs p) {
    __shared__ float s_q[128], s_k[128], s_eg[128], s_red[4];
    const int e = threadIdx.x, b = blockIdx.x / GLH, h = blockIdx.x % GLH, lane = e & 63, w = e >> 6;
    const bf16_t* P = (const bf16_t*)(p.ws + WS_P); const float* SK = (const float*)(p.ws + WS_SK); bf16_t* Y = (bf16_t*)(p.ws + WS_Y);
    const float* wg = p.in[13]; const float* bg = p.in[14]; const float ng = p.in[15][e];
    float S[128];
#pragma unroll
    for (int d = 0; d < 128; ++d) S[d] = 0.f;
    float wgc[16]; float bgc = 0.f;
#pragma unroll
    for (int j = 0; j < 16; ++j) wgc[j] = (e < 128) ? wg[j * 512 + h * 128 + e] : 0.f;
    if (e < 128) bgc = bg[h * 128 + e];
    for (int q = 0; q < LP; ++q) {
        const size_t m = (size_t)b * LP + q; bf16_t* yo = Y + m * D + 1024 + h * 256 + e;
        if (q < PADF) { *yo = 0; continue; }
        if (e < 128) { float lg = bgc;
#pragma unroll
            for (int j = 0; j < 16; ++j) lg += SK[m * 16 + j] * wgc[j];
            s_eg[e] = __expf(logsigmoidf_(lg) * (1.0f / 16.0f));
            s_q[e] = bf2f(P[m * NP0 + P0_Q + h * 128 + e]) * 0.08838834764831845f;
            s_k[e] = bf2f(P[m * NP0 + P0_K + h * 128 + e]); }
        __syncthreads();
        const float v = bf2f(P[m * NP0 + P0_V + h * 256 + e]);
        float o = 0.f;
#pragma unroll
        for (int d = 0; d < 128; ++d) { S[d] = S[d] * s_eg[d] + s_k[d] * v; o += s_q[d] * S[d]; }
        const float ss = wave_sum(o * o); if (lane == 0) s_red[w] = ss;
        __syncthreads();
        const float ms = (s_red[0] + s_red[1] + s_red[2] + s_red[3]) * (1.0f / 256.0f);
        const float r = bf2f(P[m * NP0 + P0_R + h * 256 + e]);
        *yo = (bf16_t)f2bf(o * rsqrtf(ms + NORM_EPS) * ng * siluf_(r));
        __syncthreads();
    }
}

__global__ __launch_bounds__(128) void k_gdn_naive(Ptrs p) {
    __shared__ float s_q[128], s_k[128], s_red[2], s_red2[2], s_red3[2];
    const int e = threadIdx.x, b = blockIdx.x / GDH, h = blockIdx.x % GDH, lane = e & 63, w = e >> 6;
    const bf16_t* P = (const bf16_t*)(p.ws + WS_P); const float* SK = (const float*)(p.ws + WS_SK); bf16_t* Y = (bf16_t*)(p.ws + WS_Y);
    const float* cw = p.in[18];
    const float alog = p.in[19][h], dtb = p.in[20][h], ng = p.in[21][e];
    const int cq = P1_Q + h * 128 + e, ck = P1_K + h * 128 + e, cv = P1_V + h * 128 + e;
    float wq[4], wk[4], wv[4];
#pragma unroll
    for (int j = 0; j < 4; ++j) { wq[j] = cw[j * 3072 + cq]; wk[j] = cw[j * 3072 + ck]; wv[j] = cw[j * 3072 + cv]; }
    float S[128];
#pragma unroll
    for (int d = 0; d < 128; ++d) S[d] = 0.f;
    for (int q = 0; q < LP; ++q) {
        const size_t m = (size_t)b * LP + q; bf16_t* yo = Y + m * D + h * 128 + e;
        if (q < PADF) { *yo = 0; continue; }
        float xq = 0.f, xk = 0.f, xv = 0.f;
#pragma unroll
        for (int j = 0; j < 4; ++j) { const bf16_t* pr = P + (m - 3 + j) * NP1; xq += wq[j] * bf2f(pr[cq]); xk += wk[j] * bf2f(pr[ck]); xv += wv[j] * bf2f(pr[cv]); }
        xq = siluf_(xq); xk = siluf_(xk); xv = siluf_(xv);
        const float sq = wave_sum(xq * xq), sk = wave_sum(xk * xk);
        if (lane == 0) { s_red[w] = sq; s_red2[w] = sk; }
        __syncthreads();
        const float nq = rsqrtf(s_red[0] + s_red[1] + NORM_EPS) * 0.08838834764831845f, nk = rsqrtf(s_red2[0] + s_red2[1] + NORM_EPS);
        s_q[e] = xq * nq; s_k[e] = xk * nk;
        __syncthreads();
        const float beta = sigmoidf_(SK[m * 16 + h]);
        const float eg = __expf(-__expf(alog) * softplusf_(SK[m * 16 + 8 + h] + dtb));
        float kS = 0.f;
#pragma unroll
        for (int d = 0; d < 128; ++d) { S[d] *= eg; kS += s_k[d] * S[d]; }
        const float dl = beta * (xv - kS);
        float o = 0.f;
#pragma unroll
        for (int d = 0; d < 128; ++d) { S[d] += s_k[d] * dl; o += s_q[d] * S[d]; }
        const float ss = wave_sum(o * o); if (lane == 0) s_red3[w] = ss;
        __syncthreads();
        const float ms = (s_red3[0] + s_red3[1]) * (1.0f / 128.0f);
        const float z = bf2f(P[m * NP1 + P1_Z + h * 128 + e]);
        *yo = (bf16_t)f2bf(o * rsqrtf(ms + NORM_EPS) * ng * siluf_(z));
        __syncthreads();
    }
}

__global__ __launch_bounds__(128) void k_lru_naive(Ptrs p) {
    __shared__ float s_x[128];
    const int j = threadIdx.x, b = blockIdx.x / LRB, hb = blockIdx.x % LRB, ch = hb * 128 + j;
    const bf16_t* P = (const bf16_t*)(p.ws + WS_P); bf16_t* Y = (bf16_t*)(p.ws + WS_Y);
    const float* cw = p.in[22]; const float cb = p.in[23][ch];
    const float* wa = p.in[24] + (size_t)hb * 128 * 128; const float* wx = p.in[26] + (size_t)hb * 128 * 128;
    const float ba = p.in[25][ch], bx = p.in[27][ch];
    const float nsp = -8.0f * softplusf_(-p.in[28][ch]);
    float w4[4];
#pragma unroll
    for (int t = 0; t < 4; ++t) w4[t] = cw[t * LRW + ch];
    float hs = 0.f;
    for (int q = 0; q < LP; ++q) {
        const size_t m = (size_t)b * LP + q; bf16_t* yo = Y + m * D + 1024 + ch;
        if (q < PADF) { *yo = 0; continue; }
        float xc = cb;
#pragma unroll
        for (int t = 0; t < 4; ++t) xc += w4[t] * bf2f(P[(m - 3 + t) * NP1 + P1_LX + ch]);
        s_x[j] = xc;
        __syncthreads();
        float ra = ba, ri = bx;
        for (int i = 0; i < 128; ++i) { const float xi = s_x[i]; ra += xi * wa[i * 128 + j]; ri += xi * wx[i * 128 + j]; }
        const float r = sigmoidf_(ra), ig = sigmoidf_(ri);
        const float la = nsp * r, a = __expf(la), bxv = sqrtf(-expm1f(2.0f * la)) * (ig * xc);
        hs = a * hs + bxv;
        const float gt = bf2f(P[m * NP1 + P1_LG + ch]);
        *yo = (bf16_t)f2bf(hs * gelu_tanh(gt));
        __syncthreads();
    }
}

__global__ __launch_bounds__(256) void k_router(const float* H, const float* wrg, const float* brg, const float* wre, const float* bre, int* toke, float* tokw) {
    const int lane = threadIdx.x & 63, gw = blockIdx.x * 4 + (threadIdx.x >> 6), ngw = gridDim.x * 4;
    for (int m = gw; m < MROWS; m += ngw) {
        if (!row_valid(m)) { if (lane < 2) { toke[m * 2 + lane] = 0; tokw[m * 2 + lane] = 0.f; } continue; }
        float acc[36];
#pragma unroll
        for (int j = 0; j < 36; ++j) acc[j] = 0.f;
        for (int k = lane; k < D; k += 64) { const float h = H[(size_t)m * D + k];
            const float4 g4 = *(const float4*)(wrg + (size_t)k * 4); acc[0] += h * g4.x; acc[1] += h * g4.y; acc[2] += h * g4.z; acc[3] += h * g4.w;
            const float4* w = (const float4*)(wre + (size_t)k * 32);
#pragma unroll
            for (int q = 0; q < 8; ++q) { const float4 x = w[q]; acc[4 + 4 * q] += h * x.x; acc[5 + 4 * q] += h * x.y; acc[6 + 4 * q] += h * x.z; acc[7 + 4 * q] += h * x.w; } }
#pragma unroll
        for (int j = 0; j < 36; ++j) acc[j] = wave_sum(acc[j]);
        if (lane == 0) {
            float lg[4];
#pragma unroll
            for (int j = 0; j < 4; ++j) lg[j] = acc[j] + brg[j];
            float best = lg[0]; int gt = 0;
#pragma unroll
            for (int j = 1; j < 4; ++j) if (lg[j] > best) { best = lg[j]; gt = j; }
            float den = 0.f;
#pragma unroll
            for (int j = 0; j < 4; ++j) den += __expf(lg[j] - best);
            const float ptop = 1.0f / den;
            float le[8];
#pragma unroll
            for (int j = 0; j < 8; ++j) { float v = 0.f, bb = 0.f;
#pragma unroll
                for (int gg = 0; gg < 4; ++gg) { v = (gt == gg) ? acc[4 + gg * 8 + j] : v; bb = (gt == gg) ? bre[gg * 8 + j] : bb; }
                le[j] = v + bb; }
            float v0 = le[0]; int e0 = 0;
#pragma unroll
            for (int j = 1; j < 8; ++j) if (le[j] > v0) { v0 = le[j]; e0 = j; }
            float v1 = -3.0e38f; int e1 = 0;
#pragma unroll
            for (int j = 0; j < 8; ++j) if (j != e0 && le[j] > v1) { v1 = le[j]; e1 = j; }
            const float x = __expf(v1 - v0), w0 = 1.0f / (1.0f + x), w1 = x / (1.0f + x);
            toke[m * 2] = gt * 8 + e0; toke[m * 2 + 1] = gt * 8 + e1; tokw[m * 2] = ptop * w0; tokw[m * 2 + 1] = ptop * w1;
        }
    }
}
__global__ __launch_bounds__(256) void k_moe_naive(Ptrs p) {
    __shared__ float s_x[D], s_h[MOE_FF];
    const int t = threadIdx.x;
    float* H = (float*)(p.ws + WS_H); const bf16_t* HB = (const bf16_t*)(p.ws + WS_HB);
    const int* toke = (const int*)(p.ws + WS_TOKE); const float* tokw = (const float*)(p.ws + WS_TOKW);
    const bf16_t* W1 = (const bf16_t*)(p.ws + WS_MW1); const bf16_t* W2 = (const bf16_t*)(p.ws + WS_MW2);
    for (int m = blockIdx.x; m < MROWS; m += gridDim.x) {
        if (!row_valid(m)) continue;
        for (int i = t; i < D; i += 256) s_x[i] = bf2f(HB[(size_t)m * D + i]);
        float out[8];
#pragma unroll
        for (int j = 0; j < 8; ++j) out[j] = 0.f;
        for (int kk = 0; kk < 2; ++kk) {
            __syncthreads();
            const int e = toke[m * 2 + kk]; const float w = tokw[m * 2 + kk];
            const bf16_t* wgr = W1 + ((size_t)e * 512 + 256 * (t >> 7) + (t & 127)) * D; const bf16_t* wur = wgr + (size_t)128 * D;
            float hg = 0.f, hu = 0.f;
            for (int d = 0; d < D; d += 8) { const v4u a = *(const v4u*)(wgr + d), c = *(const v4u*)(wur + d);
                const unsigned aw[4] = {a.x, a.y, a.z, a.w}, cw[4] = {c.x, c.y, c.z, c.w};
#pragma unroll
                for (int q = 0; q < 4; ++q) { const float x0 = s_x[d + 2 * q], x1 = s_x[d + 2 * q + 1];
                    hg += x0 * __uint_as_float(aw[q] << 16) + x1 * __uint_as_float(aw[q] & 0xffff0000u);
                    hu += x0 * __uint_as_float(cw[q] << 16) + x1 * __uint_as_float(cw[q] & 0xffff0000u); } }
            s_h[t] = siluf_(hg) * hu * w;
            __syncthreads();
#pragma unroll
            for (int j = 0; j < 8; ++j) { const bf16_t* wd = W2 + ((size_t)e * D + t + 256 * j) * MOE_FF; float a = 0.f;
                for (int f = 0; f < MOE_FF; f += 8) { const v4u x = *(const v4u*)(wd + f); const unsigned xw[4] = {x.x, x.y, x.z, x.w};
#pragma unroll
                    for (int q = 0; q < 4; ++q) a += s_h[f + 2 * q] * __uint_as_float(xw[q] << 16) + s_h[f + 2 * q + 1] * __uint_as_float(xw[q] & 0xffff0000u); }
                out[j] += a; }
        }
#pragma unroll
        for (int j = 0; j < 8; ++j) { float* hp = H + (size_t)m * D + t + 256 * j; *hp = DN_ALPHA * *hp + out[j]; }
        __syncthreads();
    }
}

namespace pg8 {
#define PG8_LAS __attribute__((address_space(3)))
typedef unsigned short bf16_t;
typedef short bf16x8 __attribute__((ext_vector_type(8)));
typedef float f32x4 __attribute__((ext_vector_type(4)));
typedef unsigned u32x4 __attribute__((ext_vector_type(4)));
constexpr int BM = 256, BK = 64, HALF = 128, HTB = HALF * BK * 2  , STAGE_BYTES = 8 * HTB, NXCD = 8, WGM = 8;

__host__ __device__ __forceinline__ int lds_byte(int r, int c) { const int st = (r >> 4) * 2 + (c >> 5), rr = r & 15, cc = c & 31, ob = rr * 64 + cc * 2; return st * 1024 + (ob ^ (((ob >> 9) & 1) << 5)); }
__host__ __device__ __forceinline__ void stage_rc(int b, int& R, int& C) { const int st = b / 1024, sb = b % 1024, swz = sb ^ (((sb >> 9) & 1) << 5); R = (st >> 1) * 16 + swz / 64; C = (st & 1) * 32 + (swz % 64) / 2; }
__host__ __device__ __forceinline__ int perm32(int rho) { const int n = rho >> 4, i = rho & 15; return 8 * (i >> 2) + 4 * n + (i & 3); }

struct Unit { int pm, pn, r0, nr, lb; };
struct Gemm { const bf16_t* A; const bf16_t* Bt; int M, N, K; };

struct StaticOrder {
    int nM, nN, nwg, G, c;
    __host__ __device__ void init(int M, int N, int G_, int c_) { nM = M / BM; nN = N / BM; nwg = nM * nN; G = G_; c = c_; }
    __host__ __device__ bool next(int i, Unit& u) const {
        const long L = (long)i * G + c; if (L >= nwg) return false;
        int wgid = (int)L; { const int q = nwg / NXCD, r = nwg % NXCD, xcd = wgid % NXCD, off = wgid / NXCD; wgid = (xcd < r ? xcd * (q + 1) : r * (q + 1) + (xcd - r) * q) + off; }
        const int nig = WGM * nN, gid = wgid / nig, fm = gid * WGM, gsz = (nM - fm) < WGM ? (nM - fm) : WGM;
        u.pm = fm + ((wgid % nig) % gsz); u.pn = (wgid % nig) / gsz; u.r0 = u.pm * BM; u.nr = BM; u.lb = 0; return true;
    }
    __device__ __forceinline__ void a_ready(const Unit&) const {}
    __device__ __forceinline__ void done(const Unit&) const {}
    static constexpr bool GATHER = false;
    __device__ __forceinline__ unsigned gather_voff(const Unit&, int, int, int) const { return 0u; }
};
__device__ __forceinline__ unsigned cvt_pk_bf16(float lo, float hi) { unsigned r; asm volatile("v_cvt_pk_bf16_f32 %0, %1, %2" : "=v"(r) : "v"(lo), "v"(hi)); return r; }
template <class Epi, class Sched, bool ALIGN_EPI = false, bool SP2 = false>
__device__ __forceinline__ void gemm_phase(PG8_LAS unsigned char* lds, const Gemm g, const Sched& S, const Epi& E) {
    int tid_ = threadIdx.x; asm volatile("" : "+v"(tid_));
    const int tid = tid_, wid = __builtin_amdgcn_readfirstlane(tid >> 6), lane = tid & 63, wr = wid >> 2, wc = wid & 3, fr = lane & 15, fq = lane >> 4;
    const int K = g.K, nt = K / BK;
    unsigned voffA[2], voffB[2]; int Rl[2], Cl[2];
#pragma unroll
    for (int i = 0; i < 2; ++i) { int R, C; stage_rc(tid * 16 + i * 8192, R, C); const int Rb = Epi::PERM ? ((R & ~31) + perm32(R & 31)) : R;
        Rl[i] = R; Cl[i] = C * 2; voffA[i] = (unsigned)(R * K + C) * 2u; voffB[i] = (unsigned)(Rb * K + C) * 2u; }
    const size_t kstep = (size_t)(BK * 2);
    const size_t hstep = (size_t)HALF * K * 2;
    const size_t tstep = 2 * hstep;
    const unsigned ldsw = (unsigned)wid * 1024u;
    const int aoff = lds_byte(wr * 64 + fr, fq * 8), boff = lds_byte(wc * 32 + fr, fq * 8);
#define PG8_SA(b, h) (((b) * 2 + (h)) * HTB)
#define PG8_SB(b, h) ((4 + (b) * 2 + (h)) * HTB)
#define PG8_STAGE(bufoff, gbase, voff) do { _Pragma("unroll") for (int _i = 0; _i < 2; ++_i) \
        __builtin_amdgcn_global_load_lds((const unsigned*)((const char*)(gbase) + (voff)[_i]), (PG8_LAS unsigned*)(lds + (bufoff) + ldsw + _i * 8192), 16, 0, 0); } while (0)
#define PG8_LDA(dst, b, h) do { _Pragma("unroll") for (int m = 0; m < 4; ++m) _Pragma("unroll") for (int k = 0; k < 2; ++k) dst[m][k] = *(const PG8_LAS bf16x8*)(lds + PG8_SA(b, h) + aoff + m * 2048 + k * 1024); } while (0)
#define PG8_LDB(dst, b, h) do { _Pragma("unroll") for (int n = 0; n < 2; ++n) _Pragma("unroll") for (int k = 0; k < 2; ++k) dst[n][k] = *(const PG8_LAS bf16x8*)(lds + PG8_SB(b, h) + boff + n * 2048 + k * 1024); } while (0)
#define PG8_MMA(ai, bj, At, Bt) do { __builtin_amdgcn_s_setprio(1); _Pragma("unroll") for (int m = 0; m < 4; ++m) _Pragma("unroll") for (int n = 0; n < 2; ++n) _Pragma("unroll") for (int k = 0; k < 2; ++k) \
        acc[ai][bj][m][n] = __builtin_amdgcn_mfma_f32_16x16x32_bf16(Bt[n][k], At[m][k], acc[ai][bj][m][n], 0, 0, 0); __builtin_amdgcn_s_setprio(0); } while (0)
#define PG8_WAIT_V(n) asm volatile("s_waitcnt vmcnt(" #n ")" ::: "memory")
#define PG8_WAIT_L(n) asm volatile("s_waitcnt lgkmcnt(" #n ")" ::: "memory")
#define PG8_BAR __builtin_amdgcn_s_barrier()
#define PG8_SCHED __builtin_amdgcn_sched_barrier(0)
    Unit cur, nxt; int ui = 0;
    if (!S.next(0, cur)) return;
    f32x4 acc[2][2][4][2];
#pragma unroll
    for (int a = 0; a < 2; ++a)
#pragma unroll
        for (int b = 0; b < 2; ++b)
#pragma unroll
            for (int m = 0; m < 4; ++m)
#pragma unroll
                for (int n = 0; n < 2; ++n) acc[a][b][m][n] = (f32x4){0.f, 0.f, 0.f, 0.f};
    bf16x8 At[4][2], B0[2][2], B1[2][2];
    constexpr bool GA = Sched::GATHER;
    const char* cA = GA ? (const char*)g.A : (const char*)g.A + (size_t)cur.r0 * (size_t)(K * 2); const char* cB = (const char*)g.Bt + (size_t)cur.pn * tstep;
    unsigned vAc[2][2], vAn[2][2];
#pragma unroll
    for (int h = 0; h < 2; ++h)
#pragma unroll
        for (int i = 0; i < 2; ++i) { vAc[h][i] = GA ? S.gather_voff(cur, h * HALF + Rl[i], Cl[i], K) : voffA[i] + (unsigned)(h * HALF * K * 2); vAn[h][i] = vAc[h][i]; }
#define PG8_VA(h) ((GA && last) ? vAn[h] : vAc[h])
    S.a_ready(cur);
    if constexpr (SP2) {
        PG8_STAGE(PG8_SB(0, 0), cB, voffB); PG8_STAGE(PG8_SB(0, 1), cB + hstep, voffB); PG8_STAGE(PG8_SA(0, 0), cA, vAc[0]); PG8_STAGE(PG8_SA(0, 1), cA, vAc[1]);
        if (wr == 1) PG8_BAR;
        PG8_WAIT_V(2); PG8_BAR;
        PG8_STAGE(PG8_SB(1, 0), cB + kstep, voffB); PG8_STAGE(PG8_SA(1, 0), cA + kstep, vAc[0]); PG8_STAGE(PG8_SB(1, 1), cB + hstep + kstep, voffB);
        PG8_WAIT_V(6); PG8_BAR;
    } else {
        PG8_STAGE(PG8_SB(0, 0), cB, voffB); PG8_STAGE(PG8_SA(0, 0), cA, voffA); PG8_STAGE(PG8_SB(0, 1), cB + hstep, voffB); PG8_STAGE(PG8_SA(0, 1), cA + hstep, voffA);
        if (wr == 1) PG8_BAR;
        PG8_WAIT_V(4); PG8_BAR;
        PG8_STAGE(PG8_SB(1, 0), cB + kstep, voffB); PG8_STAGE(PG8_SA(1, 0), cA + kstep, voffA); PG8_STAGE(PG8_SB(1, 1), cB + hstep + kstep, voffB);
        PG8_WAIT_V(6); PG8_BAR;
    }
    for (;;) {
        const bool has_next = S.next(ui + 1, nxt);
        const char* nA = GA ? cA : (has_next ? (const char*)g.A + (size_t)nxt.r0 * (size_t)(K * 2) : cA); const char* nB = has_next ? (const char*)g.Bt + (size_t)nxt.pn * tstep : cB;
        for (int t = 0; t < nt; t += 2) {
            const bool last = (t == nt - 2);
            const char* a1 = cA + (size_t)(t + 1) * kstep;
            const char* a2 = last ? nA : cA + (size_t)(t + 2) * kstep; const char* b2 = last ? nB : cB + (size_t)(t + 2) * kstep;
            const char* a3 = a2 + kstep; const char* b3 = b2 + kstep;
            if (last && has_next) { S.a_ready(nxt);
                if constexpr (GA) {
#pragma unroll
                    for (int h = 0; h < 2; ++h)
#pragma unroll
                        for (int i = 0; i < 2; ++i) vAn[h][i] = S.gather_voff(nxt, h * HALF + Rl[i], Cl[i], K); } }
            else if (GA && last) {
#pragma unroll
                for (int h = 0; h < 2; ++h)
#pragma unroll
                    for (int i = 0; i < 2; ++i) vAn[h][i] = vAc[h][i]; }
            if constexpr (SP2) {
            PG8_LDB(B0, 0, 0); PG8_LDB(B1, 0, 1); PG8_SCHED; PG8_LDA(At, 0, 0); PG8_STAGE(PG8_SA(1, 1), a1, vAc[1]);
            PG8_WAIT_V(8); PG8_WAIT_L(0); PG8_BAR; PG8_MMA(0, 0, At, B0); PG8_MMA(0, 1, At, B1); PG8_BAR; PG8_SCHED;
            PG8_LDA(At, 0, 1); PG8_STAGE(PG8_SB(0, 0), b2, voffB); PG8_STAGE(PG8_SB(0, 1), b2 + hstep, voffB); PG8_STAGE(PG8_SA(0, 0), a2, PG8_VA(0));
            PG8_WAIT_V(8); PG8_WAIT_L(0); PG8_BAR; PG8_MMA(1, 0, At, B0); PG8_MMA(1, 1, At, B1); PG8_BAR; PG8_SCHED;
            PG8_LDB(B0, 1, 0); PG8_LDB(B1, 1, 1); PG8_SCHED; PG8_LDA(At, 1, 0); PG8_STAGE(PG8_SA(0, 1), a2, PG8_VA(1));
            PG8_WAIT_V(8); PG8_WAIT_L(0); PG8_BAR; PG8_MMA(0, 0, At, B0); PG8_MMA(0, 1, At, B1); PG8_BAR; PG8_SCHED;
            PG8_LDA(At, 1, 1); PG8_STAGE(PG8_SB(1, 0), b3, voffB); PG8_STAGE(PG8_SB(1, 1), b3 + hstep, voffB); PG8_STAGE(PG8_SA(1, 0), a3, PG8_VA(0));
            PG8_WAIT_V(8); PG8_WAIT_L(0); PG8_BAR; PG8_MMA(1, 0, At, B0); PG8_MMA(1, 1, At, B1); PG8_BAR; PG8_SCHED;
            } else {
            PG8_LDB(B0, 0, 0); PG8_SCHED; PG8_LDA(At, 0, 0); PG8_STAGE(PG8_SA(1, 1), a1 + hstep, voffA);
            PG8_WAIT_L(8); PG8_BAR; PG8_WAIT_L(0); PG8_MMA(0, 0, At, B0); PG8_BAR; PG8_SCHED;
            PG8_LDB(B1, 0, 1); PG8_STAGE(PG8_SB(0, 0), b2, voffB);
            PG8_BAR; PG8_WAIT_L(0); PG8_MMA(0, 1, At, B1); PG8_BAR;
            PG8_LDA(At, 0, 1); PG8_STAGE(PG8_SA(0, 0), a2, voffA);
            PG8_BAR; PG8_WAIT_L(0); PG8_MMA(1, 0, At, B0); PG8_BAR; PG8_SCHED;
            PG8_STAGE(PG8_SB(0, 1), b2 + hstep, voffB);
            PG8_WAIT_V(6); PG8_BAR; PG8_MMA(1, 1, At, B1); PG8_BAR;
            PG8_LDB(B0, 1, 0); PG8_SCHED; PG8_LDA(At, 1, 0); PG8_STAGE(PG8_SA(0, 1), a2 + hstep, voffA);
            PG8_WAIT_L(8); PG8_BAR; PG8_WAIT_L(0); PG8_MMA(0, 0, At, B0); PG8_BAR; PG8_SCHED;
            PG8_LDB(B1, 1, 1); PG8_STAGE(PG8_SB(1, 0), b3, voffB);
            PG8_BAR; PG8_WAIT_L(0); PG8_MMA(0, 1, At, B1); PG8_BAR;
            PG8_LDA(At, 1, 1); PG8_STAGE(PG8_SA(1, 0), a3, voffA);
            PG8_BAR; PG8_WAIT_L(0); PG8_MMA(1, 0, At, B0); PG8_BAR; PG8_SCHED;
            PG8_STAGE(PG8_SB(1, 1), b3 + hstep, voffB);
            PG8_WAIT_V(6); PG8_BAR; PG8_MMA(1, 1, At, B1); PG8_BAR;
            }
        }
        if constexpr (ALIGN_EPI) { if (wr == 0) PG8_BAR; }
        if constexpr (!Epi::AFTER_DRAIN) { E(acc, cur, wr, wc, fr, fq); S.done(cur); }
        if (!has_next) break;
#pragma unroll
        for (int a = 0; a < 2; ++a)
#pragma unroll
            for (int b = 0; b < 2; ++b)
#pragma unroll
                for (int m = 0; m < 4; ++m)
#pragma unroll
                    for (int n = 0; n < 2; ++n) acc[a][b][m][n] = (f32x4){0.f, 0.f, 0.f, 0.f};
        cur = nxt; cA = nA; cB = nB; ++ui;
#pragma unroll
        for (int h = 0; h < 2; ++h)
#pragma unroll
            for (int i = 0; i < 2; ++i) vAc[h][i] = vAn[h][i];
        if constexpr (ALIGN_EPI) { if (wr == 1) PG8_BAR; }
    }
    PG8_WAIT_V(0);
    if constexpr (!ALIGN_EPI) { if (wr == 0) PG8_BAR; }
    PG8_BAR;
    if constexpr (Epi::AFTER_DRAIN) { E.fused(acc, cur, wr, wc, fr, fq, lds, wid, lane); S.done(cur); }
#undef PG8_SA
#undef PG8_VA
#undef PG8_SB
#undef PG8_STAGE
#undef PG8_LDA
#undef PG8_LDB
#undef PG8_MMA
#undef PG8_WAIT_V
#undef PG8_WAIT_L
#undef PG8_BAR
#undef PG8_SCHED
}
}
#define GAS __attribute__((address_space(1)))
#define LAS __attribute__((address_space(3)))
typedef float f32x4 __attribute__((ext_vector_type(4)));
typedef short bf16x8 __attribute__((ext_vector_type(8)));
constexpr int NWAVES = 8, NTHREADS = 512;
constexpr int LDS_BYTES = 163840, LDSCTL_OFF = LDS_BYTES - 4096, RING_BYTES = LDSCTL_OFF;
constexpr int LDS_TILETAB = LDSCTL_OFF + 256;

#define XB_TMO      128
#define XB_XCNT(j)  (256  + 64 * (j))
#define XB_XSUB(j)  (1280 + 64 * (j))
#define XB_XGEN(j)  (2304 + 64 * (j))
#define XB_TOP      3328
#define XB_TOPGEN   3392
#define XCD_BAR_WORDS 3456
#define XB_SPIN_CAP (1u << 18)
__device__ __forceinline__ unsigned xb_ld(unsigned* p)              { return __hip_atomic_load(p, __ATOMIC_RELAXED, __HIP_MEMORY_SCOPE_AGENT); }
__device__ __forceinline__ unsigned xb_add(unsigned* p, unsigned v) { return __hip_atomic_fetch_add(p, v, __ATOMIC_RELAXED, __HIP_MEMORY_SCOPE_AGENT); }
__device__ __forceinline__ unsigned xb_xcc_id() { return (unsigned)__builtin_amdgcn_s_getreg((3 << 11) | 20) & 0xFu; }
#define XB_SPIN(cond, bar) do { unsigned _sp = 0; while (cond) { __builtin_amdgcn_s_sleep(1); \
    if ((++_sp & 255u) == 0u) { if (xb_ld(&(bar)[XB_TMO])) break; if (_sp > XB_SPIN_CAP) { atomicAdd(&(bar)[XB_TMO], 1u); break; } } } } while (0)
struct XcdBarrier { unsigned* bar; unsigned x; volatile LAS unsigned* st; };
__device__ __forceinline__ XcdBarrier xcd_barrier_post(unsigned* bar, volatile LAS unsigned* st) {
    XcdBarrier b; b.bar = bar; b.x = xb_xcc_id(); b.st = st;
    if (threadIdx.x == 0) (void)xb_add(&bar[XB_XCNT(b.x)], 1u);
    return b;
}
__device__ __forceinline__ void xcd_barrier_complete(unsigned* bar, unsigned x, unsigned& nloc, unsigned& nx) {
    const unsigned G = gridDim.x * gridDim.y * gridDim.z;
    unsigned sum, cnt, mine, sp = 0u;
    for (;;) {
        sum = 0u; cnt = 0u; mine = 0u;
#pragma unroll
        for (unsigned j = 0; j < 16; ++j) { const unsigned c = xb_ld(&bar[XB_XCNT(j)]); sum += c; cnt += (c > 0u) ? 1u : 0u; mine = (j == x) ? c : mine; }
        if (sum == G) break;
        __builtin_amdgcn_s_sleep(1);
        if ((++sp & 255u) == 0u) { if (xb_ld(&bar[XB_TMO])) break; if (sp > XB_SPIN_CAP) { atomicAdd(&bar[XB_TMO], 1u); break; } }
    }
    nloc = mine > 0u ? mine : 1u; nx = cnt > 0u ? cnt : 1u;
}
__device__ __forceinline__ void xcd_barrier(const XcdBarrier& b) {
    asm volatile("s_waitcnt vmcnt(0)" ::: "memory");
    __syncthreads();
    if (threadIdx.x == 0) {
        unsigned* bar = b.bar;
        __builtin_amdgcn_s_waitcnt(0);
        unsigned nloc = b.st[0], nx = b.st[1];
        if (nloc == 0u) { xcd_barrier_complete(bar, b.x, nloc, nx); b.st[0] = nloc; b.st[1] = nx; }
        const unsigned old = xb_add(&bar[XB_XSUB(b.x)], 1u);
        const unsigned gen = old / nloc;
        if (old + 1u == (gen + 1u) * nloc) {
            __builtin_amdgcn_fence(__ATOMIC_RELEASE, "agent");
            asm volatile("s_waitcnt vmcnt(0)" ::: "memory");
            const unsigned og = xb_add(&bar[XB_TOP], 1u);
            const unsigned tg = og / nx;
            if (og + 1u == (tg + 1u) * nx) xb_add(&bar[XB_TOPGEN], 1u);
            else XB_SPIN(xb_ld(&bar[XB_TOPGEN]) == tg, bar);
            __builtin_amdgcn_fence(__ATOMIC_ACQUIRE, "agent");
            xb_add(&bar[XB_XGEN(b.x)], 1u);
            asm volatile("s_waitcnt vmcnt(0)" ::: "memory");
        } else {
            XB_SPIN(xb_ld(&bar[XB_XGEN(b.x)]) == gen, bar);
            __builtin_amdgcn_fence(__ATOMIC_ACQUIRE, "agent");
            asm volatile("s_waitcnt vmcnt(0)" ::: "memory");
        }
    }
    __syncthreads();
}

struct Ctx { LAS unsigned char* lds; int tid, lane, wave, vcu, G, gw, ngw; };
__device__ __forceinline__ Ctx refresh(const Ctx& C0) { Ctx C = C0; int t = threadIdx.x; asm volatile("" : "+v"(t)); C.tid = t; C.lane = t & 63; C.wave = __builtin_amdgcn_readfirstlane(t >> 6); C.gw = C.vcu * 8 + C.wave; return C; }

using pg8::cvt_pk_bf16;
struct EpiStoreBf16 {
    static constexpr bool PERM = false, AFTER_DRAIN = false;
    bf16_t* O; int ldc;
    __device__ __forceinline__ void operator()(const f32x4 (&acc)[2][2][4][2], const pg8::Unit& u, int wr, int wc, int fr, int fq) const {
        const int row0 = u.r0 + wr * 64 + fr, col0 = u.pn * 256 + wc * 32 + 4 * fq;
#pragma unroll
        for (int ai = 0; ai < 2; ++ai)
#pragma unroll
            for (int m = 0; m < 4; ++m) { bf16_t* rowp = (bf16_t*)((char*)O + ((unsigned)(row0 + ai * 128 + m * 16) * (unsigned)(ldc * 2) + (unsigned)(col0 * 2)));
#pragma unroll
                for (int bj = 0; bj < 2; ++bj)
#pragma unroll
                    for (int n = 0; n < 2; ++n) { const f32x4 v = acc[ai][bj][m][n]; uint2 w; w.x = cvt_pk_bf16(v[0], v[1]); w.y = cvt_pk_bf16(v[2], v[3]); *(uint2*)(rowp + bj * 128 + n * 16) = w; } }
    }
};
struct EpiGlu {
    static constexpr bool PERM = false, AFTER_DRAIN = false;
    const bf16_t* Z; const float* bglu; bf16_t* Y;
    __device__ __forceinline__ void operator()(const f32x4 (&acc)[2][2][4][2], const pg8::Unit& u, int wr, int wc, int fr, int fq) const {
        const int row0 = u.r0 + wr * 64 + fr, col0 = u.pn * 256 + wc * 32 + 4 * fq;
#pragma unroll
        for (int bj = 0; bj < 2; ++bj)
#pragma unroll
            for (int n = 0; n < 2; ++n) { const int c = col0 + bj * 128 + n * 16; const f32x4 bv = *(const f32x4*)(bglu + c);
#pragma unroll
                for (int ai = 0; ai < 2; ++ai)
#pragma unroll
                    for (int m = 0; m < 4; ++m) { const size_t r = (size_t)(row0 + ai * 128 + m * 16); const uint2 zz = *(const uint2*)(Z + r * S5W + c);
                        const f32x4 v = acc[ai][bj][m][n] + bv;
                        const float z0 = __uint_as_float(zz.x << 16), z1 = __uint_as_float(zz.x & 0xffff0000u), z2 = __uint_as_float(zz.y << 16), z3 = __uint_as_float(zz.y & 0xffff0000u);
                        uint2 w; w.x = cvt_pk_bf16(z0 * sigmoidf_(v[0]), z1 * sigmoidf_(v[1])); w.y = cvt_pk_bf16(z2 * sigmoidf_(v[2]), z3 * sigmoidf_(v[3]));
                        *(uint2*)(Y + r * D + c) = w; } }
    }
};
struct EpiResid {
    static constexpr bool PERM = false, AFTER_DRAIN = false;
    float* H;
    __device__ __forceinline__ void operator()(const f32x4 (&acc)[2][2][4][2], const pg8::Unit& u, int wr, int wc, int fr, int fq) const {
        const int row0 = u.r0 + wr * 64 + fr, col0 = u.pn * 256 + wc * 32 + 4 * fq;
#pragma unroll
        for (int ai = 0; ai < 2; ++ai)
#pragma unroll
            for (int m = 0; m < 4; ++m) { float* rowp = (float*)((char*)H + ((unsigned)(row0 + ai * 128 + m * 16) * (unsigned)(D * 4) + (unsigned)(col0 * 4)));
#pragma unroll
                for (int bj = 0; bj < 2; ++bj)
#pragma unroll
                    for (int n = 0; n < 2; ++n) { f32x4* q = (f32x4*)(rowp + bj * 128 + n * 16); *q = *q * DN_ALPHA + acc[ai][bj][m][n]; } }
    }
};
struct EpiMoe1 {
    static constexpr bool PERM = false, AFTER_DRAIN = false;
    bf16_t* HH; const int* list; const float* tokw;
    __device__ __forceinline__ void operator()(const f32x4 (&acc)[2][2][4][2], const pg8::Unit& u, int wr, int wc, int fr, int fq) const {
        const int f0 = (u.pn & 1) * 128 + wc * 32 + 4 * fq;
#pragma unroll
        for (int ai = 0; ai < 2; ++ai)
#pragma unroll
            for (int m = 0; m < 4; ++m) { const int lr = ai * 128 + wr * 64 + m * 16 + fr;
                if (lr < u.nr) { const unsigned r = (unsigned)(u.r0 + lr); const float w = tokw[list[u.lb + lr]];
#pragma unroll
                    for (int n = 0; n < 2; ++n) { const f32x4 g = acc[ai][0][m][n], up = acc[ai][1][m][n];
                        uint2 o; o.x = cvt_pk_bf16(siluf_(g[0]) * up[0] * w, siluf_(g[1]) * up[1] * w); o.y = cvt_pk_bf16(siluf_(g[2]) * up[2] * w, siluf_(g[3]) * up[3] * w);
                        *(uint2*)((char*)HH + (r * (unsigned)(MOE_FF * 2) + (unsigned)((f0 + n * 16) * 2))) = o; } } }
    }
};
struct EpiMoe2 {
    static constexpr bool PERM = false, AFTER_DRAIN = false;
    bf16_t* YS;
    __device__ __forceinline__ void operator()(const f32x4 (&acc)[2][2][4][2], const pg8::Unit& u, int wr, int wc, int fr, int fq) const {
        const int col0 = (u.pn & 7) * 256 + wc * 32 + 4 * fq;
#pragma unroll
        for (int ai = 0; ai < 2; ++ai)
#pragma unroll
            for (int m = 0; m < 4; ++m) { const int lr = ai * 128 + wr * 64 + m * 16 + fr; const int row = (lr < u.nr) ? (u.r0 + lr) : (XS_ROWS - 1);
                bf16_t* rowp = (bf16_t*)((char*)YS + ((unsigned)row * (unsigned)(D * 2) + (unsigned)(col0 * 2)));
#pragma unroll
                for (int bj = 0; bj < 2; ++bj)
#pragma unroll
                    for (int n = 0; n < 2; ++n) { const f32x4 v = acc[ai][bj][m][n]; uint2 w; w.x = cvt_pk_bf16(v[0], v[1]); w.y = cvt_pk_bf16(v[2], v[3]); *(uint2*)(rowp + bj * 128 + n * 16) = w; } }
    }
};
struct MoeOrder {
    static constexpr bool GATHER = false;
    __device__ __forceinline__ unsigned gather_voff(const pg8::Unit&, int, int, int) const { return 0u; }
    const volatile LAS int* tab; int ntiles, npn, G, c;
    __device__ __forceinline__ bool next(int i, pg8::Unit& u) const {
        const int L = i * G + c; if (L >= ntiles * npn) return false;
        const int t = L / npn, pn = L % npn;
        u.pm = t; u.pn = __builtin_amdgcn_readfirstlane(tab[t]) * npn + pn; u.r0 = __builtin_amdgcn_readfirstlane(tab[176 + t]); u.nr = __builtin_amdgcn_readfirstlane(tab[352 + t]); u.lb = 0; return true;
    }
    __device__ __forceinline__ void a_ready(const pg8::Unit&) const {}
    __device__ __forceinline__ void done(const pg8::Unit&) const {}
};
struct MoeGatherOrder {
    static constexpr bool GATHER = true;
    const volatile LAS int* tab; int ntiles, npn, G, c; const int* list;
    __device__ __forceinline__ bool next(int i, pg8::Unit& u) const {
        const int L = i * G + c; if (L >= ntiles * npn) return false;
        const int t = L / npn, pn = L % npn;
        u.pm = t; u.pn = __builtin_amdgcn_readfirstlane(tab[t]) * npn + pn; u.r0 = __builtin_amdgcn_readfirstlane(tab[176 + t]); u.nr = __builtin_amdgcn_readfirstlane(tab[352 + t]); u.lb = __builtin_amdgcn_readfirstlane(tab[704 + t]); return true;
    }
    __device__ __forceinline__ unsigned gather_voff(const pg8::Unit& u, int lr, int c2, int K) const {
        const int entry = (lr < u.nr) ? list[u.lb + lr] : 0;
        return (unsigned)((entry >> 1) * (K * 2) + c2);
    }
    __device__ __forceinline__ void a_ready(const pg8::Unit&) const {}
    __device__ __forceinline__ void done(const pg8::Unit&) const {}
};
__device__ __forceinline__ int moe_build_tiles(const Ctx& C0, unsigned* cnt) {
    const Ctx C = refresh(C0);
    volatile LAS int* tab = (volatile LAS int*)(C.lds + LDS_TILETAB);
    __syncthreads();
    if (C.tid == 0) { int nt = 0, off = 0;
        for (int e = 0; e < MOE_NE; ++e) { const int c = (int)xb_ld(cnt + e);
            for (int r = 0; r < c; r += 256) { tab[nt] = e; tab[176 + nt] = off + r; tab[352 + nt] = (c - r) < 256 ? (c - r) : 256; tab[704 + nt] = e * MROWS + r; ++nt; }
            off += c; }
        tab[528] = nt; }
    __syncthreads();
    return __builtin_amdgcn_readfirstlane(tab[528]);
}

__device__ __forceinline__ void split8(const f32x4 a0, const f32x4 a1, bf16x8& hi, bf16x8& lo) {
    float x[8] = {a0[0], a0[1], a0[2], a0[3], a1[0], a1[1], a1[2], a1[3]};
#pragma unroll
    for (int j = 0; j < 8; ++j) { const unsigned h = f2bf(x[j]); hi[j] = (short)h; lo[j] = (short)f2bf(x[j] - __uint_as_float(h << 16)); }
}
template <int NT> __device__ __forceinline__ void skinny3_tile(const float* Hr0, const bf16_t* Bhi, const bf16_t* Blo, f32x4 (&acc)[NT], int lane, int kb = 0, int ke = D) {
    const int fr = lane & 15, fq = lane >> 4;
#pragma unroll
    for (int nt = 0; nt < NT; ++nt) acc[nt] = (f32x4){0.f, 0.f, 0.f, 0.f};
    const float* ap = Hr0 + (size_t)fr * D + 8 * fq;
    const bf16_t* bh = Bhi + (size_t)fr * D + 8 * fq; const bf16_t* bl = Blo + (size_t)fr * D + 8 * fq;
#pragma unroll 4
    for (int k0 = kb; k0 < ke; k0 += 32) {
        bf16x8 ahi, alo; split8(*(const f32x4*)(ap + k0), *(const f32x4*)(ap + k0 + 4), ahi, alo);
#pragma unroll
        for (int nt = 0; nt < NT; ++nt) { const bf16x8 wh = *(const bf16x8*)(bh + (size_t)nt * 16 * D + k0), wl = *(const bf16x8*)(bl + (size_t)nt * 16 * D + k0);
            acc[nt] = __builtin_amdgcn_mfma_f32_16x16x32_bf16(ahi, wh, acc[nt], 0, 0, 0);
            acc[nt] = __builtin_amdgcn_mfma_f32_16x16x32_bf16(ahi, wl, acc[nt], 0, 0, 0);
            acc[nt] = __builtin_amdgcn_mfma_f32_16x16x32_bf16(alo, wh, acc[nt], 0, 0, 0); }
    }
}
constexpr int SKW_LD = 264;
template <int NT> __device__ __forceinline__ void wg_skinny(const Ctx& C, const float* H, const int (&rb)[4], const bf16_t* Bhi, const bf16_t* Blo, f32x4 (&acc)[NT]) {
    const int lane = C.lane, fr = lane & 15, fq = lane >> 4, tid = C.tid;
    LAS bf16_t* AH = (LAS bf16_t*)(C.lds + 36864); LAS bf16_t* AL = AH + 64 * SKW_LD; LAS bf16_t* BH = AL + 64 * SKW_LD; LAS bf16_t* BL = BH + NT * 16 * SKW_LD;
#pragma unroll
    for (int nt = 0; nt < NT; ++nt) acc[nt] = (f32x4){0.f, 0.f, 0.f, 0.f};
    const int ti = C.wave >> 1, kp = C.wave & 1;
    for (int kc = 0; kc < D; kc += 256) {
        __syncthreads();
        f32x4 av[8];
#pragma unroll
        for (int i = 0; i < 8; ++i) { const int idx = tid + NTHREADS * i, row = idx >> 6, c4 = (idx & 63) * 4; av[i] = *(const f32x4*)(H + (size_t)(rb[row >> 4] + (row & 15)) * D + kc + c4); }
        constexpr int NBV = NT * 16 * 32;
        v4u bhv[(NBV + NTHREADS - 1) / NTHREADS], blv[(NBV + NTHREADS - 1) / NTHREADS];
#pragma unroll
        for (int i = 0; i < (NBV + NTHREADS - 1) / NTHREADS; ++i) { const int idx = tid + NTHREADS * i;
            if (idx < NBV) { const int row = idx >> 5, c8 = (idx & 31) * 8; bhv[i] = *(const v4u*)(Bhi + (size_t)row * D + kc + c8); blv[i] = *(const v4u*)(Blo + (size_t)row * D + kc + c8); } }
#pragma unroll
        for (int i = 0; i < 8; ++i) { const int idx = tid + NTHREADS * i, row = idx >> 6, c4 = (idx & 63) * 4;
            const unsigned h01 = pk2(av[i][0], av[i][1]), h23 = pk2(av[i][2], av[i][3]);
            const unsigned l01 = pk2(av[i][0] - __uint_as_float(h01 << 16), av[i][1] - __uint_as_float(h01 & 0xffff0000u)), l23 = pk2(av[i][2] - __uint_as_float(h23 << 16), av[i][3] - __uint_as_float(h23 & 0xffff0000u));
            *(LAS v2u*)(AH + row * SKW_LD + c4) = (v2u){h01, h23}; *(LAS v2u*)(AL + row * SKW_LD + c4) = (v2u){l01, l23}; }
#pragma unroll
        for (int i = 0; i < (NBV + NTHREADS - 1) / NTHREADS; ++i) { const int idx = tid + NTHREADS * i;
            if (idx < NBV) { const int row = idx >> 5, c8 = (idx & 31) * 8; *(LAS v4u*)(BH + row * SKW_LD + c8) = bhv[i]; *(LAS v4u*)(BL + row * SKW_LD + c8) = blv[i]; } }
        __syncthreads();
#pragma unroll
        for (int k4 = 0; k4 < 4; ++k4) { const int ko = (kp * 4 + k4) * 32 + 8 * fq;
            const bf16x8 ahi = *(const LAS bf16x8*)(AH + (ti * 16 + fr) * SKW_LD + ko), alo = *(const LAS bf16x8*)(AL + (ti * 16 + fr) * SKW_LD + ko);
#pragma unroll
            for (int nt = 0; nt < NT; ++nt) { const bf16x8 wh = *(const LAS bf16x8*)(BH + (nt * 16 + fr) * SKW_LD + ko), wl = *(const LAS bf16x8*)(BL + (nt * 16 + fr) * SKW_LD + ko);
                acc[nt] = __builtin_amdgcn_mfma_f32_16x16x32_bf16(ahi, wh, acc[nt], 0, 0, 0);
                acc[nt] = __builtin_amdgcn_mfma_f32_16x16x32_bf16(ahi, wl, acc[nt], 0, 0, 0);
                acc[nt] = __builtin_amdgcn_mfma_f32_16x16x32_bf16(alo, wh, acc[nt], 0, 0, 0); } }
    }
    __syncthreads();
}
struct Args { Ptrs p; int ph_lo, ph_hi, li, pad; };
typedef const __attribute__((address_space(4))) Args* KA;
typedef const __attribute__((address_space(4))) Ptrs* KP;
__device__ __forceinline__ KA kargs() { KA q = (KA)__builtin_amdgcn_kernarg_segment_ptr(); asm volatile("" : "+s"(q)); return q; }
__device__ __forceinline__ KP kp() { return &kargs()->p; }
__device__ __forceinline__ bool in_ph(int k) { KA a = kargs(); return a->ph_lo <= k && k < a->ph_hi; }
__device__ __forceinline__ void cvt_tile64(const float* src  , size_t ldw, bf16_t* dst  , size_t ldt, LAS bf16_t* T  , int lane) {
    const int r = lane >> 4, c4 = (lane & 15) * 4;
    f32x4 v[16];
#pragma unroll
    for (int i = 0; i < 16; ++i) v[i] = *(const f32x4*)(src + (size_t)(4 * i + r) * ldw + c4);
#pragma unroll
    for (int i = 0; i < 16; ++i) { const int k = 4 * i + r;
        T[(c4 + 0) * 72 + k] = (bf16_t)f2bf(v[i][0]); T[(c4 + 1) * 72 + k] = (bf16_t)f2bf(v[i][1]); T[(c4 + 2) * 72 + k] = (bf16_t)f2bf(v[i][2]); T[(c4 + 3) * 72 + k] = (bf16_t)f2bf(v[i][3]); }
    asm volatile("s_waitcnt lgkmcnt(0)" ::: "memory");
#pragma unroll
    for (int j = 0; j < 8; ++j) { const int idx = lane + 64 * j, n = idx >> 3, kc = idx & 7;
        *(v4u*)(dst + (size_t)n * ldt + kc * 8) = *(const LAS v4u*)(T + n * 72 + kc * 8); }
    asm volatile("s_waitcnt lgkmcnt(0)" ::: "memory");
}
__device__ __forceinline__ void cvt_job_tile64(const CvtJob& j, int item, LAS bf16_t* T, int lane) {
    const int nblk = j.ncols / 64, kb = item / nblk, nb = item % nblk;
    cvt_tile64(j.src + (size_t)(64 * kb) * j.ldw + 64 * nb, j.ldw, j.dst + (size_t)(64 * nb) * j.ldt + 64 * kb, j.ldt, T, lane);
}
constexpr int CVT_MOE_TILES = MOE_NE * 384;
constexpr int CVT_STATIC_TILES = 2048 + 1024 + 1024 + 1024 + 256 + 16 * 4;
__device__ __forceinline__ void cvt_list_item(KP p, int list, int it, LAS bf16_t* T, int lane) {
    if (list == 0 && it < CVT_STATIC_TILES) {
        int j, r = it;
        if (r < 2048) j = 2; else if ((r -= 2048) < 1024) j = 3; else if ((r -= 1024) < 1024) j = 4; else if ((r -= 1024) < 1024) j = 5; else if ((r -= 1024) < 256) j = 6; else { r -= 256; j = 7 + (r >> 2); r &= 3; }
        cvt_job_tile64(static_job(p, j), r, T, lane);
    } else {
        if (list == 0) it -= CVT_STATIC_TILES;
        const int e = it / 384, r = it % 384, jj = r < 256 ? (r >> 6) : 4;
        cvt_job_tile64(moe_job(p, list, e * 5 + jj), r < 256 ? (r & 63) : (r - 256), T, lane);
    }
}
constexpr int CW_CVTQ = 32;
__device__ __forceinline__ void cvt_pull(const Ctx& C0, KP p, int list) {
    const Ctx C = refresh(C0);
    LAS bf16_t* T = (LAS bf16_t*)(C.lds + C.wave * 9216);
    unsigned* q = (unsigned*)(p->ws + WS_CTL) + CW_CVTQ + 16 * list;
    const int total = (list == 0) ? CVT_STATIC_TILES + CVT_MOE_TILES : CVT_MOE_TILES;
    constexpr int CVT_BATCH = 16;
    for (;;) {
        int it = 0; if (C.lane == 0) it = (int)atomicAdd(q, (unsigned)CVT_BATCH);
        it = __builtin_amdgcn_readfirstlane(it);
        if (it >= total) break;
        const int ie = (it + CVT_BATCH < total) ? it + CVT_BATCH : total;
        for (int k = it; k < ie; ++k) cvt_list_item(p, list, k, T, C.lane);
    }
}

__device__ __forceinline__ void ph_prologue(const Ctx& C0, KP p) {
    const Ctx C = refresh(C0);
    { LAS bf16_t* T = (LAS bf16_t*)(C.lds + C.wave * 9216);
      for (int j = 0; j < 2; ++j) { const CvtJob job = static_job(p, j); const int nit = (job.K / 64) * (job.ncols / 64);
          for (int it = C.gw; it < nit; it += C.ngw) cvt_job_tile64(job, it, T, C.lane); } }
    const size_t gt = (size_t)C.vcu * NTHREADS + C.tid, ngt = (size_t)C.G * NTHREADS;
    {
        float* H = (float*)(p->ws + WS_H); bf16_t* HB = (bf16_t*)(p->ws + WS_HB);
        const size_t n4 = (size_t)MP * D / 4;
        for (size_t i = gt; i < n4; i += ngt) {
            const int m = (int)(i / (D / 4)), c = (int)(i % (D / 4)) * 4;
            float4 v = make_float4(0.f, 0.f, 0.f, 0.f);
            if (m < MROWS) { const int b = m / LP, q = m % LP;
                if (q >= CHUNK) v = *(const float4*)(p->in[0] + ((size_t)b * SEQ + (q - CHUNK)) * D + c);
                else if (q >= PADF) v = *(const float4*)(p->in[1] + (size_t)(q - PADF) * D + c); }
            *(float4*)(H + (size_t)m * D + c) = v;
            uint2 o; o.x = pk2(v.x, v.y); o.y = pk2(v.z, v.w); *(uint2*)(HB + (size_t)m * D + c) = o;
        }
    }
    {
        bf16_t* WR = (bf16_t*)(p->ws + WS_WR); bf16_t* WK = (bf16_t*)(p->ws + WS_WSK3);
        for (size_t i = gt; i < (size_t)2 * 64 * D; i += ngt) { const int k = (int)(i % D), n = (int)((i / D) % 64), L = (int)(i / ((size_t)64 * D));
            if (n < 48) { const float x = n < 4 ? p->in[30][((size_t)L * D + k) * 4 + n] : (n < 36 ? p->in[32][((size_t)L * D + k) * 32 + (n - 4)] : 0.f);
                const unsigned h = f2bf(x); WR[((size_t)(L * 2 + 0) * 48 + n) * D + k] = (bf16_t)h; WR[((size_t)(L * 2 + 1) * 48 + n) * D + k] = (bf16_t)f2bf(x - __uint_as_float(h << 16)); }
            else { const int c = n - 48; const float x = L == 0 ? p->in[2][(size_t)k * 4112 + 3072 + c] : p->in[17][(size_t)k * 6160 + 4096 + c];
                const unsigned h = f2bf(x); WK[((size_t)(L * 2 + 0) * 16 + c) * D + k] = (bf16_t)h; WK[((size_t)(L * 2 + 1) * 16 + c) * D + k] = (bf16_t)f2bf(x - __uint_as_float(h << 16)); } }
    }
    if (gt < S5G * S5P) {
        const int i = (int)gt, g = i / S5P, pp = i % S5P;
        float* Cc = (float*)(p->ws + WS_S5C); bf16_t* Bb = (bf16_t*)(p->ws + WS_S5B);
        const float are = p->in[3][i], aim = p->in[4][i], dt = expf(p->in[5][g]);
        const float mag = expf(are * dt); float sn, cs; sincosf(aim * dt, &sn, &cs);
        const float br = mag * cs, bi = mag * sn;
        Cc[S5C_ABAR + 2 * i] = br; Cc[S5C_ABAR + 2 * i + 1] = bi;
        const float nr = br - 1.0f, ni = bi, den = are * are + aim * aim;
        const float zr = (nr * are + ni * aim) / den, zi = (ni * are - nr * aim) / den;
        for (int c = 0; c < S5C; ++c) { const float b_r = p->in[6][(size_t)i * S5C + c], b_i = p->in[7][(size_t)i * S5C + c];
            const float xr = b_r * zr - b_i * zi, xi = b_r * zi + b_i * zr;
            Cc[S5C_BBAR + ((size_t)i * S5C + c) * 2] = xr; Cc[S5C_BBAR + ((size_t)i * S5C + c) * 2 + 1] = xi;
            Bb[S5B_BR + (size_t)i * 16 + c] = (bf16_t)f2bf(xr); Bb[S5B_BI + (size_t)i * 16 + c] = (bf16_t)f2bf(xi);
            Bb[S5B_CM + ((size_t)g * 16 + c) * 128 + pp] = (bf16_t)f2bf(p->in[8][((size_t)g * 16 + c) * 64 + pp]);
            Bb[S5B_CM + ((size_t)g * 16 + c) * 128 + 64 + pp] = (bf16_t)f2bf(-p->in[9][((size_t)g * 16 + c) * 64 + pp]); }
    }
}
__device__ __forceinline__ void ph_cvt_moe(const Ctx& C0, KP p, int L) {
    const Ctx C = refresh(C0);
    float* scr = (float*)(C.lds + C.wave * 8448);
    for (int j = 0; j < MOE_NE * 5; ++j) { const CvtJob job = moe_job(p, L, j); const int nit = (job.K / 64) * (job.ncols / 32);
        for (int it = C.gw; it < nit; it += C.ngw) cvt_job_items(job, it, scr, C.lane); }
}
__device__ __forceinline__ void ph_skinny(const Ctx& C0, KP p, int L) {
    const Ctx C = refresh(C0);
    const float* H = (const float*)(p->ws + WS_H); float* SK = (float*)(p->ws + WS_SK);
    const bf16_t* Bhi = (const bf16_t*)(p->ws + WS_WSK3) + (size_t)(L * 2) * 16 * D; const bf16_t* Blo = Bhi + (size_t)16 * D;
    volatile LAS float* S = (volatile LAS float*)(C.lds);
    const int NTILE = MROWS / 16;
    for (int tb = C.vcu; tb < NTILE; tb += 4 * C.G) {
        int rb[4];
#pragma unroll
        for (int i = 0; i < 4; ++i) rb[i] = ((tb + i * C.G < NTILE) ? (tb + i * C.G) : tb) * 16;
        f32x4 acc[1]; wg_skinny<1>(C, H, rb, Bhi, Blo, acc);
        const int ti = C.wave >> 1, kh = C.wave & 1;
#pragma unroll
        for (int i = 0; i < 4; ++i) S[((ti * 2 + kh) * 16 + 4 * (C.lane >> 4) + i) * 16 + (C.lane & 15)] = acc[0][i];
        __syncthreads();
        if (kh == 0 && tb + ti * C.G < NTILE) {
#pragma unroll
            for (int i = 0; i < 4; ++i) { const int r = 4 * (C.lane >> 4) + i;
                SK[(size_t)(rb[ti] + r) * 16 + (C.lane & 15)] = S[((ti * 2) * 16 + r) * 16 + (C.lane & 15)] + S[((ti * 2 + 1) * 16 + r) * 16 + (C.lane & 15)]; } }
        __syncthreads();
    }
}
template <int MODE> __device__ __forceinline__ void ln_row(KP p, int m, const float* g, const float* b, float* out, int lane, int pos0 = 0, int pos1 = 0) {
    float* H = (float*)(p->ws + WS_H); bf16_t* HB = (bf16_t*)(p->ws + WS_HB);
    float4* hr = (float4*)(H + (size_t)m * D); uint2* hb = (uint2*)(HB + (size_t)m * D);
    if (!row_valid(m)) {
#pragma unroll
        for (int j = 0; j < 8; ++j) { hr[lane + 64 * j] = make_float4(0.f, 0.f, 0.f, 0.f); hb[lane + 64 * j] = make_uint2(0u, 0u); }
        return; }
    float4 v[8]; float s = 0.f;
#pragma unroll
    for (int j = 0; j < 8; ++j) v[j] = hr[lane + 64 * j];
    if (MODE == 2) { const uint2* mx = (const uint2*)((const bf16_t*)(p->ws + WS_MIX) + (size_t)m * D);
#pragma unroll
        for (int j = 0; j < 8; ++j) { const uint2 a = mx[lane + 64 * j];
            v[j].x = DN_ALPHA * v[j].x + __uint_as_float(a.x << 16); v[j].y = DN_ALPHA * v[j].y + __uint_as_float(a.x & 0xffff0000u);
            v[j].z = DN_ALPHA * v[j].z + __uint_as_float(a.y << 16); v[j].w = DN_ALPHA * v[j].w + __uint_as_float(a.y & 0xffff0000u); } }
    if (MODE == 1) { const bf16_t* YS = (const bf16_t*)(p->ws + WS_XS);
        const uint2* y0 = (const uint2*)(YS + (size_t)pos0 * D); const uint2* y1 = (const uint2*)(YS + (size_t)pos1 * D);
#pragma unroll
        for (int j = 0; j < 8; ++j) { const uint2 a = y0[lane + 64 * j], c = y1[lane + 64 * j];
            v[j].x = DN_ALPHA * v[j].x + (__uint_as_float(a.x << 16) + __uint_as_float(c.x << 16));
            v[j].y = DN_ALPHA * v[j].y + (__uint_as_float(a.x & 0xffff0000u) + __uint_as_float(c.x & 0xffff0000u));
            v[j].z = DN_ALPHA * v[j].z + (__uint_as_float(a.y << 16) + __uint_as_float(c.y << 16));
            v[j].w = DN_ALPHA * v[j].w + (__uint_as_float(a.y & 0xffff0000u) + __uint_as_float(c.y & 0xffff0000u)); } }
#pragma unroll
    for (int j = 0; j < 8; ++j) s += (v[j].x + v[j].y) + (v[j].z + v[j].w);
    const float mean = wave_sum(s) * (1.0f / D); float q = 0.f;
#pragma unroll
    for (int j = 0; j < 8; ++j) { v[j].x -= mean; v[j].y -= mean; v[j].z -= mean; v[j].w -= mean; q += (v[j].x * v[j].x + v[j].y * v[j].y) + (v[j].z * v[j].z + v[j].w * v[j].w); }
    const float rstd = rsqrtf(wave_sum(q) * (1.0f / D) + LN_EPS);
    const int q_ = m % LP, bb = m / LP;
#pragma unroll
    for (int j = 0; j < 8; ++j) { const int c = (lane + 64 * j) * 4; const float4 gg = *(const float4*)(g + c), bv = *(const float4*)(b + c);
        float4 o; o.x = v[j].x * rstd * gg.x + bv.x; o.y = v[j].y * rstd * gg.y + bv.y; o.z = v[j].z * rstd * gg.z + bv.z; o.w = v[j].w * rstd * gg.w + bv.w;
        hr[lane + 64 * j] = o; hb[lane + 64 * j] = make_uint2(pk2(o.x, o.y), pk2(o.z, o.w));
        if (out && q_ >= CHUNK) *(float4*)(out + ((size_t)bb * SEQ + (q_ - CHUNK)) * D + c) = o; }
}
__device__ __forceinline__ void ph_ln1_router(const Ctx& C0, KP p, int L) {
    const Ctx C = refresh(C0);
    const float* g = p->in[37] + L * D; const float* b = p->in[38] + L * D;
    const float* H = (const float*)(p->ws + WS_H); const bf16_t* WRhi = (const bf16_t*)(p->ws + WS_WR) + (size_t)(L * 2) * 48 * D; const bf16_t* WRlo = WRhi + (size_t)48 * D;
    const float* brg = p->in[31] + L * 4; const float* bre = p->in[33] + L * 32;
    int* toke = (int*)(p->ws + WS_TOKE); float* tokw = (float*)(p->ws + WS_TOKW); int* toks = (int*)(p->ws + WS_TOKS);
    unsigned* cnt = (unsigned*)(p->ws + WS_CTL) + CW_CNT + L * 32;
    volatile LAS float* S = (volatile LAS float*)(C.lds);
    const int NTILE = MP / 16;
    for (int tb = C.vcu; tb < NTILE; tb += 4 * C.G) {
        int nt = 0;
#pragma unroll
        for (int i = 0; i < 4; ++i) nt += (tb + i * C.G < NTILE) ? 1 : 0;
        for (int j = C.wave; j < nt * 16; j += NWAVES) ln_row<2>(p, (tb + (j >> 4) * C.G) * 16 + (j & 15), g, b, nullptr, C.lane);
        __syncthreads();
        const int ti = C.wave >> 1, kh = C.wave & 1, t = tb + ti * C.G;
        const bool act = ti < nt && t * 16 < MROWS;
        int rb[4];
#pragma unroll
        for (int i = 0; i < 4; ++i) rb[i] = ((i < nt) ? (tb + i * C.G) : tb) * 16;
        f32x4 acc[3]; wg_skinny<3>(C, H, rb, WRhi, WRlo, acc);
        if (act) {
#pragma unroll
            for (int n3 = 0; n3 < 3; ++n3)
#pragma unroll
                for (int i = 0; i < 4; ++i) S[((ti * 2 + kh) * 16 + 4 * (C.lane >> 4) + i) * 48 + 16 * n3 + (C.lane & 15)] = acc[n3][i];
        }
        __syncthreads();
        volatile LAS int* LC = (volatile LAS int*)(C.lds + 32768);
        if (C.tid < 32) LC[C.tid] = 0;
        __syncthreads();
        int ea = -1, eb = -1, la = 0, lb = 0; const int m = t * 16 + C.lane;
        if (act && kh == 0 && C.lane < 16) {
            if (!row_valid(m)) { toke[m * 2] = 0; toke[m * 2 + 1] = 0; tokw[m * 2] = 0.f; tokw[m * 2 + 1] = 0.f; toks[m * 2] = 0; toks[m * 2 + 1] = 0; }
            else {
                volatile LAS float* r0 = S + ((ti * 2) * 16 + C.lane) * 48; volatile LAS float* r1 = r0 + 16 * 48;
                float best = r0[0] + r1[0] + brg[0]; int gtp = 0; float lg[4]; lg[0] = best;
#pragma unroll
                for (int j = 1; j < 4; ++j) { lg[j] = r0[j] + r1[j] + brg[j]; if (lg[j] > best) { best = lg[j]; gtp = j; } }
                float den = 0.f;
#pragma unroll
                for (int j = 0; j < 4; ++j) den += __expf(lg[j] - best);
                const float ptop = 1.0f / den;
                float v0 = -3.0e38f, v1 = -3.0e38f; int e0 = 0, e1 = 0;
                for (int j = 0; j < 8; ++j) { const float le = r0[4 + gtp * 8 + j] + r1[4 + gtp * 8 + j] + bre[gtp * 8 + j]; if (le > v0) { v0 = le; e0 = j; } }
                for (int j = 0; j < 8; ++j) { const float le = r0[4 + gtp * 8 + j] + r1[4 + gtp * 8 + j] + bre[gtp * 8 + j]; if (j != e0 && le > v1) { v1 = le; e1 = j; } }
                const float x = __expf(v1 - v0), w0 = 1.0f / (1.0f + x), w1 = x / (1.0f + x);
                ea = gtp * 8 + e0; eb = gtp * 8 + e1;
                toke[m * 2] = ea; toke[m * 2 + 1] = eb; tokw[m * 2] = ptop * w0; tokw[m * 2 + 1] = ptop * w1;
                la = atomicAdd((int*)(C.lds + 32768) + ea, 1); lb = atomicAdd((int*)(C.lds + 32768) + eb, 1);
            }
        }
        __syncthreads();
        if (C.tid < 32) { const int n = LC[C.tid]; LC[32 + C.tid] = n ? (int)atomicAdd(cnt + C.tid, (unsigned)n) : 0; }
        __syncthreads();
        if (ea >= 0) { const int sa = LC[32 + ea] + la, sb_ = LC[32 + eb] + lb; toks[m * 2] = sa; toks[m * 2 + 1] = sb_;
            int* liste = (int*)(p->ws + WS_LISTE); liste[ea * MROWS + sa] = m * 2; liste[eb * MROWS + sb_] = m * 2 + 1; }
        __syncthreads();
    }
}
__device__ __forceinline__ void ph_permute(const Ctx& C0, KP p, int L) {
    const Ctx C = refresh(C0);
    unsigned* cnt = (unsigned*)(p->ws + WS_CTL) + CW_CNT + L * 32;
    const int* toke = (const int*)(p->ws + WS_TOKE); const float* tokw = (const float*)(p->ws + WS_TOKW); int* toks = (int*)(p->ws + WS_TOKS);
    const bf16_t* HB = (const bf16_t*)(p->ws + WS_HB); bf16_t* XS = (bf16_t*)(p->ws + WS_XS); float* XW = (float*)(p->ws + WS_XW);
    int c = (C.lane < 32) ? (int)xb_ld(cnt + C.lane) : 0;
    int incl = c;
#pragma unroll
    for (int o = 1; o < 32; o <<= 1) { const int t = __shfl_up(incl, o); if (C.lane >= o) incl += t; }
    const int excl = incl - c;
    for (int m = C.gw; m < MROWS; m += C.ngw) {
        if (!row_valid(m)) continue;
        const int e0 = toke[m * 2], e1 = toke[m * 2 + 1];
        const int p0 = __shfl(excl, e0) + toks[m * 2], p1 = __shfl(excl, e1) + toks[m * 2 + 1];
        const v4u* src = (const v4u*)(HB + (size_t)m * D); v4u* d0 = (v4u*)(XS + (size_t)p0 * D); v4u* d1 = (v4u*)(XS + (size_t)p1 * D);
#pragma unroll
        for (int j = 0; j < 4; ++j) { const v4u x = src[C.lane + 64 * j]; d0[C.lane + 64 * j] = x; d1[C.lane + 64 * j] = x; }
        if (C.lane == 0) { XW[p0] = tokw[m * 2]; XW[p1] = tokw[m * 2 + 1]; }
        asm volatile("s_waitcnt vmcnt(0)" ::: "memory");
        if (C.lane == 0) { toks[m * 2] = p0; toks[m * 2 + 1] = p1; }
    }
}
__device__ __forceinline__ void ph_ln2(const Ctx& C0, KP p, int L) {
    const Ctx C = refresh(C0);
    const float* g = p->in[39] + L * D; const float* b = p->in[40] + L * D;
    float* out = (L == 1) ? p->out : nullptr;
    unsigned* cnt = (unsigned*)(p->ws + WS_CTL) + CW_CNT + L * 32;
    const int* toke = (const int*)(p->ws + WS_TOKE); const int* toks = (const int*)(p->ws + WS_TOKS);
    int c = (C.lane < 32) ? (int)xb_ld(cnt + C.lane) : 0;
    int incl = c;
#pragma unroll
    for (int o = 1; o < 32; o <<= 1) { const int t = __shfl_up(incl, o); if (C.lane >= o) incl += t; }
    const int excl = incl - c;
    for (int m = C.gw; m < MP; m += C.ngw) {
        int p0 = 0, p1 = 0;
        if (row_valid(m)) { const int e0 = toke[m * 2], e1 = toke[m * 2 + 1]; p0 = __shfl(excl, e0) + toks[m * 2]; p1 = __shfl(excl, e1) + toks[m * 2 + 1]; }
        ln_row<1>(p, m, g, b, out, C.lane, p0, p1);
    }
}
constexpr int NPHASES = 23;
typedef short bf16x4 __attribute__((ext_vector_type(4)));
#define LDSW() asm volatile("s_waitcnt lgkmcnt(0)" ::: "memory")
#define LBAR() do { asm volatile("s_waitcnt lgkmcnt(0)" ::: "memory"); __builtin_amdgcn_s_barrier(); asm volatile("" ::: "memory"); } while (0)
__device__ __forceinline__ f32x4 mmaT(bf16x8 a_rows_m, bf16x8 b_rows_n, f32x4 acc) {
    return __builtin_amdgcn_mfma_f32_16x16x32_bf16(b_rows_n, a_rows_m, acc, 0, 0, 0);
}
__device__ __forceinline__ float bflo(unsigned w) { return __uint_as_float(w << 16); }
__device__ __forceinline__ float bfhi(unsigned w) { return __uint_as_float(w & 0xffff0000u); }
__device__ __forceinline__ int chunk_row0(int c) { return (c / NCH) * LP + (c % NCH) * CHUNK; }

template <bool FINAL> __device__ __forceinline__ void ph_s5(const Ctx& C0, KP p) {
    const Ctx C = refresh(C0);
    const int lane = C.lane, fr = lane & 15, fq = lane >> 4;
    LAS float* bre_l = (LAS float*)(C.lds + C.wave * 16384); LAS float* bim_l = bre_l + 16 * 68; LAS bf16_t* Sb = (LAS bf16_t*)(bim_l + 16 * 68);
    const float* Cc = (const float*)(p->ws + WS_S5C); const bf16_t* Bb = (const bf16_t*)(p->ws + WS_S5B);
    const bf16_t* P = (const bf16_t*)(p->ws + WS_P); bf16_t* Z = (bf16_t*)(p->ws + WS_Z); float* X = (float*)(p->ws + WS_S5X);
    const bf16x8 zero8 = {0, 0, 0, 0, 0, 0, 0, 0};
    const int NIT = BATCH * NCH * S5G;
    int gcur = -1; float ar = 0.f, ai = 0.f; bf16x8 bfr[4], bfi[4], cm[4]; f32x4 dd = {0.f, 0.f, 0.f, 0.f};
#pragma unroll
    for (int q = 0; q < 4; ++q) { bfr[q] = zero8; bfi[q] = zero8; cm[q] = zero8; }
    bf16x8 a[4], an[4]; uint2 uu[4], un[4]; float2 x0 = make_float2(0.f, 0.f), xn = make_float2(0.f, 0.f);
#define S5_LOAD(it_, a_, u_, x_) do { const int c_ = (it_) / S5G, g_ = (it_) % S5G, m0_ = chunk_row0(c_); \
        _Pragma("unroll") for (int sub = 0; sub < 4; ++sub) { const bf16_t* urow = P + (size_t)(m0_ + sub * 16 + fr) * NP0 + P0_U + g_ * 16; \
            a_[sub] = (lane < 32) ? *(const bf16x8*)(urow + 8 * fq) : zero8; if (FINAL) u_[sub] = *(const uint2*)(urow + 4 * fq); } \
        if (FINAL) x_ = *(const float2*)(X + ((size_t)(c_ * S5G + g_) * 64 + lane) * 2); } while (0)
    if (C.gw < NIT) S5_LOAD(C.gw, an, un, xn);
    for (int it = C.gw; it < NIT; it += C.ngw) {
        const int c = it / S5G, g = it % S5G, m0 = chunk_row0(c);
#pragma unroll
        for (int sub = 0; sub < 4; ++sub) { a[sub] = an[sub]; uu[sub] = un[sub]; }
        x0 = xn;
        if (it + C.ngw < NIT) S5_LOAD(it + C.ngw, an, un, xn);
        if (g != gcur) { gcur = g;
            ar = Cc[S5C_ABAR + 2 * (g * 64 + lane)]; ai = Cc[S5C_ABAR + 2 * (g * 64 + lane) + 1];
#pragma unroll
            for (int nt = 0; nt < 4; ++nt) { bfr[nt] = (lane < 32) ? *(const bf16x8*)(Bb + S5B_BR + (size_t)(g * 64 + nt * 16 + fr) * 16 + 8 * fq) : zero8;
                                             bfi[nt] = (lane < 32) ? *(const bf16x8*)(Bb + S5B_BI + (size_t)(g * 64 + nt * 16 + fr) * 16 + 8 * fq) : zero8; }
            if (FINAL) {
#pragma unroll
                for (int ks = 0; ks < 4; ++ks) cm[ks] = *(const bf16x8*)(Bb + S5B_CM + (size_t)(g * 16 + fr) * 128 + 32 * ks + 8 * fq);
                dd = *(const f32x4*)(p->in[10] + g * 16 + 4 * fq); } }
        float sr = FINAL ? x0.x : 0.f, si = FINAL ? x0.y : 0.f;
#pragma unroll
        for (int sub = 0; sub < 4; ++sub) {
#pragma unroll
            for (int nt = 0; nt < 4; ++nt) { const f32x4 z4 = {0.f, 0.f, 0.f, 0.f};
                const f32x4 r = mmaT(a[sub], bfr[nt], z4), im = mmaT(a[sub], bfi[nt], z4);
                *(LAS f32x4*)(bre_l + fr * 68 + nt * 16 + 4 * fq) = r; *(LAS f32x4*)(bim_l + fr * 68 + nt * 16 + 4 * fq) = im; }
            LDSW();
            float brv[16], biv[16];
#pragma unroll
            for (int t = 0; t < 16; ++t) { brv[t] = bre_l[t * 68 + lane]; biv[t] = bim_l[t * 68 + lane]; }
#pragma unroll
            for (int t = 0; t < 16; ++t) { const float nr = ar * sr - ai * si + brv[t], ni = ar * si + ai * sr + biv[t]; sr = nr; si = ni;
                if (FINAL) { Sb[t * 136 + lane] = (bf16_t)f2bf(sr); Sb[t * 136 + 64 + lane] = (bf16_t)f2bf(si); } }
            if (FINAL) {
                LDSW();
                f32x4 y = {0.f, 0.f, 0.f, 0.f};
#pragma unroll
                for (int ks = 0; ks < 4; ++ks) { const bf16x8 sa = *(const LAS bf16x8*)(Sb + fr * 136 + 32 * ks + 8 * fq); y = mmaT(sa, cm[ks], y); }
                const float z0 = gelu_tanh(y[0] + dd[0] * bflo(uu[sub].x)), z1 = gelu_tanh(y[1] + dd[1] * bfhi(uu[sub].x)), z2 = gelu_tanh(y[2] + dd[2] * bflo(uu[sub].y)), z3 = gelu_tanh(y[3] + dd[3] * bfhi(uu[sub].y));
                *(uint2*)(Z + (size_t)(m0 + sub * 16 + fr) * S5W + g * 16 + 4 * fq) = make_uint2(pk2(z0, z1), pk2(z2, z3));
            }
            LDSW();
        }
        if (!FINAL) *(float2*)(X + ((size_t)(c * S5G + g) * 64 + lane) * 2) = make_float2(sr, si);
    }
#undef S5_LOAD
}
__device__ __forceinline__ void ph_s5_carry(const Ctx& C0, KP p) {
    const Ctx C = refresh(C0);
    const int gt = C.vcu * NTHREADS + C.tid;
    if (gt >= BATCH * S5G * S5P) return;
    const float* Cc = (const float*)(p->ws + WS_S5C); float* X = (float*)(p->ws + WS_S5X);
    const int b = gt / (S5G * S5P), gp = gt % (S5G * S5P);
    float ar = Cc[S5C_ABAR + 2 * gp], ai = Cc[S5C_ABAR + 2 * gp + 1];
#pragma unroll
    for (int i = 0; i < 6; ++i) { const float nr = ar * ar - ai * ai, ni = 2.f * ar * ai; ar = nr; ai = ni; }
    float xr = 0.f, xi = 0.f;
    float2* base = (float2*)X + (size_t)b * NCH * (S5G * S5P) + gp;
    for (int n0 = 0; n0 < NCH; n0 += 8) {
        float2 f[8];
#pragma unroll
        for (int j = 0; j < 8; ++j) f[j] = (n0 + j < NCH) ? base[(size_t)(n0 + j) * (S5G * S5P)] : make_float2(0.f, 0.f);
#pragma unroll
        for (int j = 0; j < 8; ++j) if (n0 + j < NCH) { base[(size_t)(n0 + j) * (S5G * S5P)] = make_float2(xr, xi);
            const float nr = ar * xr - ai * xi + f[j].x, ni = ar * xi + ai * xr + f[j].y; xr = nr; xi = ni; }
    }
}

constexpr int LFS = 129;
constexpr int GLA_LF = 0, GLA_TOT = 64 * LFS * 4, GLA_A_KST = GLA_TOT + 2048 + 4096, GLA_A_VT = GLA_A_KST + 128 * 72 * 2, GLA_A_END = GLA_A_VT + 256 * 72 * 2;
constexpr int GLA_C_QI = GLA_TOT + 2048 + 4096, GLA_C_KI = GLA_C_QI + 64 * 136 * 2, GLA_C_ATT = GLA_C_KI + 64 * 136 * 2, GLA_C_VT = GLA_C_ATT + 64 * 72 * 2, GLA_C_RED = GLA_C_VT + 256 * 72 * 2, GLA_C_END = GLA_C_RED + 64 * 8 * 4;
static_assert(GLA_C_END <= RING_BYTES && GLA_A_END <= RING_BYTES, "GLA LDS");
__device__ __forceinline__ void gla_bcum(const Ctx& C, KP p, int m0, int h, LAS float* LF, LAS float* TOT) {
    const int t = C.tid, d = t & 127, qd = t >> 7;
    const float* SK = (const float*)(p->ws + WS_SK); const float* wg = p->in[13];
    LAS float* SKL = TOT + 512;
    if (t < 256) *(LAS f32x4*)(SKL + t * 4) = *(const f32x4*)(SK + (size_t)m0 * 16 + t * 4);
    float wgc[16];
#pragma unroll
    for (int j = 0; j < 16; ++j) wgc[j] = wg[j * 512 + h * 128 + d];
    const float bgc = p->in[14][h * 128 + d];
    __syncthreads();
    float run = 0.f;
#pragma unroll 4
    for (int i = 0; i < 16; ++i) { const int tok = 16 * qd + i, m = m0 + tok;
        float lg = bgc;
#pragma unroll
        for (int q = 0; q < 4; ++q) { const f32x4 s4 = *(const LAS f32x4*)(SKL + tok * 16 + 4 * q); lg += s4[0] * wgc[4 * q] + s4[1] * wgc[4 * q + 1] + s4[2] * wgc[4 * q + 2] + s4[3] * wgc[4 * q + 3]; }
        const float lsg = fminf(lg, 0.f) - __logf(1.0f + __expf(-fabsf(lg)));
        const float lf = ((m % LP) >= PADF) ? lsg * (1.0f / 16.0f) : 0.f;
        run += lf; LF[tok * LFS + d] = run; }
    TOT[qd * 128 + d] = run;
    __syncthreads();
    float off = 0.f;
#pragma unroll
    for (int q = 0; q < 3; ++q) off += (q < qd) ? TOT[q * 128 + d] : 0.f;
    if (qd > 0) {
#pragma unroll 4
        for (int i = 0; i < 16; ++i) LF[(16 * qd + i) * LFS + d] += off; }
    __syncthreads();
}
__device__ __forceinline__ void stage_transposed(const Ctx& C, const bf16_t* src  , int ld, int ncols, LAS bf16_t* T) {
    for (int cg = C.wave; cg < ncols / 8; cg += NWAVES) {
        const v4u x = *(const v4u*)(src + (size_t)C.lane * ld + cg * 8);
        const unsigned w[4] = {x.x, x.y, x.z, x.w};
#pragma unroll
        for (int q = 0; q < 4; ++q) { T[(cg * 8 + 2 * q) * 72 + C.lane] = (bf16_t)(w[q] & 0xffffu); T[(cg * 8 + 2 * q + 1) * 72 + C.lane] = (bf16_t)(w[q] >> 16); }
    }
}
__device__ __forceinline__ void ph_gla_a(const Ctx& C0, KP p) {
    const Ctx C = refresh(C0);
    const int lane = C.lane, fr = lane & 15, fq = lane >> 4, t = C.tid;
    LAS float* LF = (LAS float*)(C.lds + GLA_LF); LAS float* TOT = (LAS float*)(C.lds + GLA_TOT);
    LAS bf16_t* KSt = (LAS bf16_t*)(C.lds + GLA_A_KST); LAS bf16_t* Vt = (LAS bf16_t*)(C.lds + GLA_A_VT);
    const bf16_t* P = (const bf16_t*)(p->ws + WS_P); bf16_t* KV = (bf16_t*)(p->ws + WS_HB); float* DEC = (float*)(p->ws + WS_GDEC);
    for (int it = C.vcu; it < BATCH * NCH * GLH; it += C.G) {
        const int c = it / GLH, h = it % GLH, m0 = chunk_row0(c);
        v4u xk[2], xv[4];
#pragma unroll
        for (int i = 0; i < 2; ++i) xk[i] = *(const v4u*)(P + (size_t)(m0 + lane) * NP0 + P0_K + h * 128 + (C.wave + 8 * i) * 8);
#pragma unroll
        for (int i = 0; i < 4; ++i) xv[i] = *(const v4u*)(P + (size_t)(m0 + lane) * NP0 + P0_V + h * 256 + (C.wave + 8 * i) * 8);
        __syncthreads();
        gla_bcum(C, p, m0, h, LF, TOT);
#pragma unroll
        for (int i = 0; i < 2; ++i) { const int cg = C.wave + 8 * i;
            const unsigned w[4] = {xk[i].x, xk[i].y, xk[i].z, xk[i].w};
#pragma unroll
            for (int q = 0; q < 4; ++q) { const int d0 = cg * 8 + 2 * q;
                const float bl0 = LF[63 * LFS + d0], bl1 = LF[63 * LFS + d0 + 1];
                KSt[d0 * 72 + lane] = (bf16_t)f2bf(bflo(w[q]) * __expf(bl0 - LF[lane * LFS + d0]));
                KSt[(d0 + 1) * 72 + lane] = (bf16_t)f2bf(bfhi(w[q]) * __expf(bl1 - LF[lane * LFS + d0 + 1])); }
        }
#pragma unroll
        for (int i = 0; i < 4; ++i) { const int cg = C.wave + 8 * i; const unsigned w[4] = {xv[i].x, xv[i].y, xv[i].z, xv[i].w};
#pragma unroll
            for (int q = 0; q < 4; ++q) { Vt[(cg * 8 + 2 * q) * 72 + lane] = (bf16_t)(w[q] & 0xffffu); Vt[(cg * 8 + 2 * q + 1) * 72 + lane] = (bf16_t)(w[q] >> 16); } }
        if (t < 128) DEC[(size_t)it * 128 + t] = __expf(LF[63 * LFS + t]);
        __syncthreads();
        bf16x8 af[2][2];
#pragma unroll
        for (int mt = 0; mt < 2; ++mt)
#pragma unroll
            for (int ks = 0; ks < 2; ++ks) af[mt][ks] = *(const LAS bf16x8*)(Vt + ((2 * C.wave + mt) * 16 + fr) * 72 + 32 * ks + 8 * fq);
        bf16_t* kvo = KV + (size_t)it * 256 * 128;
#pragma unroll
        for (int nt = 0; nt < 8; ++nt) {
            const bf16x8 b0 = *(const LAS bf16x8*)(KSt + (nt * 16 + fr) * 72 + 8 * fq), b1 = *(const LAS bf16x8*)(KSt + (nt * 16 + fr) * 72 + 32 + 8 * fq);
#pragma unroll
            for (int mt = 0; mt < 2; ++mt) { f32x4 acc = {0.f, 0.f, 0.f, 0.f}; acc = mmaT(af[mt][0], b0, acc); acc = mmaT(af[mt][1], b1, acc);
                *(uint2*)(kvo + (size_t)((2 * C.wave + mt) * 16 + fr) * 128 + nt * 16 + 4 * fq) = make_uint2(pk2(acc[0], acc[1]), pk2(acc[2], acc[3])); }
        }
    }
}
__device__ __forceinline__ void ph_gla_b(const Ctx& C0, KP p) {
    const Ctx C = refresh(C0);
    bf16_t* KV = (bf16_t*)(p->ws + WS_HB); const float* DEC = (const float*)(p->ws + WS_GDEC);
    for (int gt = C.vcu * NTHREADS + C.tid; gt < BATCH * GLH * 256 * 64; gt += C.G * NTHREADS) {
        const int bh = gt / (256 * 64), rem = gt % (256 * 64), e = rem / 64, d = (rem % 64) * 2, b = bh / GLH, h = bh % GLH;
        float s0 = 0.f, s1 = 0.f;
        for (int n0 = 0; n0 < NCH; n0 += 8) {
            unsigned kv[8]; float2 dc[8];
#pragma unroll
            for (int j = 0; j < 8; ++j) { const int n = (n0 + j < NCH) ? n0 + j : NCH - 1; const size_t ch = (size_t)(b * NCH + n) * GLH + h;
                kv[j] = *(const unsigned*)(KV + (ch * 256 + e) * 128 + d); dc[j] = *(const float2*)(DEC + ch * 128 + d); }
#pragma unroll
            for (int j = 0; j < 8; ++j) if (n0 + j < NCH) { const size_t ch = (size_t)(b * NCH + n0 + j) * GLH + h;
                *(unsigned*)(KV + (ch * 256 + e) * 128 + d) = pk2(s0, s1);
                s0 = s0 * dc[j].x + bflo(kv[j]); s1 = s1 * dc[j].y + bfhi(kv[j]); }
        }
    }
}
__device__ __forceinline__ void ph_gla_c(const Ctx& C0, KP p) {
    const Ctx C = refresh(C0);
    const int lane = C.lane, fr = lane & 15, fq = lane >> 4;
    LAS float* LF = (LAS float*)(C.lds + GLA_LF); LAS float* TOT = (LAS float*)(C.lds + GLA_TOT);
    LAS bf16_t* Qi = (LAS bf16_t*)(C.lds + GLA_C_QI); LAS bf16_t* Ki = (LAS bf16_t*)(C.lds + GLA_C_KI); LAS bf16_t* ATT = (LAS bf16_t*)(C.lds + GLA_C_ATT);
    LAS bf16_t* Vt = (LAS bf16_t*)(C.lds + GLA_C_VT); LAS float* RED = (LAS float*)(C.lds + GLA_C_RED);
    const bf16_t* P = (const bf16_t*)(p->ws + WS_P); const bf16_t* KV = (const bf16_t*)(p->ws + WS_HB); bf16_t* Y = (bf16_t*)(p->ws + WS_Y);
    for (int it = C.vcu; it < BATCH * NCH * GLH; it += C.G) {
        const int c = it / GLH, h = it % GLH, m0 = chunk_row0(c);
        v4u xq[2], xk[2], xv[4]; bf16x8 sbf[4][2]; uint2 rr[4][2];
        const bf16_t* Sn = KV + (size_t)it * 256 * 128;
#pragma unroll
        for (int i = 0; i < 2; ++i) { const int idx = C.tid + NTHREADS * i, tok = idx >> 4, cg = idx & 15;
            xq[i] = *(const v4u*)(P + (size_t)(m0 + tok) * NP0 + P0_Q + h * 128 + cg * 8); xk[i] = *(const v4u*)(P + (size_t)(m0 + tok) * NP0 + P0_K + h * 128 + cg * 8); }
#pragma unroll
        for (int i = 0; i < 4; ++i) xv[i] = *(const v4u*)(P + (size_t)(m0 + lane) * NP0 + P0_V + h * 256 + (C.wave + 8 * i) * 8);
#pragma unroll
        for (int ks = 0; ks < 4; ++ks)
#pragma unroll
            for (int et = 0; et < 2; ++et) sbf[ks][et] = *(const bf16x8*)(Sn + (size_t)((2 * C.wave + et) * 16 + fr) * 128 + 32 * ks + 8 * fq);
#pragma unroll
        for (int mt = 0; mt < 4; ++mt)
#pragma unroll
            for (int et = 0; et < 2; ++et) rr[mt][et] = *(const uint2*)(P + (size_t)(m0 + mt * 16 + fr) * NP0 + P0_R + h * 256 + (2 * C.wave + et) * 16 + 4 * fq);
        __syncthreads();
        gla_bcum(C, p, m0, h, LF, TOT);
#pragma unroll
        for (int i = 0; i < 2; ++i) { const int idx = C.tid + NTHREADS * i, tok = idx >> 4, cg = idx & 15;
            const unsigned wq[4] = {xq[i].x, xq[i].y, xq[i].z, xq[i].w}, wk[4] = {xk[i].x, xk[i].y, xk[i].z, xk[i].w}; unsigned oq[4], ok[4];
#pragma unroll
            for (int q = 0; q < 4; ++q) { const float b0 = LF[tok * LFS + cg * 8 + 2 * q], b1 = LF[tok * LFS + cg * 8 + 2 * q + 1];
                const float e0 = __expf(b0), e1 = __expf(b1);
                oq[q] = pk2(bflo(wq[q]) * 0.08838834764831845f * e0, bfhi(wq[q]) * 0.08838834764831845f * e1);
                ok[q] = pk2(bflo(wk[q]) * rcpf_(e0), bfhi(wk[q]) * rcpf_(e1)); }
            *(LAS v4u*)(Qi + tok * 136 + cg * 8) = (v4u){oq[0], oq[1], oq[2], oq[3]}; *(LAS v4u*)(Ki + tok * 136 + cg * 8) = (v4u){ok[0], ok[1], ok[2], ok[3]}; }
#pragma unroll
        for (int i = 0; i < 4; ++i) { const int cg = C.wave + 8 * i; const unsigned w[4] = {xv[i].x, xv[i].y, xv[i].z, xv[i].w};
#pragma unroll
            for (int q = 0; q < 4; ++q) { Vt[(cg * 8 + 2 * q) * 72 + lane] = (bf16_t)(w[q] & 0xffffu); Vt[(cg * 8 + 2 * q + 1) * 72 + lane] = (bf16_t)(w[q] >> 16); } }
        __syncthreads();
        {
            const int mt = C.wave >> 1;
            bf16x8 qa[4];
#pragma unroll
            for (int ks = 0; ks < 4; ++ks) qa[ks] = *(const LAS bf16x8*)(Qi + (mt * 16 + fr) * 136 + 32 * ks + 8 * fq);
#pragma unroll
            for (int j = 0; j < 2; ++j) { const int nt = 2 * (C.wave & 1) + j; f32x4 acc = {0.f, 0.f, 0.f, 0.f};
#pragma unroll
                for (int ks = 0; ks < 4; ++ks) acc = mmaT(qa[ks], *(const LAS bf16x8*)(Ki + (nt * 16 + fr) * 136 + 32 * ks + 8 * fq), acc);
                const int cc = mt * 16 + fr, s0 = nt * 16 + 4 * fq;
                const float a0 = (s0 <= cc) ? acc[0] : 0.f, a1 = (s0 + 1 <= cc) ? acc[1] : 0.f, a2 = (s0 + 2 <= cc) ? acc[2] : 0.f, a3 = (s0 + 3 <= cc) ? acc[3] : 0.f;
                *(LAS v2u*)(ATT + cc * 72 + s0) = (v2u){pk2(a0, a1), pk2(a2, a3)}; }
        }
        __syncthreads();
        f32x4 o[4][2];
#pragma unroll
        for (int mt = 0; mt < 4; ++mt)
#pragma unroll
            for (int et = 0; et < 2; ++et) o[mt][et] = (f32x4){0.f, 0.f, 0.f, 0.f};
#pragma unroll
        for (int ks = 0; ks < 2; ++ks) { bf16x8 vb[2];
#pragma unroll
            for (int et = 0; et < 2; ++et) vb[et] = *(const LAS bf16x8*)(Vt + ((2 * C.wave + et) * 16 + fr) * 72 + 32 * ks + 8 * fq);
#pragma unroll
            for (int mt = 0; mt < 4; ++mt) { const bf16x8 aa = *(const LAS bf16x8*)(ATT + (mt * 16 + fr) * 72 + 32 * ks + 8 * fq);
#pragma unroll
                for (int et = 0; et < 2; ++et) o[mt][et] = mmaT(aa, vb[et], o[mt][et]); } }
#pragma unroll
        for (int ks = 0; ks < 4; ++ks) {
#pragma unroll
            for (int mt = 0; mt < 4; ++mt) { const bf16x8 qa = *(const LAS bf16x8*)(Qi + (mt * 16 + fr) * 136 + 32 * ks + 8 * fq);
#pragma unroll
                for (int et = 0; et < 2; ++et) o[mt][et] = mmaT(qa, sbf[ks][et], o[mt][et]); } }
#pragma unroll
        for (int mt = 0; mt < 4; ++mt) { float s = 0.f;
#pragma unroll
            for (int et = 0; et < 2; ++et) s += (o[mt][et][0] * o[mt][et][0] + o[mt][et][1] * o[mt][et][1]) + (o[mt][et][2] * o[mt][et][2] + o[mt][et][3] * o[mt][et][3]);
            s += __shfl_xor(s, 16); s += __shfl_xor(s, 32);
            if (fq == 0) RED[(mt * 16 + fr) * 8 + C.wave] = s; }
        __syncthreads();
#pragma unroll
        for (int mt = 0; mt < 4; ++mt) { const int cc = mt * 16 + fr; float s = 0.f;
#pragma unroll
            for (int w = 0; w < 8; ++w) s += RED[cc * 8 + w];
            const float rs = rsqrtf(s * (1.0f / 256.0f) + NORM_EPS);
#pragma unroll
            for (int et = 0; et < 2; ++et) { const int e = (2 * C.wave + et) * 16 + 4 * fq; const f32x4 ng = *(const f32x4*)(p->in[15] + e);
                const uint2 rg = rr[mt][et];
                const float y0 = o[mt][et][0] * rs * ng[0] * siluf_(bflo(rg.x)), y1 = o[mt][et][1] * rs * ng[1] * siluf_(bfhi(rg.x)), y2 = o[mt][et][2] * rs * ng[2] * siluf_(bflo(rg.y)), y3 = o[mt][et][3] * rs * ng[3] * siluf_(bfhi(rg.y));
                *(uint2*)(Y + (size_t)(m0 + cc) * D + 1024 + h * 256 + e) = make_uint2(pk2(y0, y1), pk2(y2, y3)); } }
    }
}
constexpr int XST = 129;
constexpr int LRU_XCF = 0, LRU_XCB = LRU_XCF + 64 * XST * 4, LRU_AL = LRU_XCB + 64 * 136 * 2, LRU_BL = LRU_AL + 64 * XST * 4, LRU_QT = LRU_BL + 64 * XST * 4, LRU_VAL = LRU_QT + 4096, LRU_END = LRU_VAL + 256;
static_assert(LRU_END <= RING_BYTES, "LRU LDS");
struct LruW { bf16x8 ba[4], bx[4]; int hb; };
template <bool FINAL> __device__ __forceinline__ void lru_item(const Ctx& C, KP p, int it, LruW& W) {
    const int lane = C.lane, fr = lane & 15, fq = lane >> 4, t = C.tid;
    LAS float* XCF = (LAS float*)(C.lds + LRU_XCF); LAS bf16_t* XCB = (LAS bf16_t*)(C.lds + LRU_XCB); LAS float* AL = (LAS float*)(C.lds + LRU_AL); LAS float* BL = (LAS float*)(C.lds + LRU_BL);
    LAS float* QT = (LAS float*)(C.lds + LRU_QT); LAS float* VAL = (LAS float*)(C.lds + LRU_VAL);
    const bf16_t* P = (const bf16_t*)(p->ws + WS_P); bf16_t* Y = (bf16_t*)(p->ws + WS_Y); float* F = (float*)(p->ws + WS_LRUF);
    const bf16_t* WA = (const bf16_t*)(p->ws + WS_WLRU); const bf16_t* WX = WA + (size_t)LRB * 128 * 128;
    const int c = it / LRB, hb = it % LRB, m0 = chunk_row0(c);
    const int j = t & 127, qd = t >> 7, ch = hb * 128 + j;
    float hq = 0.f; if (FINAL) hq = F[((size_t)c * LRW + ch) * 2];
    bf16_t gate[16];
    if (FINAL) {
#pragma unroll
        for (int i = 0; i < 16; ++i) gate[i] = P[(size_t)(m0 + 16 * qd + i) * NP1 + P1_LG + ch]; }
    if (hb != W.hb) { W.hb = hb;
#pragma unroll
        for (int ks = 0; ks < 4; ++ks) { W.ba[ks] = *(const bf16x8*)(WA + ((size_t)hb * 128 + C.wave * 16 + fr) * 128 + 32 * ks + 8 * fq); W.bx[ks] = *(const bf16x8*)(WX + ((size_t)hb * 128 + C.wave * 16 + fr) * 128 + 32 * ks + 8 * fq); } }
    __syncthreads();
    for (int i = t; i < 64 * 16; i += NTHREADS) { const int tok = i >> 4, cg = i & 15, m = m0 + tok, chc = hb * 128 + cg * 8;
        float xc[8];
#pragma unroll
        for (int q = 0; q < 8; ++q) xc[q] = p->in[23][chc + q];
#pragma unroll
        for (int tt = 0; tt < 4; ++tt) { const int mm = m - 3 + tt; v4u x = {0u, 0u, 0u, 0u}; if (mm >= 0) x = *(const v4u*)(P + (size_t)mm * NP1 + P1_LX + chc);
            const f32x4 w0 = *(const f32x4*)(p->in[22] + tt * LRW + chc), w1 = *(const f32x4*)(p->in[22] + tt * LRW + chc + 4);
            xc[0] += w0[0] * bflo(x.x); xc[1] += w0[1] * bfhi(x.x); xc[2] += w0[2] * bflo(x.y); xc[3] += w0[3] * bfhi(x.y);
            xc[4] += w1[0] * bflo(x.z); xc[5] += w1[1] * bfhi(x.z); xc[6] += w1[2] * bflo(x.w); xc[7] += w1[3] * bfhi(x.w); }
#pragma unroll
        for (int q = 0; q < 8; ++q) XCF[tok * XST + cg * 8 + q] = xc[q];
        *(LAS v4u*)(XCB + tok * 136 + cg * 8) = (v4u){pk2(xc[0], xc[1]), pk2(xc[2], xc[3]), pk2(xc[4], xc[5]), pk2(xc[6], xc[7])}; }
    if (t < 64) VAL[t] = (((m0 + t) % LP) >= PADF) ? 1.0f : 0.0f;
    __syncthreads();
    {
        f32x4 ra[4], ri[4];
#pragma unroll
        for (int mt = 0; mt < 4; ++mt) { ra[mt] = (f32x4){0.f, 0.f, 0.f, 0.f}; ri[mt] = (f32x4){0.f, 0.f, 0.f, 0.f}; }
#pragma unroll
        for (int ks = 0; ks < 4; ++ks) {
#pragma unroll
            for (int mt = 0; mt < 4; ++mt) { const bf16x8 a = *(const LAS bf16x8*)(XCB + (mt * 16 + fr) * 136 + 32 * ks + 8 * fq); ra[mt] = mmaT(a, W.ba[ks], ra[mt]); ri[mt] = mmaT(a, W.bx[ks], ri[mt]); } }
        const int j0 = C.wave * 16 + 4 * fq, ch0 = hb * 128 + j0;
        const f32x4 b_a = *(const f32x4*)(p->in[25] + ch0), b_x = *(const f32x4*)(p->in[27] + ch0), lam = *(const f32x4*)(p->in[28] + ch0);
#pragma unroll
        for (int mt = 0; mt < 4; ++mt) { const int tok = mt * 16 + fr; const float vv = VAL[tok];
#pragma unroll
            for (int i = 0; i < 4; ++i) { const float r = sigmoidf_(ra[mt][i] + b_a[i]), ig = sigmoidf_(ri[mt][i] + b_x[i]);
                const float la = -8.0f * softplusf_(-lam[i]) * r;
                AL[tok * XST + j0 + i] = __expf(la); BL[tok * XST + j0 + i] = vv * sqrtf(neg_expm1f_(2.0f * la)) * (ig * XCF[tok * XST + j0 + i]); } }
    }
    __syncthreads();
    { float av[16], bv[16];
#pragma unroll
        for (int i = 0; i < 16; ++i) { av[i] = AL[(16 * qd + i) * XST + j]; bv[i] = BL[(16 * qd + i) * XST + j]; }
        float A = 1.f, h = 0.f;
#pragma unroll
        for (int i = 0; i < 16; ++i) { h = av[i] * h + bv[i]; A *= av[i]; av[i] = A; bv[i] = h; }
        QT[(qd * 128 + j) * 2] = A; QT[(qd * 128 + j) * 2 + 1] = h;
        __syncthreads();
        float Atot = 1.f;
#pragma unroll
        for (int q = 0; q < 4; ++q) { const float Aq = QT[(q * 128 + j) * 2], hh = QT[(q * 128 + j) * 2 + 1]; if (q < qd) hq = Aq * hq + hh; Atot *= Aq; }
        if (!FINAL) { if (qd == 3) { const float A3 = QT[(3 * 128 + j) * 2], h3 = QT[(3 * 128 + j) * 2 + 1]; *(float2*)(F + ((size_t)c * LRW + ch) * 2) = make_float2(Atot, A3 * hq + h3); } }
        else {
#pragma unroll
            for (int i = 0; i < 16; ++i) { const size_t m = (size_t)(m0 + 16 * qd + i);
                Y[m * D + 1024 + ch] = (bf16_t)f2bf((bv[i] + av[i] * hq) * gelu_tanh(bf2f(gate[i]))); }
        }
    }
}
__device__ __forceinline__ void ph_lru_carry(const Ctx& C0, KP p) {
    const Ctx C = refresh(C0);
    const int gt = C.vcu * NTHREADS + C.tid;
    if (gt >= BATCH * LRW) return;
    const int b = gt / LRW, ch = gt % LRW;
    float2* base = (float2*)(p->ws + WS_LRUF) + (size_t)b * NCH * LRW + ch;
    float carry = 0.f;
    for (int n0 = 0; n0 < NCH; n0 += 8) {
        float2 f[8];
#pragma unroll
        for (int jj = 0; jj < 8; ++jj) f[jj] = (n0 + jj < NCH) ? base[(size_t)(n0 + jj) * LRW] : make_float2(1.f, 0.f);
#pragma unroll
        for (int jj = 0; jj < 8; ++jj) if (n0 + jj < NCH) { base[(size_t)(n0 + jj) * LRW] = make_float2(carry, 0.f); carry = f[jj].x * carry + f[jj].y; }
    }
}

__device__ __forceinline__ void ph_gdn_conv(const Ctx& C0, KP p) {
    const Ctx C = refresh(C0);
    const int lane = C.lane;
    const bf16_t* P = (const bf16_t*)(p->ws + WS_P); bf16_t* HBq = (bf16_t*)(p->ws + WS_HB); bf16_t* Yv = (bf16_t*)(p->ws + WS_Y);
    for (int it = C.gw; it < BATCH * NCH * 2 * 6; it += C.ngw) {
        const int cgp = it % 6, hc = it / 6, r0 = chunk_row0(hc >> 1) + 32 * (hc & 1), col = cgp * 512 + lane * 8;
        float w[4][8];
#pragma unroll
        for (int tt = 0; tt < 4; ++tt) { const f32x4 w0 = *(const f32x4*)(p->in[18] + tt * 3072 + col), w1 = *(const f32x4*)(p->in[18] + tt * 3072 + col + 4);
#pragma unroll
            for (int q = 0; q < 4; ++q) { w[tt][q] = w0[q]; w[tt][4 + q] = w1[q]; } }
        v4u win[4];
#pragma unroll
        for (int tt = 0; tt < 3; ++tt) { const int mm = r0 - 3 + tt; win[tt + 1] = (mm >= 0) ? *(const v4u*)(P + (size_t)mm * NP1 + col) : (v4u){0u, 0u, 0u, 0u}; }
        for (int rb = 0; rb < 32; rb += 8) {
            v4u rows[8];
#pragma unroll
            for (int q = 0; q < 8; ++q) rows[q] = *(const v4u*)(P + (size_t)(r0 + rb + q) * NP1 + col);
#pragma unroll
            for (int q8 = 0; q8 < 8; ++q8) { const int m = r0 + rb + q8;
                win[0] = win[1]; win[1] = win[2]; win[2] = win[3]; win[3] = rows[q8];
                float y[8];
#pragma unroll
                for (int q = 0; q < 8; ++q) y[q] = 0.f;
#pragma unroll
                for (int tt = 0; tt < 4; ++tt) { const v4u x = win[tt];
                    y[0] += w[tt][0] * bflo(x.x); y[1] += w[tt][1] * bfhi(x.x); y[2] += w[tt][2] * bflo(x.y); y[3] += w[tt][3] * bfhi(x.y);
                    y[4] += w[tt][4] * bflo(x.z); y[5] += w[tt][5] * bfhi(x.z); y[6] += w[tt][6] * bflo(x.w); y[7] += w[tt][7] * bfhi(x.w); }
                float ss = 0.f;
#pragma unroll
                for (int q = 0; q < 8; ++q) { y[q] = siluf_(y[q]); ss += y[q] * y[q]; }
                float sc = 1.0f;
                if (cgp < 4) { ss += __shfl_xor(ss, 1); ss += __shfl_xor(ss, 2); ss += __shfl_xor(ss, 4); ss += __shfl_xor(ss, 8);
                    sc = rsqrtf(ss + NORM_EPS) * (cgp < 2 ? 0.08838834764831845f : 1.0f); }
                if ((m % LP) < PADF) sc = 0.f;
                const v4u o = {pk2(y[0] * sc, y[1] * sc), pk2(y[2] * sc, y[3] * sc), pk2(y[4] * sc, y[5] * sc), pk2(y[6] * sc, y[7] * sc)};
                if (cgp < 4) *(v4u*)(HBq + (size_t)m * D + col) = o;
                else *(v4u*)(Yv + (size_t)m * D + (col - 2048)) = o;
            }
        }
    }
}
template <int S4, int N4> __device__ __forceinline__ void tri_inner(float& acc, const float (&x)[64], const LAS float* mrow) {
    if constexpr (S4 < N4) { const f32x4 mm = *(const LAS f32x4*)(mrow + 4 * S4);
        acc -= mm[0] * x[4 * S4]; acc -= mm[1] * x[4 * S4 + 1]; acc -= mm[2] * x[4 * S4 + 2]; acc -= mm[3] * x[4 * S4 + 3];
        tri_inner<S4 + 1, N4>(acc, x, mrow); }
}
template <int CC> __device__ __forceinline__ void tri_rows(float (&x)[64], const LAS float* MM, const LAS float* RHS, int t) {
    if constexpr (CC < 64) { float acc = RHS[CC * 256 + t]; tri_inner<0, (CC + 3) / 4>(acc, x, MM + CC * 68); asm volatile("" : "+v"(acc) :: "memory"); x[CC] = acc;
        tri_rows<CC + 1>(x, MM, RHS, t); }
}
constexpr int GP_KN = 0, GP_QN = GP_KN + 64 * 136 * 2, GP_MM = GP_QN + 64 * 136 * 2, GP_RHS = GP_MM + 64 * 68 * 4, GP_GC = GP_RHS + 64 * 256 * 4, GP_END = GP_GC + 1024;
static_assert(GP_END <= RING_BYTES, "GDN prep LDS");
__device__ __forceinline__ void ph_gdn_prep(const Ctx& C0, KP p) {
    const Ctx C = refresh(C0);
    const int lane = C.lane, fr = lane & 15, fq = lane >> 4, t = C.tid;
    LAS bf16_t* KN = (LAS bf16_t*)(C.lds + GP_KN); LAS bf16_t* QN = (LAS bf16_t*)(C.lds + GP_QN); LAS float* MM = (LAS float*)(C.lds + GP_MM);
    LAS float* RHS = (LAS float*)(C.lds + GP_RHS); LAS float* GC = (LAS float*)(C.lds + GP_GC); LAS float* BETA = GC + 64; LAS float* EG = GC + 128;
    bf16_t* HBq = (bf16_t*)(p->ws + WS_HB); const bf16_t* Yv = (const bf16_t*)(p->ws + WS_Y); bf16_t* P = (bf16_t*)(p->ws + WS_P);
    const float* SK = (const float*)(p->ws + WS_SK); float* GD = (float*)(p->ws + WS_LRUF) + 2 * BATCH * NCH * LRW;
    for (int it = C.vcu; it < BATCH * NCH * GDH; it += C.G) {
        const int c = it / GDH, h = it % GDH, m0 = chunk_row0(c);
        __syncthreads();
        for (int i = t; i < 64 * 16; i += NTHREADS) { const int tok = i >> 4, cg = i & 15;
            *(LAS v4u*)(QN + tok * 136 + cg * 8) = *(const v4u*)(HBq + (size_t)(m0 + tok) * D + h * 128 + cg * 8);
            *(LAS v4u*)(KN + tok * 136 + cg * 8) = *(const v4u*)(HBq + (size_t)(m0 + tok) * D + 1024 + h * 128 + cg * 8); }
        if (t < 64) { const int m = m0 + t; const bool val = (m % LP) >= PADF;
            float g = val ? -__expf(p->in[19][h]) * softplusf_(SK[(size_t)m * 16 + 8 + h] + p->in[20][h]) : 0.f;
            BETA[t] = val ? sigmoidf_(SK[(size_t)m * 16 + h]) : 0.f;
#pragma unroll
            for (int o = 1; o < 64; o <<= 1) { const float x = __shfl_up(g, o); if (lane >= o) g += x; }
            GC[t] = g; EG[t] = __expf(g); }
        __syncthreads();
        {
            const int mt = C.wave >> 1;
            bf16x8 ka[4], qa[4];
#pragma unroll
            for (int ks = 0; ks < 4; ++ks) { ka[ks] = *(const LAS bf16x8*)(KN + (mt * 16 + fr) * 136 + 32 * ks + 8 * fq); qa[ks] = *(const LAS bf16x8*)(QN + (mt * 16 + fr) * 136 + 32 * ks + 8 * fq); }
#pragma unroll
            for (int jn = 0; jn < 2; ++jn) { const int nt = 2 * (C.wave & 1) + jn; f32x4 kk = {0.f, 0.f, 0.f, 0.f}, qk = {0.f, 0.f, 0.f, 0.f};
#pragma unroll
                for (int ks = 0; ks < 4; ++ks) { const bf16x8 kb = *(const LAS bf16x8*)(KN + (nt * 16 + fr) * 136 + 32 * ks + 8 * fq); kk = mmaT(ka[ks], kb, kk); qk = mmaT(qa[ks], kb, qk); }
                const int cc = mt * 16 + fr, s0 = nt * 16 + 4 * fq; const float gcc = GC[cc], bc = BETA[cc];
                float mv[4], av[4];
#pragma unroll
                for (int i = 0; i < 4; ++i) { const int s = s0 + i; const float dcy = (s <= cc) ? __expf(gcc - GC[s]) : 0.f; mv[i] = (s < cc) ? bc * kk[i] * dcy : 0.f; av[i] = qk[i] * dcy; }
                *(LAS f32x4*)(MM + cc * 68 + s0) = (f32x4){mv[0], mv[1], mv[2], mv[3]};
                *(uint2*)(P + (size_t)(m0 + cc) * NP1 + 1024 + h * 64 + s0) = make_uint2(pk2(av[0], av[1]), pk2(av[2], av[3])); }
        }
        for (int i = t; i < 64 * 16; i += NTHREADS) { const int tok = i >> 4, cg = i & 15; const float bt = BETA[tok], be = bt * EG[tok];
            const v4u xv = *(const v4u*)(Yv + (size_t)(m0 + tok) * D + h * 128 + cg * 8); const v4u xk = *(const LAS v4u*)(KN + tok * 136 + cg * 8);
            LAS float* r = RHS + tok * 256 + cg * 8;
            r[0] = bflo(xv.x) * bt; r[1] = bfhi(xv.x) * bt; r[2] = bflo(xv.y) * bt; r[3] = bfhi(xv.y) * bt; r[4] = bflo(xv.z) * bt; r[5] = bfhi(xv.z) * bt; r[6] = bflo(xv.w) * bt; r[7] = bfhi(xv.w) * bt;
            r[128] = bflo(xk.x) * be; r[129] = bfhi(xk.x) * be; r[130] = bflo(xk.y) * be; r[131] = bfhi(xk.y) * be; r[132] = bflo(xk.z) * be; r[133] = bfhi(xk.z) * be; r[134] = bflo(xk.w) * be; r[135] = bfhi(xk.w) * be; }
        __syncthreads();
        if (C.wave < 4) {
            float x[64];
#pragma unroll
            for (int cc = 0; cc < 64; ++cc) x[cc] = 0.f;
            tri_rows<0>(x, MM, RHS, t);
            bf16_t* dst = (t < 128) ? (P + (size_t)m0 * NP1 + 2048 + h * 128 + t) : (P + (size_t)m0 * NP1 + h * 128 + (t - 128));
#pragma unroll
            for (int cc = 0; cc < 64; ++cc) dst[(size_t)cc * NP1] = (bf16_t)f2bf(x[cc]);
        } else {
            const float glast = GC[63];
            for (int i = t - 256; i < 64 * 16; i += 256) { const int tok = i >> 4, cg = i & 15; const float eq = EG[tok], ek = __expf(glast - GC[tok]);
                const v4u xq = *(const LAS v4u*)(QN + tok * 136 + cg * 8), xk = *(const LAS v4u*)(KN + tok * 136 + cg * 8);
                const v4u oq = {pk2(bflo(xq.x) * eq, bfhi(xq.x) * eq), pk2(bflo(xq.y) * eq, bfhi(xq.y) * eq), pk2(bflo(xq.z) * eq, bfhi(xq.z) * eq), pk2(bflo(xq.w) * eq, bfhi(xq.w) * eq)};
                const v4u ok = {pk2(bflo(xk.x) * ek, bfhi(xk.x) * ek), pk2(bflo(xk.y) * ek, bfhi(xk.y) * ek), pk2(bflo(xk.z) * ek, bfhi(xk.z) * ek), pk2(bflo(xk.w) * ek, bfhi(xk.w) * ek)};
                *(v4u*)(HBq + (size_t)(m0 + tok) * D + h * 128 + cg * 8) = oq; *(v4u*)(HBq + (size_t)(m0 + tok) * D + 1024 + h * 128 + cg * 8) = ok; }
            if (t == 256) GD[it] = __expf(glast);
        }
    }
}
constexpr int GS_W = 0, GS_QD = GS_W + 64 * 136 * 2, GS_KT = GS_QD + 64 * 136 * 2, GS_AQ = GS_KT + 128 * 72 * 2, GS_U = GS_AQ + 64 * 72 * 2, GS_BUF = GS_U + 64 * 40 * 2;
constexpr int GS_ST = 2 * GS_BUF, GS_VN = GS_ST + 2 * 16 * 136 * 2, GS_DEC = GS_VN + 2 * 16 * 72 * 2, GS_END = GS_DEC + 1024;
static_assert(GS_END <= RING_BYTES, "GDN seq LDS");
constexpr int GDN_STREAMS = BATCH * GDH * 4;
#define GS_STAGE_LOAD(n_) do { const size_t m0_ = (size_t)b * LP + (size_t)(n_) * 64; \
            const char* bW = (const char*)(P + m0_ * NP1 + h * 128); const char* bQ = (const char*)(HBq + m0_ * D + h * 128); const char* bK = (const char*)(HBq + m0_ * D + 1024 + h * 128); \
            const char* bA = (const char*)(P + m0_ * NP1 + 1024 + h * 64); const char* bU = (const char*)(P + m0_ * NP1 + 2048 + h * 128 + e0); \
            _Pragma("unroll") for (int i = 0; i < 8; ++i) { rw[i] = *(const v4u*)(bW + (size_t)i * (8 * NP1 * 2) + offW); rq[i] = *(const v4u*)(bQ + (size_t)i * (8 * D * 2) + offQ); rk[i] = *(const v4u*)(bK + (size_t)i * 32 + offK); } \
            _Pragma("unroll") for (int i = 0; i < 4; ++i) ra[i] = *(const v4u*)(bA + (size_t)i * (16 * NP1 * 2) + offA); \
            _Pragma("unroll") for (int i = 0; i < 2; ++i) ru[i] = *(const v4u*)(bU + (size_t)i * (32 * NP1 * 2) + offU); } while (0)
#define GS_STAGE_STORE(buf_) do { LAS bf16_t* B_ = (LAS bf16_t*)(C.lds + (buf_) * GS_BUF); \
            _Pragma("unroll") for (int i = 0; i < 8; ++i) { \
                *(LAS v4u*)(B_ + GS_W / 2 + (tid2 >> 4) * 136 + (tid2 & 15) * 8 + i * (8 * 136)) = rw[i]; *(LAS v4u*)(B_ + GS_QD / 2 + (tid2 >> 4) * 136 + (tid2 & 15) * 8 + i * (8 * 136)) = rq[i]; \
                const unsigned ww[4] = {rk[i].x, rk[i].y, rk[i].z, rk[i].w}; \
                _Pragma("unroll") for (int q = 0; q < 4; ++q) { B_[GS_KT / 2 + (tid2 >> 6) * (8 * 72) + (tid2 & 63) + (i * 16 + 2 * q) * 72] = (bf16_t)(ww[q] & 0xffffu); B_[GS_KT / 2 + (tid2 >> 6) * (8 * 72) + (tid2 & 63) + (i * 16 + 2 * q + 1) * 72] = (bf16_t)(ww[q] >> 16); } } \
            _Pragma("unroll") for (int i = 0; i < 4; ++i) *(LAS v4u*)(B_ + GS_AQ / 2 + (tid2 >> 3) * 72 + (tid2 & 7) * 8 + i * (16 * 72)) = ra[i]; \
            _Pragma("unroll") for (int i = 0; i < 2; ++i) *(LAS v4u*)(B_ + GS_U / 2 + (tid2 >> 2) * 40 + (tid2 & 3) * 8 + i * (32 * 40)) = ru[i]; } while (0)
__device__ __forceinline__ void ph_gdn_seq(const Ctx& C0, KP p, int st0, int stn) {
    const Ctx C = refresh(C0);
    const int lane = C.lane, fr = lane & 15, fq = lane >> 4, t = C.tid, w = C.wave;
    LAS bf16_t* ST = (LAS bf16_t*)(C.lds + GS_ST) + (w & 1) * 16 * 136; LAS bf16_t* VN = (LAS bf16_t*)(C.lds + GS_VN) + (w & 1) * 16 * 72; LAS float* DECL = (LAS float*)(C.lds + GS_DEC);
    const bf16_t* HBq = (const bf16_t*)(p->ws + WS_HB); const bf16_t* P = (const bf16_t*)(p->ws + WS_P); bf16_t* Y = (bf16_t*)(p->ws + WS_Y);
    const float* GD = (const float*)(p->ws + WS_LRUF) + 2 * BATCH * NCH * LRW;
    for (int st = st0; st < GDN_STREAMS; st += stn) {
        const int b = st / (GDH * 4), h = (st >> 2) % GDH, e0 = (st & 3) * 32;
        __syncthreads();
        if (w < 2) {
#pragma unroll
            for (int nt = 0; nt < 8; ++nt) *(LAS v2u*)(ST + fr * 136 + nt * 16 + 4 * fq) = (v2u){0u, 0u}; }
        if (t < NCH) DECL[t] = GD[(size_t)(b * NCH + t) * GDH + h];
        __syncthreads();
        if (w >= 4) {
            v4u rw[8], rq[8], rk[8], ra[4], ru[2];
            const int grp = (w >> 1) - 2, tid2 = t & 127;
            const unsigned offW = (unsigned)(((tid2 >> 4) * NP1 + (tid2 & 15) * 8) * 2), offQ = (unsigned)(((tid2 >> 4) * D + (tid2 & 15) * 8) * 2);
            const unsigned offK = (unsigned)(((tid2 & 63) * D + (tid2 >> 6) * 8) * 2), offA = (unsigned)(((tid2 >> 3) * NP1 + (tid2 & 7) * 8) * 2), offU = (unsigned)(((tid2 >> 2) * NP1 + (tid2 & 3) * 8) * 2);
            if (grp == 0) { GS_STAGE_LOAD(0); GS_STAGE_STORE(0); GS_STAGE_LOAD(2); } else GS_STAGE_LOAD(1);
            LBAR();
            for (int n = 0; n < NCH; ++n) {
                if (n + 1 < NCH && grp == ((n + 1) & 1)) { GS_STAGE_STORE((n + 1) & 1); if (n + 3 < NCH) GS_STAGE_LOAD(n + 3); }
                LBAR();
            }
        } else if (w < 2) {
            f32x4 S[8];
#pragma unroll
            for (int nt = 0; nt < 8; ++nt) S[nt] = (f32x4){0.f, 0.f, 0.f, 0.f};
            LBAR();
            for (int n = 0; n < NCH; ++n) {
                const LAS bf16_t* B_ = (const LAS bf16_t*)(C.lds + (n & 1) * GS_BUF);
                const LAS bf16_t* Wl = B_ + GS_W / 2; const LAS bf16_t* QD = B_ + GS_QD / 2; const LAS bf16_t* KT = B_ + GS_KT / 2; const LAS bf16_t* AQ = B_ + GS_AQ / 2; const LAS bf16_t* Ul = B_ + GS_U / 2;
                const float dec = DECL[n];
                const size_t m0 = (size_t)b * LP + (size_t)n * 64;
                f32x4 vn[4], o[4];
#pragma unroll
                for (int mt = 0; mt < 4; ++mt) { vn[mt] = (f32x4){0.f, 0.f, 0.f, 0.f}; o[mt] = (f32x4){0.f, 0.f, 0.f, 0.f}; }
                bf16x8 sb[4], wf[4][4], qf[4][4];
#pragma unroll
                for (int ks = 0; ks < 4; ++ks) sb[ks] = *(const LAS bf16x8*)(ST + fr * 136 + 32 * ks + 8 * fq);
#pragma unroll
                for (int ks = 0; ks < 4; ++ks)
#pragma unroll
                    for (int mt = 0; mt < 4; ++mt) wf[ks][mt] = *(const LAS bf16x8*)(Wl + (mt * 16 + fr) * 136 + 32 * ks + 8 * fq);
#pragma unroll
                for (int ks = 0; ks < 4; ++ks)
#pragma unroll
                    for (int mt = 0; mt < 4; ++mt) qf[ks][mt] = *(const LAS bf16x8*)(QD + (mt * 16 + fr) * 136 + 32 * ks + 8 * fq);
                v2u uu[4];
#pragma unroll
                for (int mt = 0; mt < 4; ++mt) uu[mt] = *(const LAS v2u*)(Ul + (mt * 16 + fr) * 40 + w * 16 + 4 * fq);
#pragma unroll
                for (int ks = 0; ks < 4; ++ks)
#pragma unroll
                    for (int mt = 0; mt < 4; ++mt) vn[mt] = mmaT(wf[ks][mt], sb[ks], vn[mt]);
                bf16x8 kf[8][2];
#pragma unroll
                for (int nt = 0; nt < 8; ++nt)
#pragma unroll
                    for (int ks = 0; ks < 2; ++ks) kf[nt][ks] = *(const LAS bf16x8*)(KT + (nt * 16 + fr) * 72 + 32 * ks + 8 * fq);
#pragma unroll
                for (int mt = 0; mt < 4; ++mt) {
                    const float v0 = bflo(uu[mt].x) - vn[mt][0], v1 = bfhi(uu[mt].x) - vn[mt][1], v2 = bflo(uu[mt].y) - vn[mt][2], v3 = bfhi(uu[mt].y) - vn[mt][3];
                    VN[(4 * fq + 0) * 72 + mt * 16 + fr] = (bf16_t)f2bf(v0); VN[(4 * fq + 1) * 72 + mt * 16 + fr] = (bf16_t)f2bf(v1);
                    VN[(4 * fq + 2) * 72 + mt * 16 + fr] = (bf16_t)f2bf(v2); VN[(4 * fq + 3) * 72 + mt * 16 + fr] = (bf16_t)f2bf(v3); }
#pragma unroll
                for (int ks = 0; ks < 4; ++ks)
#pragma unroll
                    for (int mt = 0; mt < 4; ++mt) o[mt] = mmaT(qf[ks][mt], sb[ks], o[mt]);
                LDSW();
                bf16x8 vb[2], af[4][2];
#pragma unroll
                for (int ks = 0; ks < 2; ++ks) vb[ks] = *(const LAS bf16x8*)(VN + fr * 72 + 32 * ks + 8 * fq);
#pragma unroll
                for (int mt = 0; mt < 4; ++mt)
#pragma unroll
                    for (int ks = 0; ks < 2; ++ks) af[mt][ks] = *(const LAS bf16x8*)(AQ + (mt * 16 + fr) * 72 + 32 * ks + 8 * fq);
#pragma unroll
                for (int nt = 0; nt < 8; ++nt) { S[nt] *= dec;
#pragma unroll
                    for (int ks = 0; ks < 2; ++ks) S[nt] = mmaT(vb[ks], kf[nt][ks], S[nt]); }
#pragma unroll
                for (int nt = 0; nt < 8; ++nt) *(LAS v2u*)(ST + fr * 136 + nt * 16 + 4 * fq) = (v2u){pk2(S[nt][0], S[nt][1]), pk2(S[nt][2], S[nt][3])};
#pragma unroll
                for (int mt = 0; mt < 4; ++mt) {
#pragma unroll
                    for (int ks = 0; ks < 2; ++ks) o[mt] = mmaT(af[mt][ks], vb[ks], o[mt]);
                    *(uint2*)(Y + (m0 + mt * 16 + fr) * D + h * 128 + e0 + w * 16 + 4 * fq) = make_uint2(pk2(o[mt][0], o[mt][1]), pk2(o[mt][2], o[mt][3])); }
                LBAR();
            }
        } else {
            LBAR();
            for (int n = 0; n < NCH; ++n) LBAR();
        }
    }
}
#undef GS_STAGE_LOAD
#undef GS_STAGE_STORE
__device__ __forceinline__ void ph_gdn_norm(const Ctx& C0, KP p) {
    const Ctx C = refresh(C0);
    const int lane = C.lane;
    bf16_t* Y = (bf16_t*)(p->ws + WS_Y); const bf16_t* P = (const bf16_t*)(p->ws + WS_P);
    for (int m = C.gw; m < MROWS; m += C.ngw) {
        bf16_t* yr = Y + (size_t)m * D + lane * 16; const bf16_t* zr = P + (size_t)m * NP1 + P1_Z + lane * 16;
        const v4u a0 = *(const v4u*)yr, a1 = *(const v4u*)(yr + 8), z0 = *(const v4u*)zr, z1 = *(const v4u*)(zr + 8);
        const unsigned aw[8] = {a0.x, a0.y, a0.z, a0.w, a1.x, a1.y, a1.z, a1.w}, zw[8] = {z0.x, z0.y, z0.z, z0.w, z1.x, z1.y, z1.z, z1.w};
        float ss = 0.f;
#pragma unroll
        for (int q = 0; q < 8; ++q) ss += bflo(aw[q]) * bflo(aw[q]) + bfhi(aw[q]) * bfhi(aw[q]);
        ss += __shfl_xor(ss, 1); ss += __shfl_xor(ss, 2); ss += __shfl_xor(ss, 4);
        const float rs = rsqrtf(ss * (1.0f / 128.0f) + NORM_EPS);
        const float* ng = p->in[21] + (lane & 7) * 16;
        unsigned ow[8];
#pragma unroll
        for (int q = 0; q < 8; ++q) ow[q] = pk2(bflo(aw[q]) * rs * ng[2 * q] * siluf_(bflo(zw[q])), bfhi(aw[q]) * rs * ng[2 * q + 1] * siluf_(bfhi(zw[q])));
        *(v4u*)yr = (v4u){ow[0], ow[1], ow[2], ow[3]}; *(v4u*)(yr + 8) = (v4u){ow[4], ow[5], ow[6], ow[7]};
    }
}

template <bool FINAL> __device__ __forceinline__ void ph_lru(const Ctx& C0, KP p, int worker, int nworkers) {
    const Ctx C = refresh(C0);
    LruW W; W.hb = -1;
#pragma unroll
    for (int q = 0; q < 4; ++q) { W.ba[q] = (bf16x8){0, 0, 0, 0, 0, 0, 0, 0}; W.bx[q] = W.ba[q]; }
    for (int it = worker; it < BATCH * NCH * LRB; it += nworkers) lru_item<FINAL>(C, p, it, W);
}
#ifndef DUP_SUB
#define DUP_SUB 0
#endif
#ifndef DUP_PHASE
#define DUP_PHASE -1
#endif
#define REP(k) for (int rep_ = 0; rep_ < ((DUP_PHASE) == (k) ? 2 : 1); ++rep_)
#define IN(k) in_ph(k)
#define SEAM(k) do { if (in_ph(k) && in_ph((k) + 1)) xcd_barrier(bar); } while (0)
template <int L> __device__ __forceinline__ void layer_phases(const Ctx& C, const XcdBarrier& bar, PG8_LAS unsigned char* ring) {
        const int base = 1 + 11 * L;
        REP(1 + 11 * L + 0) if (IN(base + 0)) {
            KP p = kp(); const int N = L ? NP1 : NP0;
            pg8::Gemm g{(const bf16_t*)(p->ws + WS_HB), (const bf16_t*)(p->ws + (L ? WS_WIN1 : WS_WIN0)), MP, N, D}; pg8::StaticOrder S; S.init(MP, N, C.G, (int)blockIdx.x);
            EpiStoreBf16 E{(bf16_t*)(p->ws + WS_P), N};
            pg8::gemm_phase<EpiStoreBf16, pg8::StaticOrder, true, true>(ring, g, S, E);
            ph_skinny(C, kp(), L);
            cvt_pull(C, kp(), L);
        }
        SEAM(base + 0);
        if constexpr (L == 0) {
            REP(1 + 11 * L + 1) if (IN(base + 1)) { for (int r2 = 0; r2 < (DUP_SUB == 3 ? 2 : 1); ++r2) ph_s5<false>(C, kp()); for (int r2 = 0; r2 < (DUP_SUB == 4 ? 2 : 1); ++r2) ph_gla_a(C, kp()); }
            SEAM(base + 1);
            REP(1 + 11 * L + 2) if (IN(base + 2)) { ph_s5_carry(C, kp()); ph_gla_b(C, kp()); }
            SEAM(base + 2);
            REP(1 + 11 * L + 3) if (IN(base + 3)) { for (int r2 = 0; r2 < (DUP_SUB == 5 ? 2 : 1); ++r2) ph_s5<true>(C, kp()); for (int r2 = 0; r2 < (DUP_SUB == 6 ? 2 : 1); ++r2) ph_gla_c(C, kp()); }
            SEAM(base + 3);
            REP(1 + 11 * L + 4) if (IN(base + 4)) {
                KP p = kp();
                pg8::Gemm g{(const bf16_t*)(p->ws + WS_Z), (const bf16_t*)(p->ws + WS_WGLU), MP, S5W, S5W}; pg8::StaticOrder S; S.init(MP, S5W, C.G, (int)blockIdx.x);
                EpiGlu E{(const bf16_t*)(p->ws + WS_Z), p->in[12], (bf16_t*)(p->ws + WS_Y)};
                pg8::gemm_phase<EpiGlu, pg8::StaticOrder, true, true>(ring, g, S, E);
            }
            SEAM(base + 4);
        } else {
            REP(1 + 11 * L + 1) if (IN(base + 1)) { for (int r2 = 0; r2 < (DUP_SUB == 7 ? 2 : 1); ++r2) ph_gdn_conv(C, kp()); for (int r2 = 0; r2 < (DUP_SUB == 8 ? 2 : 1); ++r2) ph_lru<false>(C, kp(), C.vcu, C.G); }
            SEAM(base + 1);
            REP(1 + 11 * L + 2) if (IN(base + 2)) { ph_gdn_prep(C, kp()); ph_lru_carry(C, kp()); }
            SEAM(base + 2);
            REP(1 + 11 * L + 3) if (IN(base + 3)) {
                if (C.G != 256) { ph_gdn_seq(C, kp(), C.vcu, C.G); ph_lru<true>(C, kp(), C.vcu, C.G); }
                else { const int xcd = C.vcu >> 5, j = C.vcu & 31;
                    if (j < 8) { for (int r2 = 0; r2 < (DUP_SUB == 1 ? 2 : 1); ++r2) ph_gdn_seq(C, kp(), (((j >> 2) * 8 + xcd) << 2) + (j & 3), GDN_STREAMS); }
                    else { for (int r2 = 0; r2 < (DUP_SUB == 2 ? 2 : 1); ++r2) ph_lru<true>(C, kp(), xcd * 24 + (j - 8), 192); } }
            }
            SEAM(base + 3);
            REP(1 + 11 * L + 4) if (IN(base + 4)) ph_gdn_norm(C, kp());
            SEAM(base + 4);
        }
        REP(1 + 11 * L + 5) if (IN(base + 5)) {
            KP p = kp();
            pg8::Gemm g{(const bf16_t*)(p->ws + WS_Y), (const bf16_t*)(p->ws + (L ? WS_WOUT1 : WS_WOUT0)), MP, D, D}; pg8::StaticOrder S; S.init(MP, D, C.G, (int)blockIdx.x);
            EpiStoreBf16 E{(bf16_t*)(p->ws + WS_MIX), D};
            pg8::gemm_phase<EpiStoreBf16, pg8::StaticOrder, true, true>(ring, g, S, E);
        }
        SEAM(base + 5);
        REP(1 + 11 * L + 6) if (IN(base + 6)) ph_ln1_router(C, kp(), L);
        SEAM(base + 6);
        REP(1 + 11 * L + 8) if (IN(base + 8)) {
            KP p = kp();
            const int nt = moe_build_tiles(C, (unsigned*)(p->ws + WS_CTL) + CW_CNT + L * 32);
            MoeGatherOrder S{(const volatile LAS int*)(C.lds + LDS_TILETAB), nt, 2, C.G, C.vcu, (const int*)(p->ws + WS_LISTE)};
            pg8::Gemm g{(const bf16_t*)(p->ws + WS_HB), (const bf16_t*)(p->ws + WS_MW1), 0, 0, D}; EpiMoe1 E{(bf16_t*)(p->ws + WS_HH), (const int*)(p->ws + WS_LISTE), (const float*)(p->ws + WS_TOKW)};
            pg8::gemm_phase<EpiMoe1, MoeGatherOrder, true, true>(ring, g, S, E);
        }
        SEAM(base + 8);
        REP(1 + 11 * L + 9) if (IN(base + 9)) {
            KP p = kp();
            const int nt = moe_build_tiles(C, (unsigned*)(p->ws + WS_CTL) + CW_CNT + L * 32);
            MoeOrder S{(const volatile LAS int*)(C.lds + LDS_TILETAB), nt, 8, C.G, C.vcu};
            int kk = MOE_FF; asm volatile("" : "+s"(kk));
            pg8::Gemm g{(const bf16_t*)(p->ws + WS_HH), (const bf16_t*)(p->ws + WS_MW2), 0, 0, kk}; EpiMoe2 E{(bf16_t*)(p->ws + WS_XS)};
            pg8::gemm_phase<EpiMoe2, MoeOrder, true, true>(ring, g, S, E);
        }
        SEAM(base + 9);
        REP(1 + 11 * L + 10) if (IN(base + 10)) ph_ln2(C, kp(), L);
        SEAM(base + 10);
    }
__global__ void __launch_bounds__(NTHREADS, 2) mk(Args a_unused) {
    extern __shared__ __attribute__((aligned(16))) unsigned char shm[];
    Ctx C; C.lds = (LAS unsigned char*)shm; C.tid = threadIdx.x; C.lane = C.tid & 63; C.wave = __builtin_amdgcn_readfirstlane(C.tid >> 6);
    C.G = gridDim.x; { const int bx = blockIdx.x; C.vcu = (C.G % 8 == 0) ? (bx % 8) * (C.G / 8) + bx / 8 : bx; }
    C.gw = C.vcu * NWAVES + C.wave; C.ngw = C.G * NWAVES;
    for (int u = C.tid; u < (LDS_BYTES - LDSCTL_OFF) / 4; u += NTHREADS) ((LAS unsigned*)(C.lds + LDSCTL_OFF))[u] = 0u;
    __syncthreads();
    XcdBarrier bar;
    { KA a = kargs(); bar = xcd_barrier_post((unsigned*)(a->p.ws + WS_CTL) + CW_BAR + a->li * XCD_BAR_WORDS, (volatile LAS unsigned*)(C.lds + LDSCTL_OFF)); }
    PG8_LAS unsigned char* ring = (PG8_LAS unsigned char*)shm;

    REP(0) if (IN(0)) ph_prologue(C, kp());
    SEAM(0);
    layer_phases<0>(C, bar, ring);
    layer_phases<1>(C, bar, ring);
}
#undef IN
#undef SEAM
#ifndef FUSE
#define FUSE 1
#endif
static void launch_mk(const Ptrs& p, int lo, int hi, int& li, int grid, hipStream_t s) {
    Args a{}; a.p = p; a.ph_lo = lo; a.ph_hi = hi; a.li = li++; a.pad = 0;
    if (FUSE) { hipLaunchKernelGGL(mk, dim3(grid), dim3(NTHREADS), LDS_BYTES, s, a); }
    else for (int k = lo; k < hi; ++k) { a.ph_lo = k; a.ph_hi = k + 1; a.li = li++; hipLaunchKernelGGL(mk, dim3(grid), dim3(NTHREADS), LDS_BYTES, s, a); }
}
extern "C" void kernel_launch(void* const* d_in, const int* in_sizes, int n_in, void* d_out, int out_size, void* d_ws, size_t ws_size, hipStream_t stream) {
    static int grid = 0;
    if (grid == 0) {
        if (n_in != 41 || ws_size < WS_END || out_size != BATCH * SEQ * D) { fprintf(stderr, "kernel_launch: unexpected shapes n_in %d ws %zu (need %zu) out %d\n", n_in, ws_size, (size_t)WS_END, out_size); grid = -1; }
        else {
            int dev = 0, cus = 0;
            if (hipGetDevice(&dev) != hipSuccess || hipDeviceGetAttribute(&cus, hipDeviceAttributeMultiprocessorCount, dev) != hipSuccess) { grid = -1; }
            else if (hipFuncSetAttribute((const void*)mk, hipFuncAttributeMaxDynamicSharedMemorySize, LDS_BYTES) != hipSuccess) { fprintf(stderr, "kernel_launch: hipFuncSetAttribute failed\n"); grid = -1; }
            else grid = cus;
        }
    }
    if (grid < 0) return;
    Ptrs p{};
    for (int i = 0; i < 41; ++i) p.in[i] = (const float*)d_in[i];
    p.out = (float*)d_out; p.ws = (unsigned char*)d_ws;
    hipMemsetAsync((char*)d_ws + WS_CTL, 0, 1 * MiB, stream);
    int li = 0;
    launch_mk(p, 0, NPHASES, li, grid, stream);
}
```

```cpp
#include <hip/hip_runtime.h>
#include <cstdio>
#include <cstdint>

typedef unsigned short bf16_t;
typedef unsigned v4u __attribute__((ext_vector_type(4)));
typedef unsigned v2u __attribute__((ext_vector_type(2)));

constexpr int D = 2048, BATCH = 2, SEQ = 8192, NMETA = 16, CHUNK = 64;
constexpr int PADF = CHUNK - NMETA;
constexpr int LP = SEQ + NMETA + PADF;
constexpr int NCH = LP / CHUNK;
constexpr int MROWS = BATCH * LP;
constexpr int MP = 16640;
constexpr int NP0 = 4096, NP1 = 6144;
constexpr int S5W = 1024, S5G = 64, S5P = 64, S5C = 16;
constexpr int GLH = 4, GLDK = 128, GLDV = 256, GLR = 16;
constexpr int GDH = 8, GDK = 128, GDV = 128;
constexpr int LRW = 1024, LRB = 8, LRBW = 128;
constexpr int MOE_G = 4, MOE_E = 8, MOE_NE = 32, MOE_FF = 256;
constexpr float DN_ALPHA = 1.41421356237309515f;
constexpr float LN_EPS = 1e-5f, NORM_EPS = 1e-6f;

constexpr int P0_U = 0, P0_Q = 1024, P0_K = 1536, P0_V = 2048, P0_R = 3072;
constexpr int P1_Q = 0, P1_K = 1024, P1_V = 2048, P1_Z = 3072, P1_LX = 4096, P1_LG = 5120;

constexpr size_t MiB = 1u << 20;
constexpr size_t WS_CTL = 0;
constexpr size_t WS_WIN0 = 1 * MiB;
constexpr size_t WS_WIN1 = WS_WIN0 + (size_t)NP0 * D * 2;
constexpr size_t WS_WOUT0 = WS_WIN1 + (size_t)NP1 * D * 2;
constexpr size_t WS_WOUT1 = WS_WOUT0 + (size_t)D * D * 2;
constexpr size_t WS_WGLU = WS_WOUT1 + (size_t)D * D * 2;
constexpr size_t WS_S5C = WS_WGLU + (size_t)S5W * S5W * 2;
constexpr size_t WS_WR = WS_S5C + 1 * MiB;
constexpr size_t WS_S5B = WS_S5C + 2 * MiB;
constexpr size_t WS_WSK3 = WS_S5C + 3 * MiB + 512 * 1024;
constexpr size_t WS_WLRU = WS_S5C + 3 * MiB;
constexpr size_t WS_MW1 = WS_S5C + 4 * MiB;
constexpr size_t WS_MW2 = WS_MW1 + (size_t)MOE_NE * 512 * D * 2;
constexpr size_t WS_H = WS_MW2 + (size_t)MOE_NE * D * MOE_FF * 2;
constexpr size_t WS_HB = WS_H + (size_t)MP * D * 4;
constexpr size_t WS_P = WS_HB + (size_t)MP * D * 2;
constexpr size_t WS_Z = WS_P + (size_t)MP * NP0 * 2;
constexpr size_t WS_Y = WS_P + (size_t)MP * NP1 * 2;
constexpr size_t WS_SK = WS_Y + (size_t)MP * D * 2;
constexpr size_t WS_TOKE = WS_SK + (size_t)MP * 16 * 4;
constexpr size_t WS_TOKW = WS_TOKE + (size_t)MROWS * 2 * 4;
constexpr size_t WS_TOKS = WS_TOKW + (size_t)MROWS * 2 * 4;
constexpr int XS_ROWS = 2 * (BATCH * (SEQ + NMETA)) + 256;
constexpr size_t WS_XW = WS_TOKS + (size_t)MROWS * 2 * 4;
constexpr size_t WS_LRUF = WS_XW + (size_t)XS_ROWS * 4;
constexpr size_t WS_END = WS_LRUF + 3 * MiB;
constexpr size_t WS_S5X = WS_Z + (size_t)MP * S5W * 2;
constexpr size_t WS_GDEC = WS_S5X + 9 * MiB;
static_assert(WS_GDEC + 1 * MiB <= WS_P + (size_t)MP * NP1 * 2, "layer-0 scratch inside the P region");
static_assert((size_t)BATCH * NCH * GLH * 256 * 128 * 2 <= (size_t)MP * D * 2, "GLA states fit in HB");
constexpr size_t WS_LISTE = WS_LRUF;
static_assert((size_t)MOE_NE * MROWS * 4 <= 3 * MiB, "expert lists fit in the LRUF region");
constexpr size_t WS_MIX = WS_P;
constexpr size_t WS_XS = WS_P;
constexpr size_t WS_HH = WS_XS + (size_t)XS_ROWS * D * 2;
static_assert(WS_HH + (size_t)XS_ROWS * MOE_FF * 2 <= WS_Y, "MoE temporaries fit in the P region");
constexpr int CW_CNT = 64;
constexpr int CW_BAR = 4096;
constexpr int S5C_ABAR = 0;
constexpr int S5C_BBAR = S5C_ABAR + 64 * 64 * 2;
constexpr int S5C_END = S5C_BBAR + 64 * 64 * 16 * 2;
constexpr int S5B_BR = 0, S5B_BI = 65536, S5B_CM = 131072;

__device__ __forceinline__ float bf2f(bf16_t b) { return __uint_as_float(((unsigned)b) << 16); }
typedef __bf16 bf16n2 __attribute__((ext_vector_type(2)));
__device__ __forceinline__ unsigned pk2(float lo, float hi) { const bf16n2 v = {(__bf16)lo, (__bf16)hi}; return __builtin_bit_cast(unsigned, v); }
__device__ __forceinline__ unsigned f2bf(float f) { return pk2(f, f) & 0xffffu; }
__device__ __forceinline__ float rcpf_(float x) { return __builtin_amdgcn_rcpf(x); }
__device__ __forceinline__ float sigmoidf_(float x) { return rcpf_(1.0f + __expf(-x)); }
__device__ __forceinline__ float siluf_(float x) { return x * sigmoidf_(x); }
__device__ __forceinline__ float softplusf_(float x) { return fmaxf(x, 0.f) + __logf(1.0f + __expf(-fabsf(x))); }
__device__ __forceinline__ float logsigmoidf_(float x) { return -softplusf_(-x); }
__device__ __forceinline__ float gelu_tanh(float x) { const float u = 0.7978845608028654f * (x + 0.044715f * x * x * x); return x * sigmoidf_(2.0f * u); }
__device__ __forceinline__ float neg_expm1f_(float x) { const float ax = -x; return ax < 0.03f ? ax * (1.0f - ax * (0.5f - ax * (1.0f / 6.0f))) : 1.0f - __expf(x); }
__device__ __forceinline__ float wave_sum(float v) {
#pragma unroll
    for (int o = 1; o < 64; o <<= 1) v += __shfl_xor(v, o);
    return v;
}
__device__ __forceinline__ bool row_valid(int m) { return m < MROWS && (m % LP) >= PADF; }

__device__ __forceinline__ void transpose_item(const float* src  , size_t ldw, bf16_t* dst  , size_t ldt, float* scr, int lane) {
#pragma unroll 8
    for (int i = 0; i < 32; ++i) { const int kk = 2 * i + (lane >> 5); scr[kk * 33 + (lane & 31)] = src[(size_t)kk * ldw + (lane & 31)]; }
    __builtin_amdgcn_s_waitcnt(0); asm volatile("" ::: "memory");
    const int c = lane & 7;
#pragma unroll
    for (int j = 0; j < 4; ++j) { const int n = (lane >> 3) + 8 * j; const float* s = scr + (8 * c) * 33 + n;
        v4u o; o.x = pk2(s[0 * 33], s[1 * 33]); o.y = pk2(s[2 * 33], s[3 * 33]); o.z = pk2(s[4 * 33], s[5 * 33]); o.w = pk2(s[6 * 33], s[7 * 33]);
        *(v4u*)(dst + (size_t)n * ldt + 8 * c) = o; }
    __builtin_amdgcn_s_waitcnt(0); asm volatile("" ::: "memory");
}
struct CvtJob { const float* src; size_t ldw; int K, ncols; bf16_t* dst; size_t ldt; };
__device__ __forceinline__ void cvt_job_items(const CvtJob& j, int item, float* scr, int lane) {
    const int nblk = j.ncols / 32, kb = item / nblk, nb = item % nblk;
    transpose_item(j.src + (size_t)(64 * kb) * j.ldw + 32 * nb, j.ldw, j.dst + (size_t)(32 * nb) * j.ldt + 64 * kb, j.ldt, scr, lane);
}
struct Ptrs {
    const float* in[41];
    float* out;
    unsigned char* ws;
};
template <class PP> __device__ __forceinline__ CvtJob static_job(PP p, int j) {
    CvtJob r;
    switch (j) {
    case 0: r = {p->in[2], 4112, D, 3072, (bf16_t*)(p->ws + WS_WIN0), D}; break;
    case 1: r = {p->in[2] + 3088, 4112, D, 1024, (bf16_t*)(p->ws + WS_WIN0) + (size_t)3072 * D, D}; break;
    case 2: r = {p->in[17], 6160, D, 4096, (bf16_t*)(p->ws + WS_WIN1), D}; break;
    case 3: r = {p->in[17] + 4112, 6160, D, 2048, (bf16_t*)(p->ws + WS_WIN1) + (size_t)4096 * D, D}; break;
    case 4: r = {p->in[16], D, D, D, (bf16_t*)(p->ws + WS_WOUT0), D}; break;
    case 5: r = {p->in[29], D, D, D, (bf16_t*)(p->ws + WS_WOUT1), D}; break;
    case 6: r = {p->in[11], S5W, S5W, S5W, (bf16_t*)(p->ws + WS_WGLU), S5W}; break;
    default: { const int q = j - 7, which = q >> 3, hb = q & 7;
        r = {p->in[which ? 26 : 24] + (size_t)hb * 128 * 128, 128, 128, 128, (bf16_t*)(p->ws + WS_WLRU) + (size_t)which * LRB * 128 * 128 + (size_t)hb * 128 * 128, 128}; } break;
    }
    return r;
}
template <class PP> __device__ __forceinline__ CvtJob moe_job(PP p, int L, int j) {
    const int e = j / 5, t = j % 5; CvtJob r;
    const size_t eoff = ((size_t)L * MOE_NE + e) * (size_t)D * MOE_FF;
    bf16_t* w1 = (bf16_t*)(p->ws + WS_MW1) + (size_t)e * 512 * D; bf16_t* w2 = (bf16_t*)(p->ws + WS_MW2) + (size_t)e * D * MOE_FF;
    if (t < 2) r = {p->in[34] + eoff + 128 * t, MOE_FF, D, 128, w1 + (size_t)(256 * t) * D, D};
    else if (t < 4) r = {p->in[35] + eoff + 128 * (t - 2), MOE_FF, D, 128, w1 + (size_t)(256 * (t - 2) + 128) * D, D};
    else r = {p->in[36] + eoff, D, MOE_FF, D, w2, MOE_FF};
    return r;
}
__global__ __launch_bounds__(256) void k_cvt_static(Ptrs p) {
    __shared__ float scr[4][64 * 33];
    const int lane = threadIdx.x & 63, w = threadIdx.x >> 6, gw = blockIdx.x * 4 + w, ngw = gridDim.x * 4;
    for (int j = 0; j < 7; ++j) { const CvtJob job = static_job(&p, j); const int nit = (job.K / 64) * (job.ncols / 32);
        for (int it = gw; it < nit; it += ngw) cvt_job_items(job, it, scr[w], lane); }
}
__global__ __launch_bounds__(256) void k_cvt_moe(Ptrs p, int L) {
    __shared__ float scr[4][64 * 33];
    const int lane = threadIdx.x & 63, w = threadIdx.x >> 6, gw = blockIdx.x * 4 + w, ngw = gridDim.x * 4;
    for (int j = 0; j < MOE_NE * 5; ++j) { const CvtJob job = moe_job(&p, L, j); const int nit = (job.K / 64) * (job.ncols / 32);
        for (int it = gw; it < nit; it += ngw) cvt_job_items(job, it, scr[w], lane); }
}
__global__ __launch_bounds__(256) void k_build_h0(Ptrs p) {
    float* H = (float*)(p.ws + WS_H); bf16_t* HB = (bf16_t*)(p.ws + WS_HB);
    const size_t n4 = (size_t)MP * D / 4;
    for (size_t i = (size_t)blockIdx.x * 256 + threadIdx.x; i < n4; i += (size_t)gridDim.x * 256) {
        const int m = (int)(i / (D / 4)), c = (int)(i % (D / 4)) * 4;
        float4 v = make_float4(0.f, 0.f, 0.f, 0.f);
        if (m < MROWS) { const int b = m / LP, q = m % LP;
            if (q >= CHUNK) v = *(const float4*)(p.in[0] + ((size_t)b * SEQ + (q - CHUNK)) * D + c);
            else if (q >= PADF) v = *(const float4*)(p.in[1] + (size_t)(q - PADF) * D + c); }
        *(float4*)(H + (size_t)m * D + c) = v;
        uint2 o; o.x = pk2(v.x, v.y); o.y = pk2(v.z, v.w); *(uint2*)(HB + (size_t)m * D + c) = o;
    }
}
__global__ void k_s5_consts(Ptrs p) {
    const int i = blockIdx.x * blockDim.x + threadIdx.x; if (i >= S5G * S5P) return;
    const int g = i / S5P;
    float* C = (float*)(p.ws + WS_S5C);
    const float are = p.in[3][i], aim = p.in[4][i], dt = expf(p.in[5][g]);
    const float mag = expf(are * dt); float sn, cs; sincosf(aim * dt, &sn, &cs);
    const float br = mag * cs, bi = mag * sn;
    C[S5C_ABAR + 2 * i] = br; C[S5C_ABAR + 2 * i + 1] = bi;
    const float nr = br - 1.0f, ni = bi, den = are * are + aim * aim;
    const float zr = (nr * are + ni * aim) / den, zi = (ni * are - nr * aim) / den;
    for (int c = 0; c < S5C; ++c) { const float b_r = p.in[6][(size_t)i * S5C + c], b_i = p.in[7][(size_t)i * S5C + c];
        C[S5C_BBAR + ((size_t)i * S5C + c) * 2] = b_r * zr - b_i * zi; C[S5C_BBAR + ((size_t)i * S5C + c) * 2 + 1] = b_r * zi + b_i * zr; }
}

template <class Epi> __global__ __launch_bounds__(256) void k_gemm_naive(const bf16_t* A, int lda, const bf16_t* Bt, int ldb, int K, Epi epi) {
    __shared__ float As[16][65], Bs[16][65];
    const int tx = threadIdx.x & 15, ty = threadIdx.x >> 4, m0 = blockIdx.y * 64, n0 = blockIdx.x * 64;
    float acc[4][4];
#pragma unroll
    for (int i = 0; i < 4; ++i)
#pragma unroll
        for (int j = 0; j < 4; ++j) acc[i][j] = 0.f;
    for (int k0 = 0; k0 < K; k0 += 16) {
        for (int i = threadIdx.x; i < 1024; i += 256) { const int r = i >> 4, c = i & 15;
            As[c][r] = bf2f(A[(size_t)(m0 + r) * lda + k0 + c]); Bs[c][r] = bf2f(Bt[(size_t)(n0 + r) * ldb + k0 + c]); }
        __syncthreads();
#pragma unroll
        for (int kk = 0; kk < 16; ++kk) { float a[4], b[4];
#pragma unroll
            for (int i = 0; i < 4; ++i) { a[i] = As[kk][ty * 4 + i]; b[i] = Bs[kk][tx * 4 + i]; }
#pragma unroll
            for (int i = 0; i < 4; ++i)
#pragma unroll
                for (int j = 0; j < 4; ++j) acc[i][j] += a[i] * b[j]; }
        __syncthreads();
    }
#pragma unroll
    for (int i = 0; i < 4; ++i)
#pragma unroll
        for (int j = 0; j < 4; ++j) epi(m0 + ty * 4 + i, n0 + tx * 4 + j, acc[i][j]);
}
struct NEpiBf16 { bf16_t* O; int ldo; __device__ void operator()(int r, int c, float v) const { O[(size_t)r * ldo + c] = (bf16_t)f2bf(v); } };
struct NEpiGlu { const bf16_t* Z; const float* bglu; bf16_t* Y; __device__ void operator()(int r, int c, float v) const {
    const float z = bf2f(Z[(size_t)r * S5W + c]); Y[(size_t)r * D + c] = (bf16_t)f2bf(z * sigmoidf_(v + bglu[c])); } };
struct NEpiResid { float* H; __device__ void operator()(int r, int c, float v) const { float* h = H + (size_t)r * D + c; *h = DN_ALPHA * *h + v; } };

__global__ __launch_bounds__(256) void k_skinny(const float* H, const float* W, int ldw, int col0, float* SK) {
    const int lane = threadIdx.x & 63, gw = blockIdx.x * 4 + (threadIdx.x >> 6), ngw = gridDim.x * 4;
    for (int m = gw; m < MP; m += ngw) {
        float acc[16];
#pragma unroll
        for (int j = 0; j < 16; ++j) acc[j] = 0.f;
        if (row_valid(m)) {
            for (int k = lane; k < D; k += 64) { const float h = H[(size_t)m * D + k]; const float4* w = (const float4*)(W + (size_t)k * ldw + col0);
#pragma unroll
                for (int q = 0; q < 4; ++q) { const float4 x = w[q]; acc[4 * q] += h * x.x; acc[4 * q + 1] += h * x.y; acc[4 * q + 2] += h * x.z; acc[4 * q + 3] += h * x.w; } }
#pragma unroll
            for (int j = 0; j < 16; ++j) acc[j] = wave_sum(acc[j]);
        }
        if (lane < 16) { float v = 0.f;
#pragma unroll
            for (int j = 0; j < 16; ++j) v = (lane == j) ? acc[j] : v;
            SK[(size_t)m * 16 + lane] = v; }
    }
}

__global__ __launch_bounds__(256) void k_layernorm(float* H, bf16_t* HB, const float* g, const float* b, float* out) {
    const int lane = threadIdx.x & 63, gw = blockIdx.x * 4 + (threadIdx.x >> 6), ngw = gridDim.x * 4;
    for (int m = gw; m < MP; m += ngw) {
        float4* hr = (float4*)(H + (size_t)m * D); uint2* hb = (uint2*)(HB + (size_t)m * D);
        if (!row_valid(m)) { for (int j = 0; j < 8; ++j) { hr[lane + 64 * j] = make_float4(0.f, 0.f, 0.f, 0.f); hb[lane + 64 * j] = make_uint2(0u, 0u); } continue; }
        float4 v[8]; float s = 0.f;
#pragma unroll
        for (int j = 0; j < 8; ++j) { v[j] = hr[lane + 64 * j]; s += (v[j].x + v[j].y) + (v[j].z + v[j].w); }
        const float mean = wave_sum(s) * (1.0f / D); float q = 0.f;
#pragma unroll
        for (int j = 0; j < 8; ++j) { v[j].x -= mean; v[j].y -= mean; v[j].z -= mean; v[j].w -= mean; q += (v[j].x * v[j].x + v[j].y * v[j].y) + (v[j].z * v[j].z + v[j].w * v[j].w); }
        const float rstd = rsqrtf(wave_sum(q) * (1.0f / D) + LN_EPS);
        const int q_ = m % LP, bb = m / LP;
#pragma unroll
        for (int j = 0; j < 8; ++j) { const int c = (lane + 64 * j) * 4; const float4 gg = *(const float4*)(g + c), bv = *(const float4*)(b + c);
            float4 o; o.x = v[j].x * rstd * gg.x + bv.x; o.y = v[j].y * rstd * gg.y + bv.y; o.z = v[j].z * rstd * gg.z + bv.z; o.w = v[j].w * rstd * gg.w + bv.w;
            hr[lane + 64 * j] = o; hb[lane + 64 * j] = make_uint2(pk2(o.x, o.y), pk2(o.z, o.w));
            if (out && q_ >= CHUNK) *(float4*)(out + ((size_t)bb * SEQ + (q_ - CHUNK)) * D + c) = o; }
    }
}

__global__ __launch_bounds__(64) void k_s5_naive(Ptrs p) {
    __shared__ float red[64][17];
    const int lane = threadIdx.x, b = blockIdx.x / S5G, g = blockIdx.x % S5G;
    const float* C = (const float*)(p.ws + WS_S5C);
    const bf16_t* P = (const bf16_t*)(p.ws + WS_P); bf16_t* Z = (bf16_t*)(p.ws + WS_Z);
    const float ar = C[S5C_ABAR + 2 * (g * 64 + lane)], ai = C[S5C_ABAR + 2 * (g * 64 + lane) + 1];
    float bbr[16], bbi[16], cr[16], ci[16];
#pragma unroll
    for (int c = 0; c < 16; ++c) { bbr[c] = C[S5C_BBAR + ((size_t)(g * 64 + lane) * 16 + c) * 2]; bbi[c] = C[S5C_BBAR + ((size_t)(g * 64 + lane) * 16 + c) * 2 + 1];
        cr[c] = p.in[8][((size_t)g * 16 + c) * 64 + lane]; ci[c] = p.in[9][((size_t)g * 16 + c) * 64 + lane]; }
    const float dd = (lane < 16) ? p.in[10][g * 16 + lane] : 0.f;
    float sr = 0.f, si = 0.f;
    for (int q = 0; q < LP; ++q) {
        const size_t m = (size_t)b * LP + q;
        if (q < PADF) { if (lane < 16) Z[m * S5W + g * 16 + lane] = 0; continue; }
        const bf16_t* ur = P + m * NP0 + P0_U + g * 16;
        float u[16], br = 0.f, bi = 0.f;
#pragma unroll
        for (int c = 0; c < 16; ++c) { u[c] = bf2f(ur[c]); br += u[c] * bbr[c]; bi += u[c] * bbi[c]; }
        const float nr = ar * sr - ai * si + br, ni = ar * si + ai * sr + bi; sr = nr; si = ni;
#pragma unroll
        for (int c = 0; c < 16; ++c) red[lane][c] = cr[c] * sr - ci[c] * si;
        __syncthreads();
        if (lane < 16) { float y = 0.f; for (int j = 0; j < 64; ++j) y += red[j][lane];
            float uu = 0.f;
#pragma unroll
            for (int c = 0; c < 16; ++c) uu = (lane == c) ? u[c] : uu;
            y += dd * uu; Z[m * S5W + g * 16 + lane] = (bf16_t)f2bf(gelu_tanh(y)); }
        __syncthreads();
    }
}

__global__ __launch_bounds__(256) void k_gla_naive(Ptrs p) {
    __shared__ float s_q[128], s_k[128], s_eg[128], s_red[4];
    const int e = threadIdx.x, b = blockIdx.x / GLH, h = blockIdx.x % GLH, lane = e & 63, w = e >> 6;
    const bf16_t* P = (const bf16_t*)(p.ws + WS_P); const float* SK = (const float*)(p.ws + WS_SK); bf16_t* Y = (bf16_t*)(p.ws + WS_Y);
    const float* wg = p.in[13]; const float* bg = p.in[14]; const float ng = p.in[15][e];
    float S[128];
#pragma unroll
    for (int d = 0; d < 128; ++d) S[d] = 0.f;
    float wgc[16]; float bgc = 0.f;
#pragma unroll
    for (int j = 0; j < 16; ++j) wgc[j] = (e < 128) ? wg[j * 512 + h * 128 + e] : 0.f;
    if (e < 128) bgc = bg[h * 128 + e];
    for (int q = 0; q < LP; ++q) {
        const size_t m = (size_t)b * LP + q; bf16_t* yo = Y + m * D + 1024 + h * 256 + e;
        if (q < PADF) { *yo = 0; continue; }
        if (e < 128) { float lg = bgc;
#pragma unroll
            for (int j = 0; j < 16; ++j) lg += SK[m * 16 + j] * wgc[j];
            s_eg[e] = __expf(logsigmoidf_(lg) * (1.0f / 16.0f));
            s_q[e] = bf2f(P[m * NP0 + P0_Q + h * 128 + e]) * 0.08838834764831845f;
            s_k[e] = bf2f(P[m * NP0 + P0_K + h * 128 + e]); }
        __syncthreads();
        const float v = bf2f(P[m * NP0 + P0_V + h * 256 + e]);
        float o = 0.f;
#pragma unroll
        for (int d = 0; d < 128; ++d) { S[d] = S[d] * s_eg[d] + s_k[d] * v; o += s_q[d] * S[d]; }
        const float ss = wave_sum(o * o); if (lane == 0) s_red[w] = ss;
        __syncthreads();
        const float ms = (s_red[0] + s_red[1] + s_red[2] + s_red[3]) * (1.0f / 256.0f);
        const float r = bf2f(P[m * NP0 + P0_R + h * 256 + e]);
        *yo = (bf16_t)f2bf(o * rsqrtf(ms + NORM_EPS) * ng * siluf_(r));
        __syncthreads();
    }
}

__global__ __launch_bounds__(128) void k_gdn_naive(Ptrs p) {
    __shared__ float s_q[128], s_k[128], s_red[2], s_red2[2], s_red3[2];
    const int e = threadIdx.x, b = blockIdx.x / GDH, h = blockIdx.x % GDH, lane = e & 63, w = e >> 6;
    const bf16_t* P = (const bf16_t*)(p.ws + WS_P); const float* SK = (const float*)(p.ws + WS_SK); bf16_t* Y = (bf16_t*)(p.ws + WS_Y);
    const float* cw = p.in[18];
    const float alog = p.in[19][h], dtb = p.in[20][h], ng = p.in[21][e];
    const int cq = P1_Q + h * 128 + e, ck = P1_K + h * 128 + e, cv = P1_V + h * 128 + e;
    float wq[4], wk[4], wv[4];
#pragma unroll
    for (int j = 0; j < 4; ++j) { wq[j] = cw[j * 3072 + cq]; wk[j] = cw[j * 3072 + ck]; wv[j] = cw[j * 3072 + cv]; }
    float S[128];
#pragma unroll
    for (int d = 0; d < 128; ++d) S[d] = 0.f;
    for (int q = 0; q < LP; ++q) {
        const size_t m = (size_t)b * LP + q; bf16_t* yo = Y + m * D + h * 128 + e;
        if (q < PADF) { *yo = 0; continue; }
        float xq = 0.f, xk = 0.f, xv = 0.f;
#pragma unroll
        for (int j = 0; j < 4; ++j) { const bf16_t* pr = P + (m - 3 + j) * NP1; xq += wq[j] * bf2f(pr[cq]); xk += wk[j] * bf2f(pr[ck]); xv += wv[j] * bf2f(pr[cv]); }
        xq = siluf_(xq); xk = siluf_(xk); xv = siluf_(xv);
        const float sq = wave_sum(xq * xq), sk = wave_sum(xk * xk);
        if (lane == 0) { s_red[w] = sq; s_red2[w] = sk; }
        __syncthreads();
        const float nq = rsqrtf(s_red[0] + s_red[1] + NORM_EPS) * 0.08838834764831845f, nk = rsqrtf(s_red2[0] + s_red2[1] + NORM_EPS);
        s_q[e] = xq * nq; s_k[e] = xk * nk;
        __syncthreads();
        const float beta = sigmoidf_(SK[m * 16 + h]);
        const float eg = __expf(-__expf(alog) * softplusf_(SK[m * 16 + 8 + h] + dtb));
        float kS = 0.f;
#pragma unroll
        for (int d = 0; d < 128; ++d) { S[d] *= eg; kS += s_k[d] * S[d]; }
        const float dl = beta * (xv - kS);
        float o = 0.f;
#pragma unroll
        for (int d = 0; d < 128; ++d) { S[d] += s_k[d] * dl; o += s_q[d] * S[d]; }
        const float ss = wave_sum(o * o); if (lane == 0) s_red3[w] = ss;
        __syncthreads();
        const float ms = (s_red3[0] + s_red3[1]) * (1.0f / 128.0f);
        const float z = bf2f(P[m * NP1 + P1_Z + h * 128 + e]);
        *yo = (bf16_t)f2bf(o * rsqrtf(ms + NORM_EPS) * ng * siluf_(z));
        __syncthreads();
    }
}

__global__ __launch_bounds__(128) void k_lru_naive(Ptrs p) {
    __shared__ float s_x[128];
    const int j = threadIdx.x, b = blockIdx.x / LRB, hb = blockIdx.x % LRB, ch = hb * 128 + j;
    const bf16_t* P = (const bf16_t*)(p.ws + WS_P); bf16_t* Y = (bf16_t*)(p.ws + WS_Y);
    const float* cw = p.in[22]; const float cb = p.in[23][ch];
    const float* wa = p.in[24] + (size_t)hb * 128 * 128; const float* wx = p.in[26] + (size_t)hb * 128 * 128;
    const float ba = p.in[25][ch], bx = p.in[27][ch];
    const float nsp = -8.0f * softplusf_(-p.in[28][ch]);
    float w4[4];
#pragma unroll
    for (int t = 0; t < 4; ++t) w4[t] = cw[t * LRW + ch];
    float hs = 0.f;
    for (int q = 0; q < LP; ++q) {
        const size_t m = (size_t)b * LP + q; bf16_t* yo = Y + m * D + 1024 + ch;
        if (q < PADF) { *yo = 0; continue; }
        float xc = cb;
#pragma unroll
        for (int t = 0; t < 4; ++t) xc += w4[t] * bf2f(P[(m - 3 + t) * NP1 + P1_LX + ch]);
        s_x[j] = xc;
        __syncthreads();
        float ra = ba, ri = bx;
        for (int i = 0; i < 128; ++i) { const float xi = s_x[i]; ra += xi * wa[i * 128 + j]; ri += xi * wx[i * 128 + j]; }
        const float r = sigmoidf_(ra), ig = sigmoidf_(ri);
        const float la = nsp * r, a = __expf(la), bxv = sqrtf(-expm1f(2.0f * la)) * (ig * xc);
        hs = a * hs + bxv;
        const float gt = bf2f(P[m * NP1 + P1_LG + ch]);
        *yo = (bf16_t)f2bf(hs * gelu_tanh(gt));
        __syncthreads();
    }
}

__global__ __launch_bounds__(256) void k_router(const float* H, const float* wrg, const float* brg, const float* wre, const float* bre, int* toke, float* tokw) {
    const int lane = threadIdx.x & 63, gw = blockIdx.x * 4 + (threadIdx.x >> 6), ngw = gridDim.x * 4;
    for (int m = gw; m < MROWS; m += ngw) {
        if (!row_valid(m)) { if (lane < 2) { toke[m * 2 + lane] = 0; tokw[m * 2 + lane] = 0.f; } continue; }
        float acc[36];
#pragma unroll
        for (int j = 0; j < 36; ++j) acc[j] = 0.f;
        for (int k = lane; k < D; k += 64) { const float h = H[(size_t)m * D + k];
            const float4 g4 = *(const float4*)(wrg + (size_t)k * 4); acc[0] += h * g4.x; acc[1] += h * g4.y; acc[2] += h * g4.z; acc[3] += h * g4.w;
            const float4* w = (const float4*)(wre + (size_t)k * 32);
#pragma unroll
            for (int q = 0; q < 8; ++q) { const float4 x = w[q]; acc[4 + 4 * q] += h * x.x; acc[5 + 4 * q] += h * x.y; acc[6 + 4 * q] += h * x.z; acc[7 + 4 * q] += h * x.w; } }
#pragma unroll
        for (int j = 0; j < 36; ++j) acc[j] = wave_sum(acc[j]);
        if (lane == 0) {
            float lg[4];
#pragma unroll
            for (int j = 0; j < 4; ++j) lg[j] = acc[j] + brg[j];
            float best = lg[0]; int gt = 0;
#pragma unroll
            for (int j = 1; j < 4; ++j) if (lg[j] > best) { best = lg[j]; gt = j; }
            float den = 0.f;
#pragma unroll
            for (int j = 0; j < 4; ++j) den += __expf(lg[j] - best);
            const float ptop = 1.0f / den;
            float le[8];
#pragma unroll
            for (int j = 0; j < 8; ++j) { float v = 0.f, bb = 0.f;
#pragma unroll
                for (int gg = 0; gg < 4; ++gg) { v = (gt == gg) ? acc[4 + gg * 8 + j] : v; bb = (gt == gg) ? bre[gg * 8 + j] : bb; }
                le[j] = v + bb; }
            float v0 = le[0]; int e0 = 0;
#pragma unroll
            for (int j = 1; j < 8; ++j) if (le[j] > v0) { v0 = le[j]; e0 = j; }
            float v1 = -3.0e38f; int e1 = 0;
#pragma unroll
            for (int j = 0; j < 8; ++j) if (j != e0 && le[j] > v1) { v1 = le[j]; e1 = j; }
            const float x = __expf(v1 - v0), w0 = 1.0f / (1.0f + x), w1 = x / (1.0f + x);
            toke[m * 2] = gt * 8 + e0; toke[m * 2 + 1] = gt * 8 + e1; tokw[m * 2] = ptop * w0; tokw[m * 2 + 1] = ptop * w1;
        }
    }
}
__global__ __launch_bounds__(256) void k_moe_naive(Ptrs p) {
    __shared__ float s_x[D], s_h[MOE_FF];
    const int t = threadIdx.x;
    float* H = (float*)(p.ws + WS_H); const bf16_t* HB = (const bf16_t*)(p.ws + WS_HB);
    const int* toke = (const int*)(p.ws + WS_TOKE); const float* tokw = (const float*)(p.ws + WS_TOKW);
    const bf16_t* W1 = (const bf16_t*)(p.ws + WS_MW1); const bf16_t* W2 = (const bf16_t*)(p.ws + WS_MW2);
    for (int m = blockIdx.x; m < MROWS; m += gridDim.x) {
        if (!row_valid(m)) continue;
        for (int i = t; i < D; i += 256) s_x[i] = bf2f(HB[(size_t)m * D + i]);
        float out[8];
#pragma unroll
        for (int j = 0; j < 8; ++j) out[j] = 0.f;
        for (int kk = 0; kk < 2; ++kk) {
            __syncthreads();
            const int e = toke[m * 2 + kk]; const float w = tokw[m * 2 + kk];
            const bf16_t* wgr = W1 + ((size_t)e * 512 + 256 * (t >> 7) + (t & 127)) * D; const bf16_t* wur = wgr + (size_t)128 * D;
            float hg = 0.f, hu = 0.f;
            for (int d = 0; d < D; d += 8) { const v4u a = *(const v4u*)(wgr + d), c = *(const v4u*)(wur + d);
                const unsigned aw[4] = {a.x, a.y, a.z, a.w}, cw[4] = {c.x, c.y, c.z, c.w};
#pragma unroll
                for (int q = 0; q < 4; ++q) { const float x0 = s_x[d + 2 * q], x1 = s_x[d + 2 * q + 1];
                    hg += x0 * __uint_as_float(aw[q] << 16) + x1 * __uint_as_float(aw[q] & 0xffff0000u);
                    hu += x0 * __uint_as_float(cw[q] << 16) + x1 * __uint_as_float(cw[q] & 0xffff0000u); } }
            s_h[t] = siluf_(hg) * hu * w;
            __syncthreads();
#pragma unroll
            for (int j = 0; j < 8; ++j) { const bf16_t* wd = W2 + ((size_t)e * D + t + 256 * j) * MOE_FF; float a = 0.f;
                for (int f = 0; f < MOE_FF; f += 8) { const v4u x = *(const v4u*)(wd + f); const unsigned xw[4] = {x.x, x.y, x.z, x.w};
#pragma unroll
                    for (int q = 0; q < 4; ++q) a += s_h[f + 2 * q] * __uint_as_float(xw[q] << 16) + s_h[f + 2 * q + 1] * __uint_as_float(xw[q] & 0xffff0000u); }
                out[j] += a; }
        }
#pragma unroll
        for (int j = 0; j < 8; ++j) { float* hp = H + (size_t)m * D + t + 256 * j; *hp = DN_ALPHA * *hp + out[j]; }
        __syncthreads();
    }
}

namespace pg8 {
#define PG8_LAS __attribute__((address_space(3)))
typedef unsigned short bf16_t;
typedef short bf16x8 __attribute__((ext_vector_type(8)));
typedef float f32x4 __attribute__((ext_vector_type(4)));
typedef unsigned u32x4 __attribute__((ext_vector_type(4)));
constexpr int BM = 256, BK = 64, HALF = 128, HTB = HALF * BK * 2  , STAGE_BYTES = 8 * HTB, NXCD = 8, WGM = 8;

__host__ __device__ __forceinline__ int lds_byte(int r, int c) { const int st = (r >> 4) * 2 + (c >> 5), rr = r & 15, cc = c & 31, ob = rr * 64 + cc * 2; return st * 1024 + (ob ^ (((ob >> 9) & 1) << 5)); }
__host__ __device__ __forceinline__ void stage_rc(int b, int& R, int& C) { const int st = b / 1024, sb = b % 1024, swz = sb ^ (((sb >> 9) & 1) << 5); R = (st >> 1) * 16 + swz / 64; C = (st & 1) * 32 + (swz % 64) / 2; }
__host__ __device__ __forceinline__ int perm32(int rho) { const int n = rho >> 4, i = rho & 15; return 8 * (i >> 2) + 4 * n + (i & 3); }

struct Unit { int pm, pn, r0, nr, lb; };
struct Gemm { const bf16_t* A; const bf16_t* Bt; int M, N, K; };

struct StaticOrder {
    int nM, nN, nwg, G, c;
    __host__ __device__ void init(int M, int N, int G_, int c_) { nM = M / BM; nN = N / BM; nwg = nM * nN; G = G_; c = c_; }
    __host__ __device__ bool next(int i, Unit& u) const {
        const long L = (long)i * G + c; if (L >= nwg) return false;
        int wgid = (int)L; { const int q = nwg / NXCD, r = nwg % NXCD, xcd = wgid % NXCD, off = wgid / NXCD; wgid = (xcd < r ? xcd * (q + 1) : r * (q + 1) + (xcd - r) * q) + off; }
        const int nig = WGM * nN, gid = wgid / nig, fm = gid * WGM, gsz = (nM - fm) < WGM ? (nM - fm) : WGM;
        u.pm = fm + ((wgid % nig) % gsz); u.pn = (wgid % nig) / gsz; u.r0 = u.pm * BM; u.nr = BM; u.lb = 0; return true;
    }
    __device__ __forceinline__ void a_ready(const Unit&) const {}
    __device__ __forceinline__ void done(const Unit&) const {}
    static constexpr bool GATHER = false;
    __device__ __forceinline__ unsigned gather_voff(const Unit&, int, int, int) const { return 0u; }
};
__device__ __forceinline__ unsigned cvt_pk_bf16(float lo, float hi) { unsigned r; asm volatile("v_cvt_pk_bf16_f32 %0, %1, %2" : "=v"(r) : "v"(lo), "v"(hi)); return r; }
template <class Epi, class Sched, bool ALIGN_EPI = false, bool SP2 = false>
__device__ __forceinline__ void gemm_phase(PG8_LAS unsigned char* lds, const Gemm g, const Sched& S, const Epi& E) {
    int tid_ = threadIdx.x; asm volatile("" : "+v"(tid_));
    const int tid = tid_, wid = __builtin_amdgcn_readfirstlane(tid >> 6), lane = tid & 63, wr = wid >> 2, wc = wid & 3, fr = lane & 15, fq = lane >> 4;
    const int K = g.K, nt = K / BK;
    unsigned voffA[2], voffB[2]; int Rl[2], Cl[2];
#pragma unroll
    for (int i = 0; i < 2; ++i) { int R, C; stage_rc(tid * 16 + i * 8192, R, C); const int Rb = Epi::PERM ? ((R & ~31) + perm32(R & 31)) : R;
        Rl[i] = R; Cl[i] = C * 2; voffA[i] = (unsigned)(R * K + C) * 2u; voffB[i] = (unsigned)(Rb * K + C) * 2u; }
    const size_t kstep = (size_t)(BK * 2);
    const size_t hstep = (size_t)HALF * K * 2;
    const size_t tstep = 2 * hstep;
    const unsigned ldsw = (unsigned)wid * 1024u;
    const int aoff = lds_byte(wr * 64 + fr, fq * 8), boff = lds_byte(wc * 32 + fr, fq * 8);
#define PG8_SA(b, h) (((b) * 2 + (h)) * HTB)
#define PG8_SB(b, h) ((4 + (b) * 2 + (h)) * HTB)
#define PG8_STAGE(bufoff, gbase, voff) do { _Pragma("unroll") for (int _i = 0; _i < 2; ++_i) \
        __builtin_amdgcn_global_load_lds((const unsigned*)((const char*)(gbase) + (voff)[_i]), (PG8_LAS unsigned*)(lds + (bufoff) + ldsw + _i * 8192), 16, 0, 0); } while (0)
#define PG8_LDA(dst, b, h) do { _Pragma("unroll") for (int m = 0; m < 4; ++m) _Pragma("unroll") for (int k = 0; k < 2; ++k) dst[m][k] = *(const PG8_LAS bf16x8*)(lds + PG8_SA(b, h) + aoff + m * 2048 + k * 1024); } while (0)
#define PG8_LDB(dst, b, h) do { _Pragma("unroll") for (int n = 0; n < 2; ++n) _Pragma("unroll") for (int k = 0; k < 2; ++k) dst[n][k] = *(const PG8_LAS bf16x8*)(lds + PG8_SB(b, h) + boff + n * 2048 + k * 1024); } while (0)
#define PG8_MMA(ai, bj, At, Bt) do { __builtin_amdgcn_s_setprio(1); _Pragma("unroll") for (int m = 0; m < 4; ++m) _Pragma("unroll") for (int n = 0; n < 2; ++n) _Pragma("unroll") for (int k = 0; k < 2; ++k) \
        acc[ai][bj][m][n] = __builtin_amdgcn_mfma_f32_16x16x32_bf16(Bt[n][k], At[m][k], acc[ai][bj][m][n], 0, 0, 0); __builtin_amdgcn_s_setprio(0); } while (0)
#define PG8_WAIT_V(n) asm volatile("s_waitcnt vmcnt(" #n ")" ::: "memory")
#define PG8_WAIT_L(n) asm volatile("s_waitcnt lgkmcnt(" #n ")" ::: "memory")
#define PG8_BAR __builtin_amdgcn_s_barrier()
#define PG8_SCHED __builtin_amdgcn_sched_barrier(0)
    Unit cur, nxt; int ui = 0;
    if (!S.next(0, cur)) return;
    f32x4 acc[2][2][4][2];
#pragma unroll
    for (int a = 0; a < 2; ++a)
#pragma unroll
        for (int b = 0; b < 2; ++b)
#pragma unroll
            for (int m = 0; m < 4; ++m)
#pragma unroll
                for (int n = 0; n < 2; ++n) acc[a][b][m][n] = (f32x4){0.f, 0.f, 0.f, 0.f};
    bf16x8 At[4][2], B0[2][2], B1[2][2];
    constexpr bool GA = Sched::GATHER;
    const char* cA = GA ? (const char*)g.A : (const char*)g.A + (size_t)cur.r0 * (size_t)(K * 2); const char* cB = (const char*)g.Bt + (size_t)cur.pn * tstep;
    unsigned vAc[2][2], vAn[2][2];
#pragma unroll
    for (int h = 0; h < 2; ++h)
#pragma unroll
        for (int i = 0; i < 2; ++i) { vAc[h][i] = GA ? S.gather_voff(cur, h * HALF + Rl[i], Cl[i], K) : voffA[i] + (unsigned)(h * HALF * K * 2); vAn[h][i] = vAc[h][i]; }
#define PG8_VA(h) ((GA && last) ? vAn[h] : vAc[h])
    S.a_ready(cur);
    if constexpr (SP2) {
        PG8_STAGE(PG8_SB(0, 0), cB, voffB); PG8_STAGE(PG8_SB(0, 1), cB + hstep, voffB); PG8_STAGE(PG8_SA(0, 0), cA, vAc[0]); PG8_STAGE(PG8_SA(0, 1), cA, vAc[1]);
        if (wr == 1) PG8_BAR;
        PG8_WAIT_V(2); PG8_BAR;
        PG8_STAGE(PG8_SB(1, 0), cB + kstep, voffB); PG8_STAGE(PG8_SA(1, 0), cA + kstep, vAc[0]); PG8_STAGE(PG8_SB(1, 1), cB + hstep + kstep, voffB);
        PG8_WAIT_V(6); PG8_BAR;
    } else {
        PG8_STAGE(PG8_SB(0, 0), cB, voffB); PG8_STAGE(PG8_SA(0, 0), cA, voffA); PG8_STAGE(PG8_SB(0, 1), cB + hstep, voffB); PG8_STAGE(PG8_SA(0, 1), cA + hstep, voffA);
        if (wr == 1) PG8_BAR;
        PG8_WAIT_V(4); PG8_BAR;
        PG8_STAGE(PG8_SB(1, 0), cB + kstep, voffB); PG8_STAGE(PG8_SA(1, 0), cA + kstep, voffA); PG8_STAGE(PG8_SB(1, 1), cB + hstep + kstep, voffB);
        PG8_WAIT_V(6); PG8_BAR;
    }
    for (;;) {
        const bool has_next = S.next(ui + 1, nxt);
        const char* nA = GA ? cA : (has_next ? (const char*)g.A + (size_t)nxt.r0 * (size_t)(K * 2) : cA); const char* nB = has_next ? (const char*)g.Bt + (size_t)nxt.pn * tstep : cB;
        for (int t = 0; t < nt; t += 2) {
            const bool last = (t == nt - 2);
            const char* a1 = cA + (size_t)(t + 1) * kstep;
            const char* a2 = last ? nA : cA + (size_t)(t + 2) * kstep; const char* b2 = last ? nB : cB + (size_t)(t + 2) * kstep;
            const char* a3 = a2 + kstep; const char* b3 = b2 + kstep;
            if (last && has_next) { S.a_ready(nxt);
                if constexpr (GA) {
#pragma unroll
                    for (int h = 0; h < 2; ++h)
#pragma unroll
                        for (int i = 0; i < 2; ++i) vAn[h][i] = S.gather_voff(nxt, h * HALF + Rl[i], Cl[i], K); } }
            else if (GA && last) {
#pragma unroll
                for (int h = 0; h < 2; ++h)
#pragma unroll
                    for (int i = 0; i < 2; ++i) vAn[h][i] = vAc[h][i]; }
            if constexpr (SP2) {
            PG8_LDB(B0, 0, 0); PG8_LDB(B1, 0, 1); PG8_SCHED; PG8_LDA(At, 0, 0); PG8_STAGE(PG8_SA(1, 1), a1, vAc[1]);
            PG8_WAIT_V(8); PG8_WAIT_L(0); PG8_BAR; PG8_MMA(0, 0, At, B0); PG8_MMA(0, 1, At, B1); PG8_BAR; PG8_SCHED;
            PG8_LDA(At, 0, 1); PG8_STAGE(PG8_SB(0, 0), b2, voffB); PG8_STAGE(PG8_SB(0, 1), b2 + hstep, voffB); PG8_STAGE(PG8_SA(0, 0), a2, PG8_VA(0));
            PG8_WAIT_V(8); PG8_WAIT_L(0); PG8_BAR; PG8_MMA(1, 0, At, B0); PG8_MMA(1, 1, At, B1); PG8_BAR; PG8_SCHED;
            PG8_LDB(B0, 1, 0); PG8_LDB(B1, 1, 1); PG8_SCHED; PG8_LDA(At, 1, 0); PG8_STAGE(PG8_SA(0, 1), a2, PG8_VA(1));
            PG8_WAIT_V(8); PG8_WAIT_L(0); PG8_BAR; PG8_MMA(0, 0, At, B0); PG8_MMA(0, 1, At, B1); PG8_BAR; PG8_SCHED;
            PG8_LDA(At, 1, 1); PG8_STAGE(PG8_SB(1, 0), b3, voffB); PG8_STAGE(PG8_SB(1, 1), b3 + hstep, voffB); PG8_STAGE(PG8_SA(1, 0), a3, PG8_VA(0));
            PG8_WAIT_V(8); PG8_WAIT_L(0); PG8_BAR; PG8_MMA(1, 0, At, B0); PG8_MMA(1, 1, At, B1); PG8_BAR; PG8_SCHED;
            } else {
            PG8_LDB(B0, 0, 0); PG8_SCHED; PG8_LDA(At, 0, 0); PG8_STAGE(PG8_SA(1, 1), a1 + hstep, voffA);
            PG8_WAIT_L(8); PG8_BAR; PG8_WAIT_L(0); PG8_MMA(0, 0, At, B0); PG8_BAR; PG8_SCHED;
            PG8_LDB(B1, 0, 1); PG8_STAGE(PG8_SB(0, 0), b2, voffB);
            PG8_BAR; PG8_WAIT_L(0); PG8_MMA(0, 1, At, B1); PG8_BAR;
            PG8_LDA(At, 0, 1); PG8_STAGE(PG8_SA(0, 0), a2, voffA);
            PG8_BAR; PG8_WAIT_L(0); PG8_MMA(1, 0, At, B0); PG8_BAR; PG8_SCHED;
            PG8_STAGE(PG8_SB(0, 1), b2 + hstep, voffB);
            PG8_WAIT_V(6); PG8_BAR; PG8_MMA(1, 1, At, B1); PG8_BAR;
            PG8_LDB(B0, 1, 0); PG8_SCHED; PG8_LDA(At, 1, 0); PG8_STAGE(PG8_SA(0, 1), a2 + hstep, voffA);
            PG8_WAIT_L(8); PG8_BAR; PG8_WAIT_L(0); PG8_MMA(0, 0, At, B0); PG8_BAR; PG8_SCHED;
            PG8_LDB(B1, 1, 1); PG8_STAGE(PG8_SB(1, 0), b3, voffB);
            PG8_BAR; PG8_WAIT_L(0); PG8_MMA(0, 1, At, B1); PG8_BAR;
            PG8_LDA(At, 1, 1); PG8_STAGE(PG8_SA(1, 0), a3, voffA);
            PG8_BAR; PG8_WAIT_L(0); PG8_MMA(1, 0, At, B0); PG8_BAR; PG8_SCHED;
            PG8_STAGE(PG8_SB(1, 1), b3 + hstep, voffB);
            PG8_WAIT_V(6); PG8_BAR; PG8_MMA(1, 1, At, B1); PG8_BAR;
            }
        }
        if constexpr (ALIGN_EPI) { if (wr == 0) PG8_BAR; }
        if constexpr (!Epi::AFTER_DRAIN) { E(acc, cur, wr, wc, fr, fq); S.done(cur); }
        if (!has_next) break;
#pragma unroll
        for (int a = 0; a < 2; ++a)
#pragma unroll
            for (int b = 0; b < 2; ++b)
#pragma unroll
                for (int m = 0; m < 4; ++m)
#pragma unroll
                    for (int n = 0; n < 2; ++n) acc[a][b][m][n] = (f32x4){0.f, 0.f, 0.f, 0.f};
        cur = nxt; cA = nA; cB = nB; ++ui;
#pragma unroll
        for (int h = 0; h < 2; ++h)
#pragma unroll
            for (int i = 0; i < 2; ++i) vAc[h][i] = vAn[h][i];
        if constexpr (ALIGN_EPI) { if (wr == 1) PG8_BAR; }
    }
    PG8_WAIT_V(0);
    if constexpr (!ALIGN_EPI) { if (wr == 0) PG8_BAR; }
    PG8_BAR;
    if constexpr (Epi::AFTER_DRAIN) { E.fused(acc, cur, wr, wc, fr, fq, lds, wid, lane); S.done(cur); }
#undef PG8_SA
#undef PG8_VA
#undef PG8_SB
#undef PG8_STAGE
#undef PG8_LDA
#undef PG8_LDB
#undef PG8_MMA
#undef PG8_WAIT_V
#undef PG8_WAIT_L
#undef PG8_BAR
#undef PG8_SCHED
}
}
#define GAS __attribute__((address_space(1)))
#define LAS __attribute__((address_space(3)))
typedef float f32x4 __attribute__((ext_vector_type(4)));
typedef short bf16x8 __attribute__((ext_vector_type(8)));
constexpr int NWAVES = 8, NTHREADS = 512;
constexpr int LDS_BYTES = 163840, LDSCTL_OFF = LDS_BYTES - 4096, RING_BYTES = LDSCTL_OFF;
constexpr int LDS_TILETAB = LDSCTL_OFF + 256;

#define XB_TMO      128
#define XB_XCNT(j)  (256  + 64 * (j))
#define XB_XSUB(j)  (1280 + 64 * (j))
#define XB_XGEN(j)  (2304 + 64 * (j))
#define XB_TOP      3328
#define XB_TOPGEN   3392
#define XCD_BAR_WORDS 3456
#define XB_SPIN_CAP (1u << 18)
__device__ __forceinline__ unsigned xb_ld(unsigned* p)              { return __hip_atomic_load(p, __ATOMIC_RELAXED, __HIP_MEMORY_SCOPE_AGENT); }
__device__ __forceinline__ unsigned xb_add(unsigned* p, unsigned v) { return __hip_atomic_fetch_add(p, v, __ATOMIC_RELAXED, __HIP_MEMORY_SCOPE_AGENT); }
__device__ __forceinline__ unsigned xb_xcc_id() { return (unsigned)__builtin_amdgcn_s_getreg((3 << 11) | 20) & 0xFu; }
#define XB_SPIN(cond, bar) do { unsigned _sp = 0; while (cond) { __builtin_amdgcn_s_sleep(1); \
    if ((++_sp & 255u) == 0u) { if (xb_ld(&(bar)[XB_TMO])) break; if (_sp > XB_SPIN_CAP) { atomicAdd(&(bar)[XB_TMO], 1u); break; } } } } while (0)
struct XcdBarrier { unsigned* bar; unsigned x; volatile LAS unsigned* st; };
__device__ __forceinline__ XcdBarrier xcd_barrier_post(unsigned* bar, volatile LAS unsigned* st) {
    XcdBarrier b; b.bar = bar; b.x = xb_xcc_id(); b.st = st;
    if (threadIdx.x == 0) (void)xb_add(&bar[XB_XCNT(b.x)], 1u);
    return b;
}
__device__ __forceinline__ void xcd_barrier_complete(unsigned* bar, unsigned x, unsigned& nloc, unsigned& nx) {
    const unsigned G = gridDim.x * gridDim.y * gridDim.z;
    unsigned sum, cnt, mine, sp = 0u;
    for (;;) {
        sum = 0u; cnt = 0u; mine = 0u;
#pragma unroll
        for (unsigned j = 0; j < 16; ++j) { const unsigned c = xb_ld(&bar[XB_XCNT(j)]); sum += c; cnt += (c > 0u) ? 1u : 0u; mine = (j == x) ? c : mine; }
        if (sum == G) break;
        __builtin_amdgcn_s_sleep(1);
        if ((++sp & 255u) == 0u) { if (xb_ld(&bar[XB_TMO])) break; if (sp > XB_SPIN_CAP) { atomicAdd(&bar[XB_TMO], 1u); break; } }
    }
    nloc = mine > 0u ? mine : 1u; nx = cnt > 0u ? cnt : 1u;
}
__device__ __forceinline__ void xcd_barrier(const XcdBarrier& b) {
    asm volatile("s_waitcnt vmcnt(0)" ::: "memory");
    __syncthreads();
    if (threadIdx.x == 0) {
        unsigned* bar = b.bar;
        __builtin_amdgcn_s_waitcnt(0);
        unsigned nloc = b.st[0], nx = b.st[1];
        if (nloc == 0u) { xcd_barrier_complete(bar, b.x, nloc, nx); b.st[0] = nloc; b.st[1] = nx; }
        const unsigned old = xb_add(&bar[XB_XSUB(b.x)], 1u);
        const unsigned gen = old / nloc;
        if (old + 1u == (gen + 1u) * nloc) {
            __builtin_amdgcn_fence(__ATOMIC_RELEASE, "agent");
            asm volatile("s_waitcnt vmcnt(0)" ::: "memory");
            const unsigned og = xb_add(&bar[XB_TOP], 1u);
            const unsigned tg = og / nx;
            if (og + 1u == (tg + 1u) * nx) xb_add(&bar[XB_TOPGEN], 1u);
            else XB_SPIN(xb_ld(&bar[XB_TOPGEN]) == tg, bar);
            __builtin_amdgcn_fence(__ATOMIC_ACQUIRE, "agent");
            xb_add(&bar[XB_XGEN(b.x)], 1u);
            asm volatile("s_waitcnt vmcnt(0)" ::: "memory");
        } else {
            XB_SPIN(xb_ld(&bar[XB_XGEN(b.x)]) == gen, bar);
            __builtin_amdgcn_fence(__ATOMIC_ACQUIRE, "agent");
            asm volatile("s_waitcnt vmcnt(0)" ::: "memory");
        }
    }
    __syncthreads();
}

struct Ctx { LAS unsigned char* lds; int tid, lane, wave, vcu, G, gw, ngw; };
__device__ __forceinline__ Ctx refresh(const Ctx& C0) { Ctx C = C0; int t = threadIdx.x; asm volatile("" : "+v"(t)); C.tid = t; C.lane = t & 63; C.wave = __builtin_amdgcn_readfirstlane(t >> 6); C.gw = C.vcu * 8 + C.wave; return C; }

using pg8::cvt_pk_bf16;
struct EpiStoreBf16 {
    static constexpr bool PERM = false, AFTER_DRAIN = false;
    bf16_t* O; int ldc;
    __device__ __forceinline__ void operator()(const f32x4 (&acc)[2][2][4][2], const pg8::Unit& u, int wr, int wc, int fr, int fq) const {
        const int row0 = u.r0 + wr * 64 + fr, col0 = u.pn * 256 + wc * 32 + 4 * fq;
#pragma unroll
        for (int ai = 0; ai < 2; ++ai)
#pragma unroll
            for (int m = 0; m < 4; ++m) { bf16_t* rowp = (bf16_t*)((char*)O + ((unsigned)(row0 + ai * 128 + m * 16) * (unsigned)(ldc * 2) + (unsigned)(col0 * 2)));
#pragma unroll
                for (int bj = 0; bj < 2; ++bj)
#pragma unroll
                    for (int n = 0; n < 2; ++n) { const f32x4 v = acc[ai][bj][m][n]; uint2 w; w.x = cvt_pk_bf16(v[0], v[1]); w.y = cvt_pk_bf16(v[2], v[3]); *(uint2*)(rowp + bj * 128 + n * 16) = w; } }
    }
};
struct EpiGlu {
    static constexpr bool PERM = false, AFTER_DRAIN = false;
    const bf16_t* Z; const float* bglu; bf16_t* Y;
    __device__ __forceinline__ void operator()(const f32x4 (&acc)[2][2][4][2], const pg8::Unit& u, int wr, int wc, int fr, int fq) const {
        const int row0 = u.r0 + wr * 64 + fr, col0 = u.pn * 256 + wc * 32 + 4 * fq;
#pragma unroll
        for (int bj = 0; bj < 2; ++bj)
#pragma unroll
            for (int n = 0; n < 2; ++n) { const int c = col0 + bj * 128 + n * 16; const f32x4 bv = *(const f32x4*)(bglu + c);
#pragma unroll
                for (int ai = 0; ai < 2; ++ai)
#pragma unroll
                    for (int m = 0; m < 4; ++m) { const size_t r = (size_t)(row0 + ai * 128 + m * 16); const uint2 zz = *(const uint2*)(Z + r * S5W + c);
                        const f32x4 v = acc[ai][bj][m][n] + bv;
                        const float z0 = __uint_as_float(zz.x << 16), z1 = __uint_as_float(zz.x & 0xffff0000u), z2 = __uint_as_float(zz.y << 16), z3 = __uint_as_float(zz.y & 0xffff0000u);
                        uint2 w; w.x = cvt_pk_bf16(z0 * sigmoidf_(v[0]), z1 * sigmoidf_(v[1])); w.y = cvt_pk_bf16(z2 * sigmoidf_(v[2]), z3 * sigmoidf_(v[3]));
                        *(uint2*)(Y + r * D + c) = w; } }
    }
};
struct EpiResid {
    static constexpr bool PERM = false, AFTER_DRAIN = false;
    float* H;
    __device__ __forceinline__ void operator()(const f32x4 (&acc)[2][2][4][2], const pg8::Unit& u, int wr, int wc, int fr, int fq) const {
        const int row0 = u.r0 + wr * 64 + fr, col0 = u.pn * 256 + wc * 32 + 4 * fq;
#pragma unroll
        for (int ai = 0; ai < 2; ++ai)
#pragma unroll
            for (int m = 0; m < 4; ++m) { float* rowp = (float*)((char*)H + ((unsigned)(row0 + ai * 128 + m * 16) * (unsigned)(D * 4) + (unsigned)(col0 * 4)));
#pragma unroll
                for (int bj = 0; bj < 2; ++bj)
#pragma unroll
                    for (int n = 0; n < 2; ++n) { f32x4* q = (f32x4*)(rowp + bj * 128 + n * 16); *q = *q * DN_ALPHA + acc[ai][bj][m][n]; } }
    }
};
struct EpiMoe1 {
    static constexpr bool PERM = false, AFTER_DRAIN = false;
    bf16_t* HH; const int* list; const float* tokw;
    __device__ __forceinline__ void operator()(const f32x4 (&acc)[2][2][4][2], const pg8::Unit& u, int wr, int wc, int fr, int fq) const {
        const int f0 = (u.pn & 1) * 128 + wc * 32 + 4 * fq;
#pragma unroll
        for (int ai = 0; ai < 2; ++ai)
#pragma unroll
            for (int m = 0; m < 4; ++m) { const int lr = ai * 128 + wr * 64 + m * 16 + fr;
                if (lr < u.nr) { const unsigned r = (unsigned)(u.r0 + lr); const float w = tokw[list[u.lb + lr]];
#pragma unroll
                    for (int n = 0; n < 2; ++n) { const f32x4 g = acc[ai][0][m][n], up = acc[ai][1][m][n];
                        uint2 o; o.x = cvt_pk_bf16(siluf_(g[0]) * up[0] * w, siluf_(g[1]) * up[1] * w); o.y = cvt_pk_bf16(siluf_(g[2]) * up[2] * w, siluf_(g[3]) * up[3] * w);
                        *(uint2*)((char*)HH + (r * (unsigned)(MOE_FF * 2) + (unsigned)((f0 + n * 16) * 2))) = o; } } }
    }
};
struct EpiMoe2 {
    static constexpr bool PERM = false, AFTER_DRAIN = false;
    bf16_t* YS;
    __device__ __forceinline__ void operator()(const f32x4 (&acc)[2][2][4][2], const pg8::Unit& u, int wr, int wc, int fr, int fq) const {
        const int col0 = (u.pn & 7) * 256 + wc * 32 + 4 * fq;
#pragma unroll
        for (int ai = 0; ai < 2; ++ai)
#pragma unroll
            for (int m = 0; m < 4; ++m) { const int lr = ai * 128 + wr * 64 + m * 16 + fr; const int row = (lr < u.nr) ? (u.r0 + lr) : (XS_ROWS - 1);
                bf16_t* rowp = (bf16_t*)((char*)YS + ((unsigned)row * (unsigned)(D * 2) + (unsigned)(col0 * 2)));
#pragma unroll
                for (int bj = 0; bj < 2; ++bj)
#pragma unroll
                    for (int n = 0; n < 2; ++n) { const f32x4 v = acc[ai][bj][m][n]; uint2 w; w.x = cvt_pk_bf16(v[0], v[1]); w.y = cvt_pk_bf16(v[2], v[3]); *(uint2*)(rowp + bj * 128 + n * 16) = w; } }
    }
};
struct MoeOrder {
    static constexpr bool GATHER = false;
    __device__ __forceinline__ unsigned gather_voff(const pg8::Unit&, int, int, int) const { return 0u; }
    const volatile LAS int* tab; int ntiles, npn, G, c;
    __device__ __forceinline__ bool next(int i, pg8::Unit& u) const {
        const int L = i * G + c; if (L >= ntiles * npn) return false;
        const int t = L / npn, pn = L % npn;
        u.pm = t; u.pn = __builtin_amdgcn_readfirstlane(tab[t]) * npn + pn; u.r0 = __builtin_amdgcn_readfirstlane(tab[176 + t]); u.nr = __builtin_amdgcn_readfirstlane(tab[352 + t]); u.lb = 0; return true;
    }
    __device__ __forceinline__ void a_ready(const pg8::Unit&) const {}
    __device__ __forceinline__ void done(const pg8::Unit&) const {}
};
struct MoeGatherOrder {
    static constexpr bool GATHER = true;
    const volatile LAS int* tab; int ntiles, npn, G, c; const int* list;
    __device__ __forceinline__ bool next(int i, pg8::Unit& u) const {
        const int L = i * G + c; if (L >= ntiles * npn) return false;
        const int t = L / npn, pn = L % npn;
        u.pm = t; u.pn = __builtin_amdgcn_readfirstlane(tab[t]) * npn + pn; u.r0 = __builtin_amdgcn_readfirstlane(tab[176 + t]); u.nr = __builtin_amdgcn_readfirstlane(tab[352 + t]); u.lb = __builtin_amdgcn_readfirstlane(tab[704 + t]); return true;
    }
    __device__ __forceinline__ unsigned gather_voff(const pg8::Unit& u, int lr, int c2, int K) const {
        const int entry = (lr < u.nr) ? list[u.lb + lr] : 0;
        return (unsigned)((entry >> 1) * (K * 2) + c2);
    }
    __device__ __forceinline__ void a_ready(const pg8::Unit&) const {}
    __device__ __forceinline__ void done(const pg8::Unit&) const {}
};
__device__ __forceinline__ int moe_build_tiles(const Ctx& C0, unsigned* cnt) {
    const Ctx C = refresh(C0);
    volatile LAS int* tab = (volatile LAS int*)(C.lds + LDS_TILETAB);
    __syncthreads();
    if (C.tid == 0) { int nt = 0, off = 0;
        for (int e = 0; e < MOE_NE; ++e) { const int c = (int)xb_ld(cnt + e);
            for (int r = 0; r < c; r += 256) { tab[nt] = e; tab[176 + nt] = off + r; tab[352 + nt] = (c - r) < 256 ? (c - r) : 256; tab[704 + nt] = e * MROWS + r; ++nt; }
            off += c; }
        tab[528] = nt; }
    __syncthreads();
    return __builtin_amdgcn_readfirstlane(tab[528]);
}

__device__ __forceinline__ void split8(const f32x4 a0, const f32x4 a1, bf16x8& hi, bf16x8& lo) {
    float x[8] = {a0[0], a0[1], a0[2], a0[3], a1[0], a1[1], a1[2], a1[3]};
#pragma unroll
    for (int j = 0; j < 8; ++j) { const unsigned h = f2bf(x[j]); hi[j] = (short)h; lo[j] = (short)f2bf(x[j] - __uint_as_float(h << 16)); }
}
template <int NT> __device__ __forceinline__ void skinny3_tile(const float* Hr0, const bf16_t* Bhi, const bf16_t* Blo, f32x4 (&acc)[NT], int lane, int kb = 0, int ke = D) {
    const int fr = lane & 15, fq = lane >> 4;
#pragma unroll
    for (int nt = 0; nt < NT; ++nt) acc[nt] = (f32x4){0.f, 0.f, 0.f, 0.f};
    const float* ap = Hr0 + (size_t)fr * D + 8 * fq;
    const bf16_t* bh = Bhi + (size_t)fr * D + 8 * fq; const bf16_t* bl = Blo + (size_t)fr * D + 8 * fq;
#pragma unroll 4
    for (int k0 = kb; k0 < ke; k0 += 32) {
        bf16x8 ahi, alo; split8(*(const f32x4*)(ap + k0), *(const f32x4*)(ap + k0 + 4), ahi, alo);
#pragma unroll
        for (int nt = 0; nt < NT; ++nt) { const bf16x8 wh = *(const bf16x8*)(bh + (size_t)nt * 16 * D + k0), wl = *(const bf16x8*)(bl + (size_t)nt * 16 * D + k0);
            acc[nt] = __builtin_amdgcn_mfma_f32_16x16x32_bf16(ahi, wh, acc[nt], 0, 0, 0);
            acc[nt] = __builtin_amdgcn_mfma_f32_16x16x32_bf16(ahi, wl, acc[nt], 0, 0, 0);
            acc[nt] = __builtin_amdgcn_mfma_f32_16x16x32_bf16(alo, wh, acc[nt], 0, 0, 0); }
    }
}
constexpr int SKW_LD = 264;
template <int NT> __device__ __forceinline__ void wg_skinny(const Ctx& C, const float* H, const int (&rb)[4], const bf16_t* Bhi, const bf16_t* Blo, f32x4 (&acc)[NT]) {
    const int lane = C.lane, fr = lane & 15, fq = lane >> 4, tid = C.tid;
    LAS bf16_t* AH = (LAS bf16_t*)(C.lds + 36864); LAS bf16_t* AL = AH + 64 * SKW_LD; LAS bf16_t* BH = AL + 64 * SKW_LD; LAS bf16_t* BL = BH + NT * 16 * SKW_LD;
#pragma unroll
    for (int nt = 0; nt < NT; ++nt) acc[nt] = (f32x4){0.f, 0.f, 0.f, 0.f};
    const int ti = C.wave >> 1, kp = C.wave & 1;
    for (int kc = 0; kc < D; kc += 256) {
        __syncthreads();
        f32x4 av[8];
#pragma unroll
        for (int i = 0; i < 8; ++i) { const int idx = tid + NTHREADS * i, row = idx >> 6, c4 = (idx & 63) * 4; av[i] = *(const f32x4*)(H + (size_t)(rb[row >> 4] + (row & 15)) * D + kc + c4); }
        constexpr int NBV = NT * 16 * 32;
        v4u bhv[(NBV + NTHREADS - 1) / NTHREADS], blv[(NBV + NTHREADS - 1) / NTHREADS];
#pragma unroll
        for (int i = 0; i < (NBV + NTHREADS - 1) / NTHREADS; ++i) { const int idx = tid + NTHREADS * i;
            if (idx < NBV) { const int row = idx >> 5, c8 = (idx & 31) * 8; bhv[i] = *(const v4u*)(Bhi + (size_t)row * D + kc + c8); blv[i] = *(const v4u*)(Blo + (size_t)row * D + kc + c8); } }
#pragma unroll
        for (int i = 0; i < 8; ++i) { const int idx = tid + NTHREADS * i, row = idx >> 6, c4 = (idx & 63) * 4;
            const unsigned h01 = pk2(av[i][0], av[i][1]), h23 = pk2(av[i][2], av[i][3]);
            const unsigned l01 = pk2(av[i][0] - __uint_as_float(h01 << 16), av[i][1] - __uint_as_float(h01 & 0xffff0000u)), l23 = pk2(av[i][2] - __uint_as_float(h23 << 16), av[i][3] - __uint_as_float(h23 & 0xffff0000u));
            *(LAS v2u*)(AH + row * SKW_LD + c4) = (v2u){h01, h23}; *(LAS v2u*)(AL + row * SKW_LD + c4) = (v2u){l01, l23}; }
#pragma unroll
        for (int i = 0; i < (NBV + NTHREADS - 1) / NTHREADS; ++i) { const int idx = tid + NTHREADS * i;
            if (idx < NBV) { const int row = idx >> 5, c8 = (idx & 31) * 8; *(LAS v4u*)(BH + row * SKW_LD + c8) = bhv[i]; *(LAS v4u*)(BL + row * SKW_LD + c8) = blv[i]; } }
        __syncthreads();
#pragma unroll
        for (int k4 = 0; k4 < 4; ++k4) { const int ko = (kp * 4 + k4) * 32 + 8 * fq;
            const bf16x8 ahi = *(const LAS bf16x8*)(AH + (ti * 16 + fr) * SKW_LD + ko), alo = *(const LAS bf16x8*)(AL + (ti * 16 + fr) * SKW_LD + ko);
#pragma unroll
            for (int nt = 0; nt < NT; ++nt) { const bf16x8 wh = *(const LAS bf16x8*)(BH + (nt * 16 + fr) * SKW_LD + ko), wl = *(const LAS bf16x8*)(BL + (nt * 16 + fr) * SKW_LD + ko);
                acc[nt] = __builtin_amdgcn_mfma_f32_16x16x32_bf16(ahi, wh, acc[nt], 0, 0, 0);
                acc[nt] = __builtin_amdgcn_mfma_f32_16x16x32_bf16(ahi, wl, acc[nt], 0, 0, 0);
                acc[nt] = __builtin_amdgcn_mfma_f32_16x16x32_bf16(alo, wh, acc[nt], 0, 0, 0); } }
    }
    __syncthreads();
}
struct Args { Ptrs p; int ph_lo, ph_hi, li, pad; };
typedef const __attribute__((address_space(4))) Args* KA;
typedef const __attribute__((address_space(4))) Ptrs* KP;
__device__ __forceinline__ KA kargs() { KA q = (KA)__builtin_amdgcn_kernarg_segment_ptr(); asm volatile("" : "+s"(q)); return q; }
__device__ __forceinline__ KP kp() { return &kargs()->p; }
__device__ __forceinline__ bool in_ph(int k) { KA a = kargs(); return a->ph_lo <= k && k < a->ph_hi; }
__device__ __forceinline__ void cvt_tile64(const float* src  , size_t ldw, bf16_t* dst  , size_t ldt, LAS bf16_t* T  , int lane) {
    const int r = lane >> 4, c4 = (lane & 15) * 4;
    f32x4 v[16];
#pragma unroll
    for (int i = 0; i < 16; ++i) v[i] = __builtin_nontemporal_load((const f32x4*)(src + (size_t)(4 * i + r) * ldw + c4));
#pragma unroll
    for (int i = 0; i < 16; ++i) { const int k = 4 * i + r;
        T[(c4 + 0) * 72 + k] = (bf16_t)f2bf(v[i][0]); T[(c4 + 1) * 72 + k] = (bf16_t)f2bf(v[i][1]); T[(c4 + 2) * 72 + k] = (bf16_t)f2bf(v[i][2]); T[(c4 + 3) * 72 + k] = (bf16_t)f2bf(v[i][3]); }
    asm volatile("s_waitcnt lgkmcnt(0)" ::: "memory");
#pragma unroll
    for (int j = 0; j < 8; ++j) { const int idx = lane + 64 * j, n = idx >> 3, kc = idx & 7;
        *(v4u*)(dst + (size_t)n * ldt + kc * 8) = *(const LAS v4u*)(T + n * 72 + kc * 8); }
    asm volatile("s_waitcnt lgkmcnt(0)" ::: "memory");
}
__device__ __forceinline__ void cvt_job_tile64(const CvtJob& j, int item, LAS bf16_t* T, int lane) {
    const int nblk = j.ncols / 64, kb = item / nblk, nb = item % nblk;
    cvt_tile64(j.src + (size_t)(64 * kb) * j.ldw + 64 * nb, j.ldw, j.dst + (size_t)(64 * nb) * j.ldt + 64 * kb, j.ldt, T, lane);
}
constexpr int CVT_MOE_TILES = MOE_NE * 384;
constexpr int CVT_STATIC_TILES = 2048 + 1024 + 1024 + 1024 + 256 + 16 * 4;
__device__ __forceinline__ void cvt_list_item(KP p, int list, int it, LAS bf16_t* T, int lane) {
    if (list == 0 && it < CVT_STATIC_TILES) {
        int j, r = it;
        if (r < 2048) j = 2; else if ((r -= 2048) < 1024) j = 3; else if ((r -= 1024) < 1024) j = 4; else if ((r -= 1024) < 1024) j = 5; else if ((r -= 1024) < 256) j = 6; else { r -= 256; j = 7 + (r >> 2); r &= 3; }
        cvt_job_tile64(static_job(p, j), r, T, lane);
    } else {
        if (list == 0) it -= CVT_STATIC_TILES;
        const int e = it / 384, r = it % 384, jj = r < 256 ? (r >> 6) : 4;
        cvt_job_tile64(moe_job(p, list, e * 5 + jj), r < 256 ? (r & 63) : (r - 256), T, lane);
    }
}
constexpr int CW_CVTQ = 32;
__device__ __forceinline__ void cvt_pull(const Ctx& C0, KP p, int list) {
    const Ctx C = refresh(C0);
    LAS bf16_t* T = (LAS bf16_t*)(C.lds + C.wave * 9216);
    unsigned* q = (unsigned*)(p->ws + WS_CTL) + CW_CVTQ + 16 * list;
    const int total = (list == 0) ? CVT_STATIC_TILES + CVT_MOE_TILES : CVT_MOE_TILES;
    constexpr int CVT_BATCH = 16;
    for (;;) {
        int it = 0; if (C.lane == 0) it = (int)atomicAdd(q, (unsigned)CVT_BATCH);
        it = __builtin_amdgcn_readfirstlane(it);
        if (it >= total) break;
        const int ie = (it + CVT_BATCH < total) ? it + CVT_BATCH : total;
        for (int k = it; k < ie; ++k) cvt_list_item(p, list, k, T, C.lane);
    }
}

__device__ __forceinline__ void ph_prologue(const Ctx& C0, KP p) {
    const Ctx C = refresh(C0);
    { LAS bf16_t* T = (LAS bf16_t*)(C.lds + C.wave * 9216);
      for (int j = 0; j < 2; ++j) { const CvtJob job = static_job(p, j); const int nit = (job.K / 64) * (job.ncols / 64);
          for (int it = C.gw; it < nit; it += C.ngw) cvt_job_tile64(job, it, T, C.lane); } }
    const size_t gt = (size_t)C.vcu * NTHREADS + C.tid, ngt = (size_t)C.G * NTHREADS;
    {
        float* H = (float*)(p->ws + WS_H); bf16_t* HB = (bf16_t*)(p->ws + WS_HB);
        const size_t n4 = (size_t)MP * D / 4;
        for (size_t i = gt; i < n4; i += ngt) {
            const int m = (int)(i / (D / 4)), c = (int)(i % (D / 4)) * 4;
            float4 v = make_float4(0.f, 0.f, 0.f, 0.f);
            if (m < MROWS) { const int b = m / LP, q = m % LP;
                if (q >= CHUNK) { const f32x4 t4 = __builtin_nontemporal_load((const f32x4*)(p->in[0] + ((size_t)b * SEQ + (q - CHUNK)) * D + c)); v = make_float4(t4[0], t4[1], t4[2], t4[3]); }
                else if (q >= PADF) v = *(const float4*)(p->in[1] + (size_t)(q - PADF) * D + c); }
            *(float4*)(H + (size_t)m * D + c) = v;
            uint2 o; o.x = pk2(v.x, v.y); o.y = pk2(v.z, v.w); *(uint2*)(HB + (size_t)m * D + c) = o;
        }
    }
    {
        bf16_t* WR = (bf16_t*)(p->ws + WS_WR); bf16_t* WK = (bf16_t*)(p->ws + WS_WSK3);
        for (size_t i = gt; i < (size_t)2 * 64 * D; i += ngt) { const int k = (int)(i % D), n = (int)((i / D) % 64), L = (int)(i / ((size_t)64 * D));
            if (n < 48) { const float x = n < 4 ? p->in[30][((size_t)L * D + k) * 4 + n] : (n < 36 ? p->in[32][((size_t)L * D + k) * 32 + (n - 4)] : 0.f);
                const unsigned h = f2bf(x); WR[((size_t)(L * 2 + 0) * 48 + n) * D + k] = (bf16_t)h; WR[((size_t)(L * 2 + 1) * 48 + n) * D + k] = (bf16_t)f2bf(x - __uint_as_float(h << 16)); }
            else { const int c = n - 48; const float x = L == 0 ? p->in[2][(size_t)k * 4112 + 3072 + c] : p->in[17][(size_t)k * 6160 + 4096 + c];
                const unsigned h = f2bf(x); WK[((size_t)(L * 2 + 0) * 16 + c) * D + k] = (bf16_t)h; WK[((size_t)(L * 2 + 1) * 16 + c) * D + k] = (bf16_t)f2bf(x - __uint_as_float(h << 16)); } }
    }
    if (gt < S5G * S5P) {
        const int i = (int)gt, g = i / S5P, pp = i % S5P;
        float* Cc = (float*)(p->ws + WS_S5C); bf16_t* Bb = (bf16_t*)(p->ws + WS_S5B);
        const float are = p->in[3][i], aim = p->in[4][i], dt = expf(p->in[5][g]);
        const float mag = expf(are * dt); float sn, cs; sincosf(aim * dt, &sn, &cs);
        const float br = mag * cs, bi = mag * sn;
        Cc[S5C_ABAR + 2 * i] = br; Cc[S5C_ABAR + 2 * i + 1] = bi;
        const float nr = br - 1.0f, ni = bi, den = are * are + aim * aim;
        const float zr = (nr * are + ni * aim) / den, zi = (ni * are - nr * aim) / den;
        for (int c = 0; c < S5C; ++c) { const float b_r = p->in[6][(size_t)i * S5C + c], b_i = p->in[7][(size_t)i * S5C + c];
            const float xr = b_r * zr - b_i * zi, xi = b_r * zi + b_i * zr;
            Cc[S5C_BBAR + ((size_t)i * S5C + c) * 2] = xr; Cc[S5C_BBAR + ((size_t)i * S5C + c) * 2 + 1] = xi;
            Bb[S5B_BR + (size_t)i * 16 + c] = (bf16_t)f2bf(xr); Bb[S5B_BI + (size_t)i * 16 + c] = (bf16_t)f2bf(xi);
            Bb[S5B_CM + ((size_t)g * 16 + c) * 128 + pp] = (bf16_t)f2bf(p->in[8][((size_t)g * 16 + c) * 64 + pp]);
            Bb[S5B_CM + ((size_t)g * 16 + c) * 128 + 64 + pp] = (bf16_t)f2bf(-p->in[9][((size_t)g * 16 + c) * 64 + pp]); }
    }
}
__device__ __forceinline__ void ph_cvt_moe(const Ctx& C0, KP p, int L) {
    const Ctx C = refresh(C0);
    float* scr = (float*)(C.lds + C.wave * 8448);
    for (int j = 0; j < MOE_NE * 5; ++j) { const CvtJob job = moe_job(p, L, j); const int nit = (job.K / 64) * (job.ncols / 32);
        for (int it = C.gw; it < nit; it += C.ngw) cvt_job_items(job, it, scr, C.lane); }
}
__device__ __forceinline__ void ph_skinny(const Ctx& C0, KP p, int L) {
    const Ctx C = refresh(C0);
    const float* H = (const float*)(p->ws + WS_H); float* SK = (float*)(p->ws + WS_SK);
    const bf16_t* Bhi = (const bf16_t*)(p->ws + WS_WSK3) + (size_t)(L * 2) * 16 * D; const bf16_t* Blo = Bhi + (size_t)16 * D;
    volatile LAS float* S = (volatile LAS float*)(C.lds);
    const int NTILE = MROWS / 16;
    for (int tb = C.vcu; tb < NTILE; tb += 4 * C.G) {
        int rb[4];
#pragma unroll
        for (int i = 0; i < 4; ++i) rb[i] = ((tb + i * C.G < NTILE) ? (tb + i * C.G) : tb) * 16;
        f32x4 acc[1]; wg_skinny<1>(C, H, rb, Bhi, Blo, acc);
        const int ti = C.wave >> 1, kh = C.wave & 1;
#pragma unroll
        for (int i = 0; i < 4; ++i) S[((ti * 2 + kh) * 16 + 4 * (C.lane >> 4) + i) * 16 + (C.lane & 15)] = acc[0][i];
        __syncthreads();
        if (kh == 0 && tb + ti * C.G < NTILE) {
#pragma unroll
            for (int i = 0; i < 4; ++i) { const int r = 4 * (C.lane >> 4) + i;
                SK[(size_t)(rb[ti] + r) * 16 + (C.lane & 15)] = S[((ti * 2) * 16 + r) * 16 + (C.lane & 15)] + S[((ti * 2 + 1) * 16 + r) * 16 + (C.lane & 15)]; } }
        __syncthreads();
    }
}
template <int MODE> __device__ __forceinline__ void ln_row(KP p, int m, const float* g, const float* b, float* out, int lane, int pos0 = 0, int pos1 = 0) {
    float* H = (float*)(p->ws + WS_H); bf16_t* HB = (bf16_t*)(p->ws + WS_HB);
    float4* hr = (float4*)(H + (size_t)m * D); uint2* hb = (uint2*)(HB + (size_t)m * D);
    if (!row_valid(m)) {
#pragma unroll
        for (int j = 0; j < 8; ++j) { hr[lane + 64 * j] = make_float4(0.f, 0.f, 0.f, 0.f); hb[lane + 64 * j] = make_uint2(0u, 0u); }
        return; }
    float4 v[8]; float s = 0.f;
#pragma unroll
    for (int j = 0; j < 8; ++j) v[j] = hr[lane + 64 * j];
    if (MODE == 2) { const uint2* mx = (const uint2*)((const bf16_t*)(p->ws + WS_MIX) + (size_t)m * D);
#pragma unroll
        for (int j = 0; j < 8; ++j) { const uint2 a = mx[lane + 64 * j];
            v[j].x = DN_ALPHA * v[j].x + __uint_as_float(a.x << 16); v[j].y = DN_ALPHA * v[j].y + __uint_as_float(a.x & 0xffff0000u);
            v[j].z = DN_ALPHA * v[j].z + __uint_as_float(a.y << 16); v[j].w = DN_ALPHA * v[j].w + __uint_as_float(a.y & 0xffff0000u); } }
    if (MODE == 1) { const bf16_t* YS = (const bf16_t*)(p->ws + WS_XS);
        const uint2* y0 = (const uint2*)(YS + (size_t)pos0 * D); const uint2* y1 = (const uint2*)(YS + (size_t)pos1 * D);
#pragma unroll
        for (int j = 0; j < 8; ++j) { const uint2 a = y0[lane + 64 * j], c = y1[lane + 64 * j];
            v[j].x = DN_ALPHA * v[j].x + (__uint_as_float(a.x << 16) + __uint_as_float(c.x << 16));
            v[j].y = DN_ALPHA * v[j].y + (__uint_as_float(a.x & 0xffff0000u) + __uint_as_float(c.x & 0xffff0000u));
            v[j].z = DN_ALPHA * v[j].z + (__uint_as_float(a.y << 16) + __uint_as_float(c.y << 16));
            v[j].w = DN_ALPHA * v[j].w + (__uint_as_float(a.y & 0xffff0000u) + __uint_as_float(c.y & 0xffff0000u)); } }
#pragma unroll
    for (int j = 0; j < 8; ++j) s += (v[j].x + v[j].y) + (v[j].z + v[j].w);
    const float mean = wave_sum(s) * (1.0f / D); float q = 0.f;
#pragma unroll
    for (int j = 0; j < 8; ++j) { v[j].x -= mean; v[j].y -= mean; v[j].z -= mean; v[j].w -= mean; q += (v[j].x * v[j].x + v[j].y * v[j].y) + (v[j].z * v[j].z + v[j].w * v[j].w); }
    const float rstd = rsqrtf(wave_sum(q) * (1.0f / D) + LN_EPS);
    const int q_ = m % LP, bb = m / LP;
#pragma unroll
    for (int j = 0; j < 8; ++j) { const int c = (lane + 64 * j) * 4; const float4 gg = *(const float4*)(g + c), bv = *(const float4*)(b + c);
        float4 o; o.x = v[j].x * rstd * gg.x + bv.x; o.y = v[j].y * rstd * gg.y + bv.y; o.z = v[j].z * rstd * gg.z + bv.z; o.w = v[j].w * rstd * gg.w + bv.w;
        hr[lane + 64 * j] = o; hb[lane + 64 * j] = make_uint2(pk2(o.x, o.y), pk2(o.z, o.w));
        if (out && q_ >= CHUNK) __builtin_nontemporal_store((f32x4){o.x, o.y, o.z, o.w}, (f32x4*)(out + ((size_t)bb * SEQ + (q_ - CHUNK)) * D + c)); }
}
__device__ __forceinline__ void ph_ln1_router(const Ctx& C0, KP p, int L) {
    const Ctx C = refresh(C0);
    const float* g = p->in[37] + L * D; const float* b = p->in[38] + L * D;
    const float* H = (const float*)(p->ws + WS_H); const bf16_t* WRhi = (const bf16_t*)(p->ws + WS_WR) + (size_t)(L * 2) * 48 * D; const bf16_t* WRlo = WRhi + (size_t)48 * D;
    const float* brg = p->in[31] + L * 4; const float* bre = p->in[33] + L * 32;
    int* toke = (int*)(p->ws + WS_TOKE); float* tokw = (float*)(p->ws + WS_TOKW); int* toks = (int*)(p->ws + WS_TOKS);
    unsigned* cnt = (unsigned*)(p->ws + WS_CTL) + CW_CNT + L * 32;
    volatile LAS float* S = (volatile LAS float*)(C.lds);
    const int NTILE = MP / 16;
    for (int tb = C.vcu; tb < NTILE; tb += 4 * C.G) {
        int nt = 0;
#pragma unroll
        for (int i = 0; i < 4; ++i) nt += (tb + i * C.G < NTILE) ? 1 : 0;
        for (int j = C.wave; j < nt * 16; j += NWAVES) ln_row<2>(p, (tb + (j >> 4) * C.G) * 16 + (j & 15), g, b, nullptr, C.lane);
        __syncthreads();
        const int ti = C.wave >> 1, kh = C.wave & 1, t = tb + ti * C.G;
        const bool act = ti < nt && t * 16 < MROWS;
        int rb[4];
#pragma unroll
        for (int i = 0; i < 4; ++i) rb[i] = ((i < nt) ? (tb + i * C.G) : tb) * 16;
        f32x4 acc[3]; wg_skinny<3>(C, H, rb, WRhi, WRlo, acc);
        if (act) {
#pragma unroll
            for (int n3 = 0; n3 < 3; ++n3)
#pragma unroll
                for (int i = 0; i < 4; ++i) S[((ti * 2 + kh) * 16 + 4 * (C.lane >> 4) + i) * 48 + 16 * n3 + (C.lane & 15)] = acc[n3][i];
        }
        __syncthreads();
        volatile LAS int* LC = (volatile LAS int*)(C.lds + 32768);
        if (C.tid < 32) LC[C.tid] = 0;
        __syncthreads();
        int ea = -1, eb = -1, la = 0, lb = 0; const int m = t * 16 + C.lane;
        if (act && kh == 0 && C.lane < 16) {
            if (!row_valid(m)) { toke[m * 2] = 0; toke[m * 2 + 1] = 0; tokw[m * 2] = 0.f; tokw[m * 2 + 1] = 0.f; toks[m * 2] = 0; toks[m * 2 + 1] = 0; }
            else {
                volatile LAS float* r0 = S + ((ti * 2) * 16 + C.lane) * 48; volatile LAS float* r1 = r0 + 16 * 48;
                float best = r0[0] + r1[0] + brg[0]; int gtp = 0; float lg[4]; lg[0] = best;
#pragma unroll
                for (int j = 1; j < 4; ++j) { lg[j] = r0[j] + r1[j] + brg[j]; if (lg[j] > best) { best = lg[j]; gtp = j; } }
                float den = 0.f;
#pragma unroll
                for (int j = 0; j < 4; ++j) den += __expf(lg[j] - best);
                const float ptop = 1.0f / den;
                float v0 = -3.0e38f, v1 = -3.0e38f; int e0 = 0, e1 = 0;
                for (int j = 0; j < 8; ++j) { const float le = r0[4 + gtp * 8 + j] + r1[4 + gtp * 8 + j] + bre[gtp * 8 + j]; if (le > v0) { v0 = le; e0 = j; } }
                for (int j = 0; j < 8; ++j) { const float le = r0[4 + gtp * 8 + j] + r1[4 + gtp * 8 + j] + bre[gtp * 8 + j]; if (j != e0 && le > v1) { v1 = le; e1 = j; } }
                const float x = __expf(v1 - v0), w0 = 1.0f / (1.0f + x), w1 = x / (1.0f + x);
                ea = gtp * 8 + e0; eb = gtp * 8 + e1;
                toke[m * 2] = ea; toke[m * 2 + 1] = eb; tokw[m * 2] = ptop * w0; tokw[m * 2 + 1] = ptop * w1;
                la = atomicAdd((int*)(C.lds + 32768) + ea, 1); lb = atomicAdd((int*)(C.lds + 32768) + eb, 1);
            }
        }
        __syncthreads();
        if (C.tid < 32) { const int n = LC[C.tid]; LC[32 + C.tid] = n ? (int)atomicAdd(cnt + C.tid, (unsigned)n) : 0; }
        __syncthreads();
        if (ea >= 0) { const int sa = LC[32 + ea] + la, sb_ = LC[32 + eb] + lb; toks[m * 2] = sa; toks[m * 2 + 1] = sb_;
            int* liste = (int*)(p->ws + WS_LISTE); liste[ea * MROWS + sa] = m * 2; liste[eb * MROWS + sb_] = m * 2 + 1; }
        __syncthreads();
    }
}
__device__ __forceinline__ void ph_permute(const Ctx& C0, KP p, int L) {
    const Ctx C = refresh(C0);
    unsigned* cnt = (unsigned*)(p->ws + WS_CTL) + CW_CNT + L * 32;
    const int* toke = (const int*)(p->ws + WS_TOKE); const float* tokw = (const float*)(p->ws + WS_TOKW); int* toks = (int*)(p->ws + WS_TOKS);
    const bf16_t* HB = (const bf16_t*)(p->ws + WS_HB); bf16_t* XS = (bf16_t*)(p->ws + WS_XS); float* XW = (float*)(p->ws + WS_XW);
    int c = (C.lane < 32) ? (int)xb_ld(cnt + C.lane) : 0;
    int incl = c;
#pragma unroll
    for (int o = 1; o < 32; o <<= 1) { const int t = __shfl_up(incl, o); if (C.lane >= o) incl += t; }
    const int excl = incl - c;
    for (int m = C.gw; m < MROWS; m += C.ngw) {
        if (!row_valid(m)) continue;
        const int e0 = toke[m * 2], e1 = toke[m * 2 + 1];
        const int p0 = __shfl(excl, e0) + toks[m * 2], p1 = __shfl(excl, e1) + toks[m * 2 + 1];
        const v4u* src = (const v4u*)(HB + (size_t)m * D); v4u* d0 = (v4u*)(XS + (size_t)p0 * D); v4u* d1 = (v4u*)(XS + (size_t)p1 * D);
#pragma unroll
        for (int j = 0; j < 4; ++j) { const v4u x = src[C.lane + 64 * j]; d0[C.lane + 64 * j] = x; d1[C.lane + 64 * j] = x; }
        if (C.lane == 0) { XW[p0] = tokw[m * 2]; XW[p1] = tokw[m * 2 + 1]; }
        asm volatile("s_waitcnt vmcnt(0)" ::: "memory");
        if (C.lane == 0) { toks[m * 2] = p0; toks[m * 2 + 1] = p1; }
    }
}
__device__ __forceinline__ void ph_ln2(const Ctx& C0, KP p, int L) {
    const Ctx C = refresh(C0);
    const float* g = p->in[39] + L * D; const float* b = p->in[40] + L * D;
    float* out = (L == 1) ? p->out : nullptr;
    unsigned* cnt = (unsigned*)(p->ws + WS_CTL) + CW_CNT + L * 32;
    const int* toke = (const int*)(p->ws + WS_TOKE); const int* toks = (const int*)(p->ws + WS_TOKS);
    int c = (C.lane < 32) ? (int)xb_ld(cnt + C.lane) : 0;
    int incl = c;
#pragma unroll
    for (int o = 1; o < 32; o <<= 1) { const int t = __shfl_up(incl, o); if (C.lane >= o) incl += t; }
    const int excl = incl - c;
    for (int m = C.gw; m < MP; m += C.ngw) {
        int p0 = 0, p1 = 0;
        if (row_valid(m)) { const int e0 = toke[m * 2], e1 = toke[m * 2 + 1]; p0 = __shfl(excl, e0) + toks[m * 2]; p1 = __shfl(excl, e1) + toks[m * 2 + 1]; }
        ln_row<1>(p, m, g, b, out, C.lane, p0, p1);
    }
}
constexpr int NPHASES = 23;
typedef short bf16x4 __attribute__((ext_vector_type(4)));
#define LDSW() asm volatile("s_waitcnt lgkmcnt(0)" ::: "memory")
#define LBAR() do { asm volatile("s_waitcnt lgkmcnt(0)" ::: "memory"); __builtin_amdgcn_s_barrier(); asm volatile("" ::: "memory"); } while (0)
__device__ __forceinline__ f32x4 mmaT(bf16x8 a_rows_m, bf16x8 b_rows_n, f32x4 acc) {
    return __builtin_amdgcn_mfma_f32_16x16x32_bf16(b_rows_n, a_rows_m, acc, 0, 0, 0);
}
__device__ __forceinline__ float bflo(unsigned w) { return __uint_as_float(w << 16); }
__device__ __forceinline__ float bfhi(unsigned w) { return __uint_as_float(w & 0xffff0000u); }
__device__ __forceinline__ int chunk_row0(int c) { return (c / NCH) * LP + (c % NCH) * CHUNK; }

template <bool FINAL> __device__ __forceinline__ void ph_s5(const Ctx& C0, KP p) {
    const Ctx C = refresh(C0);
    const int lane = C.lane, fr = lane & 15, fq = lane >> 4;
    LAS float* bre_l = (LAS float*)(C.lds + C.wave * 16384); LAS float* bim_l = bre_l + 16 * 68; LAS bf16_t* Sb = (LAS bf16_t*)(bim_l + 16 * 68);
    const float* Cc = (const float*)(p->ws + WS_S5C); const bf16_t* Bb = (const bf16_t*)(p->ws + WS_S5B);
    const bf16_t* P = (const bf16_t*)(p->ws + WS_P); bf16_t* Z = (bf16_t*)(p->ws + WS_Z); float* X = (float*)(p->ws + WS_S5X);
    const bf16x8 zero8 = {0, 0, 0, 0, 0, 0, 0, 0};
    const int NIT = BATCH * NCH * S5G;
    int gcur = -1; float ar = 0.f, ai = 0.f; bf16x8 bfr[4], bfi[4], cm[4]; f32x4 dd = {0.f, 0.f, 0.f, 0.f};
#pragma unroll
    for (int q = 0; q < 4; ++q) { bfr[q] = zero8; bfi[q] = zero8; cm[q] = zero8; }
    bf16x8 a[4], an[4]; uint2 uu[4], un[4]; float2 x0 = make_float2(0.f, 0.f), xn = make_float2(0.f, 0.f);
#define S5_LOAD(it_, a_, u_, x_) do { const int c_ = (it_) / S5G, g_ = (it_) % S5G, m0_ = chunk_row0(c_); \
        _Pragma("unroll") for (int sub = 0; sub < 4; ++sub) { const bf16_t* urow = P + (size_t)(m0_ + sub * 16 + fr) * NP0 + P0_U + g_ * 16; \
            a_[sub] = (lane < 32) ? *(const bf16x8*)(urow + 8 * fq) : zero8; if (FINAL) u_[sub] = *(const uint2*)(urow + 4 * fq); } \
        if (FINAL) x_ = *(const float2*)(X + ((size_t)(c_ * S5G + g_) * 64 + lane) * 2); } while (0)
    if (C.gw < NIT) S5_LOAD(C.gw, an, un, xn);
    for (int it = C.gw; it < NIT; it += C.ngw) {
        const int c = it / S5G, g = it % S5G, m0 = chunk_row0(c);
#pragma unroll
        for (int sub = 0; sub < 4; ++sub) { a[sub] = an[sub]; uu[sub] = un[sub]; }
        x0 = xn;
        if (it + C.ngw < NIT) S5_LOAD(it + C.ngw, an, un, xn);
        if (g != gcur) { gcur = g;
            ar = Cc[S5C_ABAR + 2 * (g * 64 + lane)]; ai = Cc[S5C_ABAR + 2 * (g * 64 + lane) + 1];
#pragma unroll
            for (int nt = 0; nt < 4; ++nt) { bfr[nt] = (lane < 32) ? *(const bf16x8*)(Bb + S5B_BR + (size_t)(g * 64 + nt * 16 + fr) * 16 + 8 * fq) : zero8;
                                             bfi[nt] = (lane < 32) ? *(const bf16x8*)(Bb + S5B_BI + (size_t)(g * 64 + nt * 16 + fr) * 16 + 8 * fq) : zero8; }
            if (FINAL) {
#pragma unroll
                for (int ks = 0; ks < 4; ++ks) cm[ks] = *(const bf16x8*)(Bb + S5B_CM + (size_t)(g * 16 + fr) * 128 + 32 * ks + 8 * fq);
                dd = *(const f32x4*)(p->in[10] + g * 16 + 4 * fq); } }
        float sr = FINAL ? x0.x : 0.f, si = FINAL ? x0.y : 0.f;
#pragma unroll
        for (int sub = 0; sub < 4; ++sub) {
#pragma unroll
            for (int nt = 0; nt < 4; ++nt) { const f32x4 z4 = {0.f, 0.f, 0.f, 0.f};
                const f32x4 r = mmaT(a[sub], bfr[nt], z4), im = mmaT(a[sub], bfi[nt], z4);
                *(LAS f32x4*)(bre_l + fr * 68 + nt * 16 + 4 * fq) = r; *(LAS f32x4*)(bim_l + fr * 68 + nt * 16 + 4 * fq) = im; }
            LDSW();
            float brv[16], biv[16];
#pragma unroll
            for (int t = 0; t < 16; ++t) { brv[t] = bre_l[t * 68 + lane]; biv[t] = bim_l[t * 68 + lane]; }
#pragma unroll
            for (int t = 0; t < 16; ++t) { const float nr = ar * sr - ai * si + brv[t], ni = ar * si + ai * sr + biv[t]; sr = nr; si = ni;
                if (FINAL) { Sb[t * 136 + lane] = (bf16_t)f2bf(sr); Sb[t * 136 + 64 + lane] = (bf16_t)f2bf(si); } }
            if (FINAL) {
                LDSW();
                f32x4 y = {0.f, 0.f, 0.f, 0.f};
#pragma unroll
                for (int ks = 0; ks < 4; ++ks) { const bf16x8 sa = *(const LAS bf16x8*)(Sb + fr * 136 + 32 * ks + 8 * fq); y = mmaT(sa, cm[ks], y); }
                const float z0 = gelu_tanh(y[0] + dd[0] * bflo(uu[sub].x)), z1 = gelu_tanh(y[1] + dd[1] * bfhi(uu[sub].x)), z2 = gelu_tanh(y[2] + dd[2] * bflo(uu[sub].y)), z3 = gelu_tanh(y[3] + dd[3] * bfhi(uu[sub].y));
                *(uint2*)(Z + (size_t)(m0 + sub * 16 + fr) * S5W + g * 16 + 4 * fq) = make_uint2(pk2(z0, z1), pk2(z2, z3));
            }
            LDSW();
        }
        if (!FINAL) *(float2*)(X + ((size_t)(c * S5G + g) * 64 + lane) * 2) = make_float2(sr, si);
    }
#undef S5_LOAD
}
__device__ __forceinline__ void ph_s5_carry(const Ctx& C0, KP p) {
    const Ctx C = refresh(C0);
    const int gt = C.vcu * NTHREADS + C.tid;
    if (gt >= BATCH * S5G * S5P) return;
    const float* Cc = (const float*)(p->ws + WS_S5C); float* X = (float*)(p->ws + WS_S5X);
    const int b = gt / (S5G * S5P), gp = gt % (S5G * S5P);
    float ar = Cc[S5C_ABAR + 2 * gp], ai = Cc[S5C_ABAR + 2 * gp + 1];
#pragma unroll
    for (int i = 0; i < 6; ++i) { const float nr = ar * ar - ai * ai, ni = 2.f * ar * ai; ar = nr; ai = ni; }
    float xr = 0.f, xi = 0.f;
    float2* base = (float2*)X + (size_t)b * NCH * (S5G * S5P) + gp;
    for (int n0 = 0; n0 < NCH; n0 += 8) {
        float2 f[8];
#pragma unroll
        for (int j = 0; j < 8; ++j) f[j] = (n0 + j < NCH) ? base[(size_t)(n0 + j) * (S5G * S5P)] : make_float2(0.f, 0.f);
#pragma unroll
        for (int j = 0; j < 8; ++j) if (n0 + j < NCH) { base[(size_t)(n0 + j) * (S5G * S5P)] = make_float2(xr, xi);
            const float nr = ar * xr - ai * xi + f[j].x, ni = ar * xi + ai * xr + f[j].y; xr = nr; xi = ni; }
    }
}

constexpr int LFS = 129;
constexpr int GLA_LF = 0, GLA_TOT = 64 * LFS * 4, GLA_A_KST = GLA_TOT + 2048 + 4096, GLA_A_VT = GLA_A_KST + 128 * 72 * 2, GLA_A_END = GLA_A_VT + 256 * 72 * 2;
constexpr int GLA_C_QI = GLA_TOT + 2048 + 4096, GLA_C_KI = GLA_C_QI + 64 * 136 * 2, GLA_C_ATT = GLA_C_KI + 64 * 136 * 2, GLA_C_VT = GLA_C_ATT + 64 * 72 * 2, GLA_C_RED = GLA_C_VT + 256 * 72 * 2, GLA_C_END = GLA_C_RED + 64 * 8 * 4;
static_assert(GLA_C_END <= RING_BYTES && GLA_A_END <= RING_BYTES, "GLA LDS");
__device__ __forceinline__ void gla_bcum(const Ctx& C, KP p, int m0, int h, LAS float* LF, LAS float* TOT) {
    const int t = C.tid, d = t & 127, qd = t >> 7;
    const float* SK = (const float*)(p->ws + WS_SK); const float* wg = p->in[13];
    LAS float* SKL = TOT + 512;
    if (t < 256) *(LAS f32x4*)(SKL + t * 4) = *(const f32x4*)(SK + (size_t)m0 * 16 + t * 4);
    float wgc[16];
#pragma unroll
    for (int j = 0; j < 16; ++j) wgc[j] = wg[j * 512 + h * 128 + d];
    const float bgc = p->in[14][h * 128 + d];
    __syncthreads();
    float run = 0.f;
#pragma unroll 4
    for (int i = 0; i < 16; ++i) { const int tok = 16 * qd + i, m = m0 + tok;
        float lg = bgc;
#pragma unroll
        for (int q = 0; q < 4; ++q) { const f32x4 s4 = *(const LAS f32x4*)(SKL + tok * 16 + 4 * q); lg += s4[0] * wgc[4 * q] + s4[1] * wgc[4 * q + 1] + s4[2] * wgc[4 * q + 2] + s4[3] * wgc[4 * q + 3]; }
        const float lsg = fminf(lg, 0.f) - __logf(1.0f + __expf(-fabsf(lg)));
        const float lf = ((m % LP) >= PADF) ? lsg * (1.0f / 16.0f) : 0.f;
        run += lf; LF[tok * LFS + d] = run; }
    TOT[qd * 128 + d] = run;
    __syncthreads();
    float off = 0.f;
#pragma unroll
    for (int q = 0; q < 3; ++q) off += (q < qd) ? TOT[q * 128 + d] : 0.f;
    if (qd > 0) {
#pragma unroll 4
        for (int i = 0; i < 16; ++i) LF[(16 * qd + i) * LFS + d] += off; }
    __syncthreads();
}
__device__ __forceinline__ void stage_transposed(const Ctx& C, const bf16_t* src  , int ld, int ncols, LAS bf16_t* T) {
    for (int cg = C.wave; cg < ncols / 8; cg += NWAVES) {
        const v4u x = *(const v4u*)(src + (size_t)C.lane * ld + cg * 8);
        const unsigned w[4] = {x.x, x.y, x.z, x.w};
#pragma unroll
        for (int q = 0; q < 4; ++q) { T[(cg * 8 + 2 * q) * 72 + C.lane] = (bf16_t)(w[q] & 0xffffu); T[(cg * 8 + 2 * q + 1) * 72 + C.lane] = (bf16_t)(w[q] >> 16); }
    }
}
__device__ __forceinline__ void ph_gla_a(const Ctx& C0, KP p) {
    const Ctx C = refresh(C0);
    const int lane = C.lane, fr = lane & 15, fq = lane >> 4, t = C.tid;
    LAS float* LF = (LAS float*)(C.lds + GLA_LF); LAS float* TOT = (LAS float*)(C.lds + GLA_TOT);
    LAS bf16_t* KSt = (LAS bf16_t*)(C.lds + GLA_A_KST); LAS bf16_t* Vt = (LAS bf16_t*)(C.lds + GLA_A_VT);
    const bf16_t* P = (const bf16_t*)(p->ws + WS_P); bf16_t* KV = (bf16_t*)(p->ws + WS_HB); float* DEC = (float*)(p->ws + WS_GDEC);
    for (int it = C.vcu; it < BATCH * NCH * GLH; it += C.G) {
        const int c = it / GLH, h = it % GLH, m0 = chunk_row0(c);
        v4u xk[2], xv[4];
#pragma unroll
        for (int i = 0; i < 2; ++i) xk[i] = *(const v4u*)(P + (size_t)(m0 + lane) * NP0 + P0_K + h * 128 + (C.wave + 8 * i) * 8);
#pragma unroll
        for (int i = 0; i < 4; ++i) xv[i] = *(const v4u*)(P + (size_t)(m0 + lane) * NP0 + P0_V + h * 256 + (C.wave + 8 * i) * 8);
        __syncthreads();
        gla_bcum(C, p, m0, h, LF, TOT);
#pragma unroll
        for (int i = 0; i < 2; ++i) { const int cg = C.wave + 8 * i;
            const unsigned w[4] = {xk[i].x, xk[i].y, xk[i].z, xk[i].w};
#pragma unroll
            for (int q = 0; q < 4; ++q) { const int d0 = cg * 8 + 2 * q;
                const float bl0 = LF[63 * LFS + d0], bl1 = LF[63 * LFS + d0 + 1];
                KSt[d0 * 72 + lane] = (bf16_t)f2bf(bflo(w[q]) * __expf(bl0 - LF[lane * LFS + d0]));
                KSt[(d0 + 1) * 72 + lane] = (bf16_t)f2bf(bfhi(w[q]) * __expf(bl1 - LF[lane * LFS + d0 + 1])); }
        }
#pragma unroll
        for (int i = 0; i < 4; ++i) { const int cg = C.wave + 8 * i; const unsigned w[4] = {xv[i].x, xv[i].y, xv[i].z, xv[i].w};
#pragma unroll
            for (int q = 0; q < 4; ++q) { Vt[(cg * 8 + 2 * q) * 72 + lane] = (bf16_t)(w[q] & 0xffffu); Vt[(cg * 8 + 2 * q + 1) * 72 + lane] = (bf16_t)(w[q] >> 16); } }
        if (t < 128) DEC[(size_t)it * 128 + t] = __expf(LF[63 * LFS + t]);
        __syncthreads();
        bf16x8 af[2][2];
#pragma unroll
        for (int mt = 0; mt < 2; ++mt)
#pragma unroll
            for (int ks = 0; ks < 2; ++ks) af[mt][ks] = *(const LAS bf16x8*)(Vt + ((2 * C.wave + mt) * 16 + fr) * 72 + 32 * ks + 8 * fq);
        bf16_t* kvo = KV + (size_t)it * 256 * 128;
#pragma unroll
        for (int nt = 0; nt < 8; ++nt) {
            const bf16x8 b0 = *(const LAS bf16x8*)(KSt + (nt * 16 + fr) * 72 + 8 * fq), b1 = *(const LAS bf16x8*)(KSt + (nt * 16 + fr) * 72 + 32 + 8 * fq);
#pragma unroll
            for (int mt = 0; mt < 2; ++mt) { f32x4 acc = {0.f, 0.f, 0.f, 0.f}; acc = mmaT(af[mt][0], b0, acc); acc = mmaT(af[mt][1], b1, acc);
                *(uint2*)(kvo + (size_t)((2 * C.wave + mt) * 16 + fr) * 128 + nt * 16 + 4 * fq) = make_uint2(pk2(acc[0], acc[1]), pk2(acc[2], acc[3])); }
        }
    }
}
__device__ __forceinline__ void ph_gla_b(const Ctx& C0, KP p) {
    const Ctx C = refresh(C0);
    bf16_t* KV = (bf16_t*)(p->ws + WS_HB); const float* DEC = (const float*)(p->ws + WS_GDEC);
    for (int gt = C.vcu * NTHREADS + C.tid; gt < BATCH * GLH * 256 * 64; gt += C.G * NTHREADS) {
        const int bh = gt / (256 * 64), rem = gt % (256 * 64), e = rem / 64, d = (rem % 64) * 2, b = bh / GLH, h = bh % GLH;
        float s0 = 0.f, s1 = 0.f;
        for (int n0 = 0; n0 < NCH; n0 += 8) {
            unsigned kv[8]; float2 dc[8];
#pragma unroll
            for (int j = 0; j < 8; ++j) { const int n = (n0 + j < NCH) ? n0 + j : NCH - 1; const size_t ch = (size_t)(b * NCH + n) * GLH + h;
                kv[j] = *(const unsigned*)(KV + (ch * 256 + e) * 128 + d); dc[j] = *(const float2*)(DEC + ch * 128 + d); }
#pragma unroll
            for (int j = 0; j < 8; ++j) if (n0 + j < NCH) { const size_t ch = (size_t)(b * NCH + n0 + j) * GLH + h;
                *(unsigned*)(KV + (ch * 256 + e) * 128 + d) = pk2(s0, s1);
                s0 = s0 * dc[j].x + bflo(kv[j]); s1 = s1 * dc[j].y + bfhi(kv[j]); }
        }
    }
}
__device__ __forceinline__ void ph_gla_c(const Ctx& C0, KP p) {
    const Ctx C = refresh(C0);
    const int lane = C.lane, fr = lane & 15, fq = lane >> 4;
    LAS float* LF = (LAS float*)(C.lds + GLA_LF); LAS float* TOT = (LAS float*)(C.lds + GLA_TOT);
    LAS bf16_t* Qi = (LAS bf16_t*)(C.lds + GLA_C_QI); LAS bf16_t* Ki = (LAS bf16_t*)(C.lds + GLA_C_KI); LAS bf16_t* ATT = (LAS bf16_t*)(C.lds + GLA_C_ATT);
    LAS bf16_t* Vt = (LAS bf16_t*)(C.lds + GLA_C_VT); LAS float* RED = (LAS float*)(C.lds + GLA_C_RED);
    const bf16_t* P = (const bf16_t*)(p->ws + WS_P); const bf16_t* KV = (const bf16_t*)(p->ws + WS_HB); bf16_t* Y = (bf16_t*)(p->ws + WS_Y);
    for (int it = C.vcu; it < BATCH * NCH * GLH; it += C.G) {
        const int c = it / GLH, h = it % GLH, m0 = chunk_row0(c);
        v4u xq[2], xk[2], xv[4]; bf16x8 sbf[4][2]; uint2 rr[4][2];
        const bf16_t* Sn = KV + (size_t)it * 256 * 128;
#pragma unroll
        for (int i = 0; i < 2; ++i) { const int idx = C.tid + NTHREADS * i, tok = idx >> 4, cg = idx & 15;
            xq[i] = *(const v4u*)(P + (size_t)(m0 + tok) * NP0 + P0_Q + h * 128 + cg * 8); xk[i] = *(const v4u*)(P + (size_t)(m0 + tok) * NP0 + P0_K + h * 128 + cg * 8); }
#pragma unroll
        for (int i = 0; i < 4; ++i) xv[i] = *(const v4u*)(P + (size_t)(m0 + lane) * NP0 + P0_V + h * 256 + (C.wave + 8 * i) * 8);
#pragma unroll
        for (int ks = 0; ks < 4; ++ks)
#pragma unroll
            for (int et = 0; et < 2; ++et) sbf[ks][et] = *(const bf16x8*)(Sn + (size_t)((2 * C.wave + et) * 16 + fr) * 128 + 32 * ks + 8 * fq);
#pragma unroll
        for (int mt = 0; mt < 4; ++mt)
#pragma unroll
            for (int et = 0; et < 2; ++et) rr[mt][et] = *(const uint2*)(P + (size_t)(m0 + mt * 16 + fr) * NP0 + P0_R + h * 256 + (2 * C.wave + et) * 16 + 4 * fq);
        __syncthreads();
        gla_bcum(C, p, m0, h, LF, TOT);
#pragma unroll
        for (int i = 0; i < 2; ++i) { const int idx = C.tid + NTHREADS * i, tok = idx >> 4, cg = idx & 15;
            const unsigned wq[4] = {xq[i].x, xq[i].y, xq[i].z, xq[i].w}, wk[4] = {xk[i].x, xk[i].y, xk[i].z, xk[i].w}; unsigned oq[4], ok[4];
#pragma unroll
            for (int q = 0; q < 4; ++q) { const float b0 = LF[tok * LFS + cg * 8 + 2 * q], b1 = LF[tok * LFS + cg * 8 + 2 * q + 1];
                const float e0 = __expf(b0), e1 = __expf(b1);
                oq[q] = pk2(bflo(wq[q]) * 0.08838834764831845f * e0, bfhi(wq[q]) * 0.08838834764831845f * e1);
                ok[q] = pk2(bflo(wk[q]) * rcpf_(e0), bfhi(wk[q]) * rcpf_(e1)); }
            *(LAS v4u*)(Qi + tok * 136 + cg * 8) = (v4u){oq[0], oq[1], oq[2], oq[3]}; *(LAS v4u*)(Ki + tok * 136 + cg * 8) = (v4u){ok[0], ok[1], ok[2], ok[3]}; }
#pragma unroll
        for (int i = 0; i < 4; ++i) { const int cg = C.wave + 8 * i; const unsigned w[4] = {xv[i].x, xv[i].y, xv[i].z, xv[i].w};
#pragma unroll
            for (int q = 0; q < 4; ++q) { Vt[(cg * 8 + 2 * q) * 72 + lane] = (bf16_t)(w[q] & 0xffffu); Vt[(cg * 8 + 2 * q + 1) * 72 + lane] = (bf16_t)(w[q] >> 16); } }
        __syncthreads();
        {
            const int mt = C.wave >> 1;
            bf16x8 qa[4];
#pragma unroll
            for (int ks = 0; ks < 4; ++ks) qa[ks] = *(const LAS bf16x8*)(Qi + (mt * 16 + fr) * 136 + 32 * ks + 8 * fq);
#pragma unroll
            for (int j = 0; j < 2; ++j) { const int nt = 2 * (C.wave & 1) + j; f32x4 acc = {0.f, 0.f, 0.f, 0.f};
#pragma unroll
                for (int ks = 0; ks < 4; ++ks) acc = mmaT(qa[ks], *(const LAS bf16x8*)(Ki + (nt * 16 + fr) * 136 + 32 * ks + 8 * fq), acc);
                const int cc = mt * 16 + fr, s0 = nt * 16 + 4 * fq;
                const float a0 = (s0 <= cc) ? acc[0] : 0.f, a1 = (s0 + 1 <= cc) ? acc[1] : 0.f, a2 = (s0 + 2 <= cc) ? acc[2] : 0.f, a3 = (s0 + 3 <= cc) ? acc[3] : 0.f;
                *(LAS v2u*)(ATT + cc * 72 + s0) = (v2u){pk2(a0, a1), pk2(a2, a3)}; }
        }
        __syncthreads();
        f32x4 o[4][2];
#pragma unroll
        for (int mt = 0; mt < 4; ++mt)
#pragma unroll
            for (int et = 0; et < 2; ++et) o[mt][et] = (f32x4){0.f, 0.f, 0.f, 0.f};
#pragma unroll
        for (int ks = 0; ks < 2; ++ks) { bf16x8 vb[2];
#pragma unroll
            for (int et = 0; et < 2; ++et) vb[et] = *(const LAS bf16x8*)(Vt + ((2 * C.wave + et) * 16 + fr) * 72 + 32 * ks + 8 * fq);
#pragma unroll
            for (int mt = 0; mt < 4; ++mt) { const bf16x8 aa = *(const LAS bf16x8*)(ATT + (mt * 16 + fr) * 72 + 32 * ks + 8 * fq);
#pragma unroll
                for (int et = 0; et < 2; ++et) o[mt][et] = mmaT(aa, vb[et], o[mt][et]); } }
#pragma unroll
        for (int ks = 0; ks < 4; ++ks) {
#pragma unroll
            for (int mt = 0; mt < 4; ++mt) { const bf16x8 qa = *(const LAS bf16x8*)(Qi + (mt * 16 + fr) * 136 + 32 * ks + 8 * fq);
#pragma unroll
                for (int et = 0; et < 2; ++et) o[mt][et] = mmaT(qa, sbf[ks][et], o[mt][et]); } }
#pragma unroll
        for (int mt = 0; mt < 4; ++mt) { float s = 0.f;
#pragma unroll
            for (int et = 0; et < 2; ++et) s += (o[mt][et][0] * o[mt][et][0] + o[mt][et][1] * o[mt][et][1]) + (o[mt][et][2] * o[mt][et][2] + o[mt][et][3] * o[mt][et][3]);
            s += __shfl_xor(s, 16); s += __shfl_xor(s, 32);
            if (fq == 0) RED[(mt * 16 + fr) * 8 + C.wave] = s; }
        __syncthreads();
#pragma unroll
        for (int mt = 0; mt < 4; ++mt) { const int cc = mt * 16 + fr; float s = 0.f;
#pragma unroll
            for (int w = 0; w < 8; ++w) s += RED[cc * 8 + w];
            const float rs = rsqrtf(s * (1.0f / 256.0f) + NORM_EPS);
#pragma unroll
            for (int et = 0; et < 2; ++et) { const int e = (2 * C.wave + et) * 16 + 4 * fq; const f32x4 ng = *(const f32x4*)(p->in[15] + e);
                const uint2 rg = rr[mt][et];
                const float y0 = o[mt][et][0] * rs * ng[0] * siluf_(bflo(rg.x)), y1 = o[mt][et][1] * rs * ng[1] * siluf_(bfhi(rg.x)), y2 = o[mt][et][2] * rs * ng[2] * siluf_(bflo(rg.y)), y3 = o[mt][et][3] * rs * ng[3] * siluf_(bfhi(rg.y));
                *(uint2*)(Y + (size_t)(m0 + cc) * D + 1024 + h * 256 + e) = make_uint2(pk2(y0, y1), pk2(y2, y3)); } }
    }
}
constexpr int XST = 129;
constexpr int LRU_XCF = 0, LRU_XCB = LRU_XCF + 64 * XST * 4, LRU_AL = LRU_XCB + 64 * 136 * 2, LRU_BL = LRU_AL + 64 * XST * 4, LRU_QT = LRU_BL + 64 * XST * 4, LRU_VAL = LRU_QT + 4096, LRU_END = LRU_VAL + 256;
static_assert(LRU_END <= RING_BYTES, "LRU LDS");
struct LruW { bf16x8 ba[4], bx[4]; int hb; };
template <bool FINAL> __device__ __forceinline__ void lru_item(const Ctx& C, KP p, int it, LruW& W) {
    const int lane = C.lane, fr = lane & 15, fq = lane >> 4, t = C.tid;
    LAS float* XCF = (LAS float*)(C.lds + LRU_XCF); LAS bf16_t* XCB = (LAS bf16_t*)(C.lds + LRU_XCB); LAS float* AL = (LAS float*)(C.lds + LRU_AL); LAS float* BL = (LAS float*)(C.lds + LRU_BL);
    LAS float* QT = (LAS float*)(C.lds + LRU_QT); LAS float* VAL = (LAS float*)(C.lds + LRU_VAL);
    const bf16_t* P = (const bf16_t*)(p->ws + WS_P); bf16_t* Y = (bf16_t*)(p->ws + WS_Y); float* F = (float*)(p->ws + WS_LRUF);
    const bf16_t* WA = (const bf16_t*)(p->ws + WS_WLRU); const bf16_t* WX = WA + (size_t)LRB * 128 * 128;
    const int c = it / LRB, hb = it % LRB, m0 = chunk_row0(c);
    const int j = t & 127, qd = t >> 7, ch = hb * 128 + j;
    float hq = 0.f; if (FINAL) hq = F[((size_t)c * LRW + ch) * 2];
    bf16_t gate[16];
    if (FINAL) {
#pragma unroll
        for (int i = 0; i < 16; ++i) gate[i] = P[(size_t)(m0 + 16 * qd + i) * NP1 + P1_LG + ch]; }
    if (hb != W.hb) { W.hb = hb;
#pragma unroll
        for (int ks = 0; ks < 4; ++ks) { W.ba[ks] = *(const bf16x8*)(WA + ((size_t)hb * 128 + C.wave * 16 + fr) * 128 + 32 * ks + 8 * fq); W.bx[ks] = *(const bf16x8*)(WX + ((size_t)hb * 128 + C.wave * 16 + fr) * 128 + 32 * ks + 8 * fq); } }
    __syncthreads();
    for (int i = t; i < 64 * 16; i += NTHREADS) { const int tok = i >> 4, cg = i & 15, m = m0 + tok, chc = hb * 128 + cg * 8;
        float xc[8];
#pragma unroll
        for (int q = 0; q < 8; ++q) xc[q] = p->in[23][chc + q];
#pragma unroll
        for (int tt = 0; tt < 4; ++tt) { const int mm = m - 3 + tt; v4u x = {0u, 0u, 0u, 0u}; if (mm >= 0) x = *(const v4u*)(P + (size_t)mm * NP1 + P1_LX + chc);
            const f32x4 w0 = *(const f32x4*)(p->in[22] + tt * LRW + chc), w1 = *(const f32x4*)(p->in[22] + tt * LRW + chc + 4);
            xc[0] += w0[0] * bflo(x.x); xc[1] += w0[1] * bfhi(x.x); xc[2] += w0[2] * bflo(x.y); xc[3] += w0[3] * bfhi(x.y);
            xc[4] += w1[0] * bflo(x.z); xc[5] += w1[1] * bfhi(x.z); xc[6] += w1[2] * bflo(x.w); xc[7] += w1[3] * bfhi(x.w); }
#pragma unroll
        for (int q = 0; q < 8; ++q) XCF[tok * XST + cg * 8 + q] = xc[q];
        *(LAS v4u*)(XCB + tok * 136 + cg * 8) = (v4u){pk2(xc[0], xc[1]), pk2(xc[2], xc[3]), pk2(xc[4], xc[5]), pk2(xc[6], xc[7])}; }
    if (t < 64) VAL[t] = (((m0 + t) % LP) >= PADF) ? 1.0f : 0.0f;
    __syncthreads();
    {
        f32x4 ra[4], ri[4];
#pragma unroll
        for (int mt = 0; mt < 4; ++mt) { ra[mt] = (f32x4){0.f, 0.f, 0.f, 0.f}; ri[mt] = (f32x4){0.f, 0.f, 0.f, 0.f}; }
#pragma unroll
        for (int ks = 0; ks < 4; ++ks) {
#pragma unroll
            for (int mt = 0; mt < 4; ++mt) { const bf16x8 a = *(const LAS bf16x8*)(XCB + (mt * 16 + fr) * 136 + 32 * ks + 8 * fq); ra[mt] = mmaT(a, W.ba[ks], ra[mt]); ri[mt] = mmaT(a, W.bx[ks], ri[mt]); } }
        const int j0 = C.wave * 16 + 4 * fq, ch0 = hb * 128 + j0;
        const f32x4 b_a = *(const f32x4*)(p->in[25] + ch0), b_x = *(const f32x4*)(p->in[27] + ch0), lam = *(const f32x4*)(p->in[28] + ch0);
#pragma unroll
        for (int mt = 0; mt < 4; ++mt) { const int tok = mt * 16 + fr; const float vv = VAL[tok];
#pragma unroll
            for (int i = 0; i < 4; ++i) { const float r = sigmoidf_(ra[mt][i] + b_a[i]), ig = sigmoidf_(ri[mt][i] + b_x[i]);
                const float la = -8.0f * softplusf_(-lam[i]) * r;
                AL[tok * XST + j0 + i] = __expf(la); BL[tok * XST + j0 + i] = vv * sqrtf(neg_expm1f_(2.0f * la)) * (ig * XCF[tok * XST + j0 + i]); } }
    }
    __syncthreads();
    { float av[16], bv[16];
#pragma unroll
        for (int i = 0; i < 16; ++i) { av[i] = AL[(16 * qd + i) * XST + j]; bv[i] = BL[(16 * qd + i) * XST + j]; }
        float A = 1.f, h = 0.f;
#pragma unroll
        for (int i = 0; i < 16; ++i) { h = av[i] * h + bv[i]; A *= av[i]; av[i] = A; bv[i] = h; }
        QT[(qd * 128 + j) * 2] = A; QT[(qd * 128 + j) * 2 + 1] = h;
        __syncthreads();
        float Atot = 1.f;
#pragma unroll
        for (int q = 0; q < 4; ++q) { const float Aq = QT[(q * 128 + j) * 2], hh = QT[(q * 128 + j) * 2 + 1]; if (q < qd) hq = Aq * hq + hh; Atot *= Aq; }
        if (!FINAL) { if (qd == 3) { const float A3 = QT[(3 * 128 + j) * 2], h3 = QT[(3 * 128 + j) * 2 + 1]; *(float2*)(F + ((size_t)c * LRW + ch) * 2) = make_float2(Atot, A3 * hq + h3); } }
        else {
#pragma unroll
            for (int i = 0; i < 16; ++i) { const size_t m = (size_t)(m0 + 16 * qd + i);
                Y[m * D + 1024 + ch] = (bf16_t)f2bf((bv[i] + av[i] * hq) * gelu_tanh(bf2f(gate[i]))); }
        }
    }
}
__device__ __forceinline__ void ph_lru_carry(const Ctx& C0, KP p) {
    const Ctx C = refresh(C0);
    const int gt = C.vcu * NTHREADS + C.tid;
    if (gt >= BATCH * LRW) return;
    const int b = gt / LRW, ch = gt % LRW;
    float2* base = (float2*)(p->ws + WS_LRUF) + (size_t)b * NCH * LRW + ch;
    float carry = 0.f;
    for (int n0 = 0; n0 < NCH; n0 += 8) {
        float2 f[8];
#pragma unroll
        for (int jj = 0; jj < 8; ++jj) f[jj] = (n0 + jj < NCH) ? base[(size_t)(n0 + jj) * LRW] : make_float2(1.f, 0.f);
#pragma unroll
        for (int jj = 0; jj < 8; ++jj) if (n0 + jj < NCH) { base[(size_t)(n0 + jj) * LRW] = make_float2(carry, 0.f); carry = f[jj].x * carry + f[jj].y; }
    }
}

__device__ __forceinline__ void ph_gdn_conv(const Ctx& C0, KP p) {
    const Ctx C = refresh(C0);
    const int lane = C.lane;
    const bf16_t* P = (const bf16_t*)(p->ws + WS_P); bf16_t* HBq = (bf16_t*)(p->ws + WS_HB); bf16_t* Yv = (bf16_t*)(p->ws + WS_Y);
    for (int it = C.gw; it < BATCH * NCH * 2 * 6; it += C.ngw) {
        const int cgp = it % 6, hc = it / 6, r0 = chunk_row0(hc >> 1) + 32 * (hc & 1), col = cgp * 512 + lane * 8;
        float w[4][8];
#pragma unroll
        for (int tt = 0; tt < 4; ++tt) { const f32x4 w0 = *(const f32x4*)(p->in[18] + tt * 3072 + col), w1 = *(const f32x4*)(p->in[18] + tt * 3072 + col + 4);
#pragma unroll
            for (int q = 0; q < 4; ++q) { w[tt][q] = w0[q]; w[tt][4 + q] = w1[q]; } }
        v4u win[4];
#pragma unroll
        for (int tt = 0; tt < 3; ++tt) { const int mm = r0 - 3 + tt; win[tt + 1] = (mm >= 0) ? *(const v4u*)(P + (size_t)mm * NP1 + col) : (v4u){0u, 0u, 0u, 0u}; }
        for (int rb = 0; rb < 32; rb += 8) {
            v4u rows[8];
#pragma unroll
            for (int q = 0; q < 8; ++q) rows[q] = *(const v4u*)(P + (size_t)(r0 + rb + q) * NP1 + col);
#pragma unroll
            for (int q8 = 0; q8 < 8; ++q8) { const int m = r0 + rb + q8;
                win[0] = win[1]; win[1] = win[2]; win[2] = win[3]; win[3] = rows[q8];
                float y[8];
#pragma unroll
                for (int q = 0; q < 8; ++q) y[q] = 0.f;
#pragma unroll
                for (int tt = 0; tt < 4; ++tt) { const v4u x = win[tt];
                    y[0] += w[tt][0] * bflo(x.x); y[1] += w[tt][1] * bfhi(x.x); y[2] += w[tt][2] * bflo(x.y); y[3] += w[tt][3] * bfhi(x.y);
                    y[4] += w[tt][4] * bflo(x.z); y[5] += w[tt][5] * bfhi(x.z); y[6] += w[tt][6] * bflo(x.w); y[7] += w[tt][7] * bfhi(x.w); }
                float ss = 0.f;
#pragma unroll
                for (int q = 0; q < 8; ++q) { y[q] = siluf_(y[q]); ss += y[q] * y[q]; }
                float sc = 1.0f;
                if (cgp < 4) { ss += __shfl_xor(ss, 1); ss += __shfl_xor(ss, 2); ss += __shfl_xor(ss, 4); ss += __shfl_xor(ss, 8);
                    sc = rsqrtf(ss + NORM_EPS) * (cgp < 2 ? 0.08838834764831845f : 1.0f); }
                if ((m % LP) < PADF) sc = 0.f;
                const v4u o = {pk2(y[0] * sc, y[1] * sc), pk2(y[2] * sc, y[3] * sc), pk2(y[4] * sc, y[5] * sc), pk2(y[6] * sc, y[7] * sc)};
                if (cgp < 4) *(v4u*)(HBq + (size_t)m * D + col) = o;
                else *(v4u*)(Yv + (size_t)m * D + (col - 2048)) = o;
            }
        }
    }
}
template <int S4, int N4> __device__ __forceinline__ void tri_inner(float& acc, const float (&x)[64], const LAS float* mrow) {
    if constexpr (S4 < N4) { const f32x4 mm = *(const LAS f32x4*)(mrow + 4 * S4);
        acc -= mm[0] * x[4 * S4]; acc -= mm[1] * x[4 * S4 + 1]; acc -= mm[2] * x[4 * S4 + 2]; acc -= mm[3] * x[4 * S4 + 3];
        tri_inner<S4 + 1, N4>(acc, x, mrow); }
}
template <int CC> __device__ __forceinline__ void tri_rows(float (&x)[64], const LAS float* MM, const LAS float* RHS, int t) {
    if constexpr (CC < 64) { float acc = RHS[CC * 256 + t]; tri_inner<0, (CC + 3) / 4>(acc, x, MM + CC * 68); asm volatile("" : "+v"(acc) :: "memory"); x[CC] = acc;
        tri_rows<CC + 1>(x, MM, RHS, t); }
}
constexpr int GP_KN = 0, GP_QN = GP_KN + 64 * 136 * 2, GP_MM = GP_QN + 64 * 136 * 2, GP_RHS = GP_MM + 64 * 68 * 4, GP_GC = GP_RHS + 64 * 256 * 4, GP_END = GP_GC + 1024;
static_assert(GP_END <= RING_BYTES, "GDN prep LDS");
__device__ __forceinline__ void ph_gdn_prep(const Ctx& C0, KP p) {
    const Ctx C = refresh(C0);
    const int lane = C.lane, fr = lane & 15, fq = lane >> 4, t = C.tid;
    LAS bf16_t* KN = (LAS bf16_t*)(C.lds + GP_KN); LAS bf16_t* QN = (LAS bf16_t*)(C.lds + GP_QN); LAS float* MM = (LAS float*)(C.lds + GP_MM);
    LAS float* RHS = (LAS float*)(C.lds + GP_RHS); LAS float* GC = (LAS float*)(C.lds + GP_GC); LAS float* BETA = GC + 64; LAS float* EG = GC + 128;
    bf16_t* HBq = (bf16_t*)(p->ws + WS_HB); const bf16_t* Yv = (const bf16_t*)(p->ws + WS_Y); bf16_t* P = (bf16_t*)(p->ws + WS_P);
    const float* SK = (const float*)(p->ws + WS_SK); float* GD = (float*)(p->ws + WS_LRUF) + 2 * BATCH * NCH * LRW;
    for (int it = C.vcu; it < BATCH * NCH * GDH; it += C.G) {
        const int c = it / GDH, h = it % GDH, m0 = chunk_row0(c);
        __syncthreads();
        for (int i = t; i < 64 * 16; i += NTHREADS) { const int tok = i >> 4, cg = i & 15;
            *(LAS v4u*)(QN + tok * 136 + cg * 8) = *(const v4u*)(HBq + (size_t)(m0 + tok) * D + h * 128 + cg * 8);
            *(LAS v4u*)(KN + tok * 136 + cg * 8) = *(const v4u*)(HBq + (size_t)(m0 + tok) * D + 1024 + h * 128 + cg * 8); }
        if (t < 64) { const int m = m0 + t; const bool val = (m % LP) >= PADF;
            float g = val ? -__expf(p->in[19][h]) * softplusf_(SK[(size_t)m * 16 + 8 + h] + p->in[20][h]) : 0.f;
            BETA[t] = val ? sigmoidf_(SK[(size_t)m * 16 + h]) : 0.f;
#pragma unroll
            for (int o = 1; o < 64; o <<= 1) { const float x = __shfl_up(g, o); if (lane >= o) g += x; }
            GC[t] = g; EG[t] = __expf(g); }
        __syncthreads();
        {
            const int mt = C.wave >> 1;
            bf16x8 ka[4], qa[4];
#pragma unroll
            for (int ks = 0; ks < 4; ++ks) { ka[ks] = *(const LAS bf16x8*)(KN + (mt * 16 + fr) * 136 + 32 * ks + 8 * fq); qa[ks] = *(const LAS bf16x8*)(QN + (mt * 16 + fr) * 136 + 32 * ks + 8 * fq); }
#pragma unroll
            for (int jn = 0; jn < 2; ++jn) { const int nt = 2 * (C.wave & 1) + jn; f32x4 kk = {0.f, 0.f, 0.f, 0.f}, qk = {0.f, 0.f, 0.f, 0.f};
#pragma unroll
                for (int ks = 0; ks < 4; ++ks) { const bf16x8 kb = *(const LAS bf16x8*)(KN + (nt * 16 + fr) * 136 + 32 * ks + 8 * fq); kk = mmaT(ka[ks], kb, kk); qk = mmaT(qa[ks], kb, qk); }
                const int cc = mt * 16 + fr, s0 = nt * 16 + 4 * fq; const float gcc = GC[cc], bc = BETA[cc];
                float mv[4], av[4];
#pragma unroll
                for (int i = 0; i < 4; ++i) { const int s = s0 + i; const float dcy = (s <= cc) ? __expf(gcc - GC[s]) : 0.f; mv[i] = (s < cc) ? bc * kk[i] * dcy : 0.f; av[i] = qk[i] * dcy; }
                *(LAS f32x4*)(MM + cc * 68 + s0) = (f32x4){mv[0], mv[1], mv[2], mv[3]};
                *(uint2*)(P + (size_t)(m0 + cc) * NP1 + 1024 + h * 64 + s0) = make_uint2(pk2(av[0], av[1]), pk2(av[2], av[3])); }
        }
        for (int i = t; i < 64 * 16; i += NTHREADS) { const int tok = i >> 4, cg = i & 15; const float bt = BETA[tok], be = bt * EG[tok];
            const v4u xv = *(const v4u*)(Yv + (size_t)(m0 + tok) * D + h * 128 + cg * 8); const v4u xk = *(const LAS v4u*)(KN + tok * 136 + cg * 8);
            LAS float* r = RHS + tok * 256 + cg * 8;
            r[0] = bflo(xv.x) * bt; r[1] = bfhi(xv.x) * bt; r[2] = bflo(xv.y) * bt; r[3] = bfhi(xv.y) * bt; r[4] = bflo(xv.z) * bt; r[5] = bfhi(xv.z) * bt; r[6] = bflo(xv.w) * bt; r[7] = bfhi(xv.w) * bt;
            r[128] = bflo(xk.x) * be; r[129] = bfhi(xk.x) * be; r[130] = bflo(xk.y) * be; r[131] = bfhi(xk.y) * be; r[132] = bflo(xk.z) * be; r[133] = bfhi(xk.z) * be; r[134] = bflo(xk.w) * be; r[135] = bfhi(xk.w) * be; }
        __syncthreads();
        if (C.wave < 4) {
            float x[64];
#pragma unroll
            for (int cc = 0; cc < 64; ++cc) x[cc] = 0.f;
            tri_rows<0>(x, MM, RHS, t);
            bf16_t* dst = (t < 128) ? (P + (size_t)m0 * NP1 + 2048 + h * 128 + t) : (P + (size_t)m0 * NP1 + h * 128 + (t - 128));
#pragma unroll
            for (int cc = 0; cc < 64; ++cc) dst[(size_t)cc * NP1] = (bf16_t)f2bf(x[cc]);
        } else {
            const float glast = GC[63];
            for (int i = t - 256; i < 64 * 16; i += 256) { const int tok = i >> 4, cg = i & 15; const float eq = EG[tok], ek = __expf(glast - GC[tok]);
                const v4u xq = *(const LAS v4u*)(QN + tok * 136 + cg * 8), xk = *(const LAS v4u*)(KN + tok * 136 + cg * 8);
                const v4u oq = {pk2(bflo(xq.x) * eq, bfhi(xq.x) * eq), pk2(bflo(xq.y) * eq, bfhi(xq.y) * eq), pk2(bflo(xq.z) * eq, bfhi(xq.z) * eq), pk2(bflo(xq.w) * eq, bfhi(xq.w) * eq)};
                const v4u ok = {pk2(bflo(xk.x) * ek, bfhi(xk.x) * ek), pk2(bflo(xk.y) * ek, bfhi(xk.y) * ek), pk2(bflo(xk.z) * ek, bfhi(xk.z) * ek), pk2(bflo(xk.w) * ek, bfhi(xk.w) * ek)};
                *(v4u*)(HBq + (size_t)(m0 + tok) * D + h * 128 + cg * 8) = oq; *(v4u*)(HBq + (size_t)(m0 + tok) * D + 1024 + h * 128 + cg * 8) = ok; }
            if (t == 256) GD[it] = __expf(glast);
        }
    }
}
constexpr int GS_W = 0, GS_QD = GS_W + 64 * 136 * 2, GS_KT = GS_QD + 64 * 136 * 2, GS_AQ = GS_KT + 128 * 72 * 2, GS_U = GS_AQ + 64 * 72 * 2, GS_BUF = GS_U + 64 * 40 * 2;
constexpr int GS_ST = 2 * GS_BUF, GS_VN = GS_ST + 2 * 16 * 136 * 2, GS_DEC = GS_VN + 2 * 16 * 72 * 2, GS_END = GS_DEC + 1024;
static_assert(GS_END <= RING_BYTES, "GDN seq LDS");
constexpr int GDN_STREAMS = BATCH * GDH * 4;
#define GS_STAGE_LOAD(n_) do { const size_t m0_ = (size_t)b * LP + (size_t)(n_) * 64; \
            const char* bW = (const char*)(P + m0_ * NP1 + h * 128); const char* bQ = (const char*)(HBq + m0_ * D + h * 128); const char* bK = (const char*)(HBq + m0_ * D + 1024 + h * 128); \
            const char* bA = (const char*)(P + m0_ * NP1 + 1024 + h * 64); const char* bU = (const char*)(P + m0_ * NP1 + 2048 + h * 128 + e0); \
            _Pragma("unroll") for (int i = 0; i < 8; ++i) { rw[i] = *(const v4u*)(bW + (size_t)i * (8 * NP1 * 2) + offW); rq[i] = *(const v4u*)(bQ + (size_t)i * (8 * D * 2) + offQ); rk[i] = *(const v4u*)(bK + (size_t)i * 32 + offK); } \
            _Pragma("unroll") for (int i = 0; i < 4; ++i) ra[i] = *(const v4u*)(bA + (size_t)i * (16 * NP1 * 2) + offA); \
            _Pragma("unroll") for (int i = 0; i < 2; ++i) ru[i] = *(const v4u*)(bU + (size_t)i * (32 * NP1 * 2) + offU); } while (0)
#define GS_STAGE_STORE(buf_) do { LAS bf16_t* B_ = (LAS bf16_t*)(C.lds + (buf_) * GS_BUF); \
            _Pragma("unroll") for (int i = 0; i < 8; ++i) { \
                *(LAS v4u*)(B_ + GS_W / 2 + (tid2 >> 4) * 136 + (tid2 & 15) * 8 + i * (8 * 136)) = rw[i]; *(LAS v4u*)(B_ + GS_QD / 2 + (tid2 >> 4) * 136 + (tid2 & 15) * 8 + i * (8 * 136)) = rq[i]; \
                const unsigned ww[4] = {rk[i].x, rk[i].y, rk[i].z, rk[i].w}; \
                _Pragma("unroll") for (int q = 0; q < 4; ++q) { B_[GS_KT / 2 + (tid2 >> 6) * (8 * 72) + (tid2 & 63) + (i * 16 + 2 * q) * 72] = (bf16_t)(ww[q] & 0xffffu); B_[GS_KT / 2 + (tid2 >> 6) * (8 * 72) + (tid2 & 63) + (i * 16 + 2 * q + 1) * 72] = (bf16_t)(ww[q] >> 16); } } \
            _Pragma("unroll") for (int i = 0; i < 4; ++i) *(LAS v4u*)(B_ + GS_AQ / 2 + (tid2 >> 3) * 72 + (tid2 & 7) * 8 + i * (16 * 72)) = ra[i]; \
            _Pragma("unroll") for (int i = 0; i < 2; ++i) *(LAS v4u*)(B_ + GS_U / 2 + (tid2 >> 2) * 40 + (tid2 & 3) * 8 + i * (32 * 40)) = ru[i]; } while (0)
__device__ __forceinline__ void ph_gdn_seq(const Ctx& C0, KP p, int st0, int stn) {
    const Ctx C = refresh(C0);
    const int lane = C.lane, fr = lane & 15, fq = lane >> 4, t = C.tid, w = C.wave;
    LAS bf16_t* ST = (LAS bf16_t*)(C.lds + GS_ST) + (w & 1) * 16 * 136; LAS bf16_t* VN = (LAS bf16_t*)(C.lds + GS_VN) + (w & 1) * 16 * 72; LAS float* DECL = (LAS float*)(C.lds + GS_DEC);
    const bf16_t* HBq = (const bf16_t*)(p->ws + WS_HB); const bf16_t* P = (const bf16_t*)(p->ws + WS_P); bf16_t* Y = (bf16_t*)(p->ws + WS_Y);
    const float* GD = (const float*)(p->ws + WS_LRUF) + 2 * BATCH * NCH * LRW;
    for (int st = st0; st < GDN_STREAMS; st += stn) {
        const int b = st / (GDH * 4), h = (st >> 2) % GDH, e0 = (st & 3) * 32;
        __syncthreads();
        if (w < 2) {
#pragma unroll
            for (int nt = 0; nt < 8; ++nt) *(LAS v2u*)(ST + fr * 136 + nt * 16 + 4 * fq) = (v2u){0u, 0u}; }
        if (t < NCH) DECL[t] = GD[(size_t)(b * NCH + t) * GDH + h];
        __syncthreads();
        if (w >= 4) {
            v4u rw[8], rq[8], rk[8], ra[4], ru[2];
            const int grp = (w >> 1) - 2, tid2 = t & 127;
            const unsigned offW = (unsigned)(((tid2 >> 4) * NP1 + (tid2 & 15) * 8) * 2), offQ = (unsigned)(((tid2 >> 4) * D + (tid2 & 15) * 8) * 2);
            const unsigned offK = (unsigned)(((tid2 & 63) * D + (tid2 >> 6) * 8) * 2), offA = (unsigned)(((tid2 >> 3) * NP1 + (tid2 & 7) * 8) * 2), offU = (unsigned)(((tid2 >> 2) * NP1 + (tid2 & 3) * 8) * 2);
            if (grp == 0) { GS_STAGE_LOAD(0); GS_STAGE_STORE(0); GS_STAGE_LOAD(2); } else GS_STAGE_LOAD(1);
            LBAR();
            for (int n = 0; n < NCH; ++n) {
                if (n + 1 < NCH && grp == ((n + 1) & 1)) { GS_STAGE_STORE((n + 1) & 1); if (n + 3 < NCH) GS_STAGE_LOAD(n + 3); }
                LBAR();
            }
        } else if (w < 2) {
            f32x4 S[8];
#pragma unroll
            for (int nt = 0; nt < 8; ++nt) S[nt] = (f32x4){0.f, 0.f, 0.f, 0.f};
            LBAR();
            for (int n = 0; n < NCH; ++n) {
                const LAS bf16_t* B_ = (const LAS bf16_t*)(C.lds + (n & 1) * GS_BUF);
                const LAS bf16_t* Wl = B_ + GS_W / 2; const LAS bf16_t* QD = B_ + GS_QD / 2; const LAS bf16_t* KT = B_ + GS_KT / 2; const LAS bf16_t* AQ = B_ + GS_AQ / 2; const LAS bf16_t* Ul = B_ + GS_U / 2;
                const float dec = DECL[n];
                const size_t m0 = (size_t)b * LP + (size_t)n * 64;
                f32x4 vn[4], o[4];
#pragma unroll
                for (int mt = 0; mt < 4; ++mt) { vn[mt] = (f32x4){0.f, 0.f, 0.f, 0.f}; o[mt] = (f32x4){0.f, 0.f, 0.f, 0.f}; }
                bf16x8 sb[4], wf[4][4], qf[4][4];
#pragma unroll
                for (int ks = 0; ks < 4; ++ks) sb[ks] = *(const LAS bf16x8*)(ST + fr * 136 + 32 * ks + 8 * fq);
#pragma unroll
                for (int ks = 0; ks < 4; ++ks)
#pragma unroll
                    for (int mt = 0; mt < 4; ++mt) wf[ks][mt] = *(const LAS bf16x8*)(Wl + (mt * 16 + fr) * 136 + 32 * ks + 8 * fq);
#pragma unroll
                for (int ks = 0; ks < 4; ++ks)
#pragma unroll
                    for (int mt = 0; mt < 4; ++mt) qf[ks][mt] = *(const LAS bf16x8*)(QD + (mt * 16 + fr) * 136 + 32 * ks + 8 * fq);
                v2u uu[4];
#pragma unroll
                for (int mt = 0; mt < 4; ++mt) uu[mt] = *(const LAS v2u*)(Ul + (mt * 16 + fr) * 40 + w * 16 + 4 * fq);
#pragma unroll
                for (int ks = 0; ks < 4; ++ks)
#pragma unroll
                    for (int mt = 0; mt < 4; ++mt) vn[mt] = mmaT(wf[ks][mt], sb[ks], vn[mt]);
                bf16x8 kf[8][2];
#pragma unroll
                for (int nt = 0; nt < 8; ++nt)
#pragma unroll
                    for (int ks = 0; ks < 2; ++ks) kf[nt][ks] = *(const LAS bf16x8*)(KT + (nt * 16 + fr) * 72 + 32 * ks + 8 * fq);
#pragma unroll
                for (int mt = 0; mt < 4; ++mt) {
                    const float v0 = bflo(uu[mt].x) - vn[mt][0], v1 = bfhi(uu[mt].x) - vn[mt][1], v2 = bflo(uu[mt].y) - vn[mt][2], v3 = bfhi(uu[mt].y) - vn[mt][3];
                    VN[(4 * fq + 0) * 72 + mt * 16 + fr] = (bf16_t)f2bf(v0); VN[(4 * fq + 1) * 72 + mt * 16 + fr] = (bf16_t)f2bf(v1);
                    VN[(4 * fq + 2) * 72 + mt * 16 + fr] = (bf16_t)f2bf(v2); VN[(4 * fq + 3) * 72 + mt * 16 + fr] = (bf16_t)f2bf(v3); }
#pragma unroll
                for (int ks = 0; ks < 4; ++ks)
#pragma unroll
                    for (int mt = 0; mt < 4; ++mt) o[mt] = mmaT(qf[ks][mt], sb[ks], o[mt]);
                LDSW();
                bf16x8 vb[2], af[4][2];
#pragma unroll
                for (int ks = 0; ks < 2; ++ks) vb[ks] = *(const LAS bf16x8*)(VN + fr * 72 + 32 * ks + 8 * fq);
#pragma unroll
                for (int mt = 0; mt < 4; ++mt)
#pragma unroll
                    for (int ks = 0; ks < 2; ++ks) af[mt][ks] = *(const LAS bf16x8*)(AQ + (mt * 16 + fr) * 72 + 32 * ks + 8 * fq);
#pragma unroll
                for (int nt = 0; nt < 8; ++nt) { S[nt] *= dec;
#pragma unroll
                    for (int ks = 0; ks < 2; ++ks) S[nt] = mmaT(vb[ks], kf[nt][ks], S[nt]); }
#pragma unroll
                for (int nt = 0; nt < 8; ++nt) *(LAS v2u*)(ST + fr * 136 + nt * 16 + 4 * fq) = (v2u){pk2(S[nt][0], S[nt][1]), pk2(S[nt][2], S[nt][3])};
#pragma unroll
                for (int mt = 0; mt < 4; ++mt) {
#pragma unroll
                    for (int ks = 0; ks < 2; ++ks) o[mt] = mmaT(af[mt][ks], vb[ks], o[mt]);
                    *(uint2*)(Y + (m0 + mt * 16 + fr) * D + h * 128 + e0 + w * 16 + 4 * fq) = make_uint2(pk2(o[mt][0], o[mt][1]), pk2(o[mt][2], o[mt][3])); }
                LBAR();
            }
        } else {
            LBAR();
            for (int n = 0; n < NCH; ++n) LBAR();
        }
    }
}
#undef GS_STAGE_LOAD
#undef GS_STAGE_STORE
__device__ __forceinline__ void ph_gdn_norm(const Ctx& C0, KP p) {
    const Ctx C = refresh(C0);
    const int lane = C.lane;
    bf16_t* Y = (bf16_t*)(p->ws + WS_Y); const bf16_t* P = (const bf16_t*)(p->ws + WS_P);
    for (int m = C.gw; m < MROWS; m += C.ngw) {
        bf16_t* yr = Y + (size_t)m * D + lane * 16; const bf16_t* zr = P + (size_t)m * NP1 + P1_Z + lane * 16;
        const v4u a0 = *(const v4u*)yr, a1 = *(const v4u*)(yr + 8), z0 = *(const v4u*)zr, z1 = *(const v4u*)(zr + 8);
        const unsigned aw[8] = {a0.x, a0.y, a0.z, a0.w, a1.x, a1.y, a1.z, a1.w}, zw[8] = {z0.x, z0.y, z0.z, z0.w, z1.x, z1.y, z1.z, z1.w};
        float ss = 0.f;
#pragma unroll
        for (int q = 0; q < 8; ++q) ss += bflo(aw[q]) * bflo(aw[q]) + bfhi(aw[q]) * bfhi(aw[q]);
        ss += __shfl_xor(ss, 1); ss += __shfl_xor(ss, 2); ss += __shfl_xor(ss, 4);
        const float rs = rsqrtf(ss * (1.0f / 128.0f) + NORM_EPS);
        const float* ng = p->in[21] + (lane & 7) * 16;
        unsigned ow[8];
#pragma unroll
        for (int q = 0; q < 8; ++q) ow[q] = pk2(bflo(aw[q]) * rs * ng[2 * q] * siluf_(bflo(zw[q])), bfhi(aw[q]) * rs * ng[2 * q + 1] * siluf_(bfhi(zw[q])));
        *(v4u*)yr = (v4u){ow[0], ow[1], ow[2], ow[3]}; *(v4u*)(yr + 8) = (v4u){ow[4], ow[5], ow[6], ow[7]};
    }
}

template <bool FINAL> __device__ __forceinline__ void ph_lru(const Ctx& C0, KP p, int worker, int nworkers) {
    const Ctx C = refresh(C0);
    LruW W; W.hb = -1;
#pragma unroll
    for (int q = 0; q < 4; ++q) { W.ba[q] = (bf16x8){0, 0, 0, 0, 0, 0, 0, 0}; W.bx[q] = W.ba[q]; }
    for (int it = worker; it < BATCH * NCH * LRB; it += nworkers) lru_item<FINAL>(C, p, it, W);
}
#ifndef DUP_SUB
#define DUP_SUB 0
#endif
#ifndef DUP_PHASE
#define DUP_PHASE -1
#endif
#define REP(k) for (int rep_ = 0; rep_ < ((DUP_PHASE) == (k) ? 2 : 1); ++rep_)
#define IN(k) in_ph(k)
#define SEAM(k) do { if (in_ph(k) && in_ph((k) + 1)) xcd_barrier(bar); } while (0)
template <int L> __device__ __forceinline__ void layer_phases(const Ctx& C, const XcdBarrier& bar, PG8_LAS unsigned char* ring) {
        const int base = 1 + 11 * L;
        REP(1 + 11 * L + 0) if (IN(base + 0)) {
            KP p = kp(); const int N = L ? NP1 : NP0;
            pg8::Gemm g{(const bf16_t*)(p->ws + WS_HB), (const bf16_t*)(p->ws + (L ? WS_WIN1 : WS_WIN0)), MP, N, D}; pg8::StaticOrder S; S.init(MP, N, C.G, (int)blockIdx.x);
            EpiStoreBf16 E{(bf16_t*)(p->ws + WS_P), N};
            pg8::gemm_phase<EpiStoreBf16, pg8::StaticOrder, true, true>(ring, g, S, E);
            ph_skinny(C, kp(), L);
            cvt_pull(C, kp(), L);
        }
        SEAM(base + 0);
        if constexpr (L == 0) {
            REP(1 + 11 * L + 1) if (IN(base + 1)) { for (int r2 = 0; r2 < (DUP_SUB == 3 ? 2 : 1); ++r2) ph_s5<false>(C, kp()); for (int r2 = 0; r2 < (DUP_SUB == 4 ? 2 : 1); ++r2) ph_gla_a(C, kp()); }
            SEAM(base + 1);
            REP(1 + 11 * L + 2) if (IN(base + 2)) { ph_s5_carry(C, kp()); ph_gla_b(C, kp()); }
            SEAM(base + 2);
            REP(1 + 11 * L + 3) if (IN(base + 3)) { for (int r2 = 0; r2 < (DUP_SUB == 5 ? 2 : 1); ++r2) ph_s5<true>(C, kp()); for (int r2 = 0; r2 < (DUP_SUB == 6 ? 2 : 1); ++r2) ph_gla_c(C, kp()); }
            SEAM(base + 3);
            REP(1 + 11 * L + 4) if (IN(base + 4)) {
                KP p = kp();
                pg8::Gemm g{(const bf16_t*)(p->ws + WS_Z), (const bf16_t*)(p->ws + WS_WGLU), MP, S5W, S5W}; pg8::StaticOrder S; S.init(MP, S5W, C.G, (int)blockIdx.x);
                EpiGlu E{(const bf16_t*)(p->ws + WS_Z), p->in[12], (bf16_t*)(p->ws + WS_Y)};
                pg8::gemm_phase<EpiGlu, pg8::StaticOrder, true, true>(ring, g, S, E);
            }
            SEAM(base + 4);
        } else {
            REP(1 + 11 * L + 1) if (IN(base + 1)) { for (int r2 = 0; r2 < (DUP_SUB == 7 ? 2 : 1); ++r2) ph_gdn_conv(C, kp()); for (int r2 = 0; r2 < (DUP_SUB == 8 ? 2 : 1); ++r2) ph_lru<false>(C, kp(), C.vcu, C.G); }
            SEAM(base + 1);
            REP(1 + 11 * L + 2) if (IN(base + 2)) { ph_gdn_prep(C, kp()); ph_lru_carry(C, kp()); }
            SEAM(base + 2);
            REP(1 + 11 * L + 3) if (IN(base + 3)) {
                if (C.G != 256) { ph_gdn_seq(C, kp(), C.vcu, C.G); ph_lru<true>(C, kp(), C.vcu, C.G); }
                else { const int xcd = C.vcu >> 5, j = C.vcu & 31;
                    if (j < 8) { for (int r2 = 0; r2 < (DUP_SUB == 1 ? 2 : 1); ++r2) ph_gdn_seq(C, kp(), (((j >> 2) * 8 + xcd) << 2) + (j & 3), GDN_STREAMS); }
                    else { for (int r2 = 0; r2 < (DUP_SUB == 2 ? 2 : 1); ++r2) ph_lru<true>(C, kp(), xcd * 24 + (j - 8), 192); } }
            }
            SEAM(base + 3);
            REP(1 + 11 * L + 4) if (IN(base + 4)) ph_gdn_norm(C, kp());
            SEAM(base + 4);
        }
        REP(1 + 11 * L + 5) if (IN(base + 5)) {
            KP p = kp();
            pg8::Gemm g{(const bf16_t*)(p->ws + WS_Y), (const bf16_t*)(p->ws + (L ? WS_WOUT1 : WS_WOUT0)), MP, D, D}; pg8::StaticOrder S; S.init(MP, D, C.G, (int)blockIdx.x);
            EpiStoreBf16 E{(bf16_t*)(p->ws + WS_MIX), D};
            pg8::gemm_phase<EpiStoreBf16, pg8::StaticOrder, true, true>(ring, g, S, E);
        }
        SEAM(base + 5);
        REP(1 + 11 * L + 6) if (IN(base + 6)) ph_ln1_router(C, kp(), L);
        SEAM(base + 6);
        REP(1 + 11 * L + 8) if (IN(base + 8)) {
            KP p = kp();
            const int nt = moe_build_tiles(C, (unsigned*)(p->ws + WS_CTL) + CW_CNT + L * 32);
            MoeGatherOrder S{(const volatile LAS int*)(C.lds + LDS_TILETAB), nt, 2, C.G, C.vcu, (const int*)(p->ws + WS_LISTE)};
            pg8::Gemm g{(const bf16_t*)(p->ws + WS_HB), (const bf16_t*)(p->ws + WS_MW1), 0, 0, D}; EpiMoe1 E{(bf16_t*)(p->ws + WS_HH), (const int*)(p->ws + WS_LISTE), (const float*)(p->ws + WS_TOKW)};
            pg8::gemm_phase<EpiMoe1, MoeGatherOrder, true, true>(ring, g, S, E);
        }
        SEAM(base + 8);
        REP(1 + 11 * L + 9) if (IN(base + 9)) {
            KP p = kp();
            const int nt = moe_build_tiles(C, (unsigned*)(p->ws + WS_CTL) + CW_CNT + L * 32);
            MoeOrder S{(const volatile LAS int*)(C.lds + LDS_TILETAB), nt, 8, C.G, C.vcu};
            int kk = MOE_FF; asm volatile("" : "+s"(kk));
            pg8::Gemm g{(const bf16_t*)(p->ws + WS_HH), (const bf16_t*)(p->ws + WS_MW2), 0, 0, kk}; EpiMoe2 E{(bf16_t*)(p->ws + WS_XS)};
            pg8::gemm_phase<EpiMoe2, MoeOrder, true, true>(ring, g, S, E);
        }
        SEAM(base + 9);
        REP(1 + 11 * L + 10) if (IN(base + 10)) ph_ln2(C, kp(), L);
        SEAM(base + 10);
    }
__global__ void __launch_bounds__(NTHREADS, 2) mk(Args a_unused) {
    extern __shared__ __attribute__((aligned(16))) unsigned char shm[];
    Ctx C; C.lds = (LAS unsigned char*)shm; C.tid = threadIdx.x; C.lane = C.tid & 63; C.wave = __builtin_amdgcn_readfirstlane(C.tid >> 6);
    C.G = gridDim.x; { const int bx = blockIdx.x; C.vcu = (C.G % 8 == 0) ? (bx % 8) * (C.G / 8) + bx / 8 : bx; }
    C.gw = C.vcu * NWAVES + C.wave; C.ngw = C.G * NWAVES;
    for (int u = C.tid; u < (LDS_BYTES - LDSCTL_OFF) / 4; u += NTHREADS) ((LAS unsigned*)(C.lds + LDSCTL_OFF))[u] = 0u;
    __syncthreads();
    XcdBarrier bar;
    { KA a = kargs(); bar = xcd_barrier_post((unsigned*)(a->p.ws + WS_CTL) + CW_BAR + a->li * XCD_BAR_WORDS, (volatile LAS unsigned*)(C.lds + LDSCTL_OFF)); }
    PG8_LAS unsigned char* ring = (PG8_LAS unsigned char*)shm;

    REP(0) if (IN(0)) ph_prologue(C, kp());
    SEAM(0);
    layer_phases<0>(C, bar, ring);
    layer_phases<1>(C, bar, ring);
}
#undef IN
#undef SEAM
#ifndef FUSE
#define FUSE 1
#endif
static void launch_mk(const Ptrs& p, int lo, int hi, int& li, int grid, hipStream_t s) {
    Args a{}; a.p = p; a.ph_lo = lo; a.ph_hi = hi; a.li = li++; a.pad = 0;
    if (FUSE) { hipLaunchKernelGGL(mk, dim3(grid), dim3(NTHREADS), LDS_BYTES, s, a); }
    else for (int k = lo; k < hi; ++k) { a.ph_lo = k; a.ph_hi = k + 1; a.li = li++; hipLaunchKernelGGL(mk, dim3(grid), dim3(NTHREADS), LDS_BYTES, s, a); }
}
extern "C" void kernel_launch(void* const* d_in, const int* in_sizes, int n_in, void* d_out, int out_size, void* d_ws, size_t ws_size, hipStream_t stream) {
    static int grid = 0;
    if (grid == 0) {
        if (n_in != 41 || ws_size < WS_END || out_size != BATCH * SEQ * D) { fprintf(stderr, "kernel_launch: unexpected shapes n_in %d ws %zu (need %zu) out %d\n", n_in, ws_size, (size_t)WS_END, out_size); grid = -1; }
        else {
            int dev = 0, cus = 0;
            if (hipGetDevice(&dev) != hipSuccess || hipDeviceGetAttribute(&cus, hipDeviceAttributeMultiprocessorCount, dev) != hipSuccess) { grid = -1; }
            else if (hipFuncSetAttribute((const void*)mk, hipFuncAttributeMaxDynamicSharedMemorySize, LDS_BYTES) != hipSuccess) { fprintf(stderr, "kernel_launch: hipFuncSetAttribute failed\n"); grid = -1; }
            else grid = cus;
        }
    }
    if (grid < 0) return;
    Ptrs p{};
    for (int i = 0; i < 41; ++i) p.in[i] = (const float*)d_in[i];
    p.out = (float*)d_out; p.ws = (unsigned char*)d_ws;
    hipMemsetAsync((char*)d_ws + WS_CTL, 0, 1 * MiB, stream);
    int li = 0;
    launch_mk(p, 0, NPHASES, li, grid, stream);
}
```
